# Optimizing an MI355X kernel written in HIP

```python
import jax, jax.numpy as jnp
from jax import lax
import numpy as np

D_MODEL = 4096
BATCH = 1
SEQ = 16384
DEPTH = 1
DEC_BATCH = 2
DEC_SEQ = 4096
PAST_LEN = 128

HEAD_DIM = 128
N_HEADS = D_MODEL // HEAD_DIM
N_NA_HEADS = N_HEADS // 2
N_SW_HEADS = N_HEADS - N_NA_HEADS
N_SW_KV_HEADS = max(1, N_SW_HEADS // 4)
D_NA = N_NA_HEADS * HEAD_DIM
D_SW = N_SW_HEADS * HEAD_DIM
D_SW_KV = N_SW_KV_HEADS * HEAD_DIM
D_IN = 3 * D_NA + D_SW + 2 * D_SW_KV
D_FF = -(-8 * D_MODEL // (3 * 256)) * 256
GRID_W = 64
NA_MAX_ROWS = 8
NA_COLS = 16
NA_QROWS = 2
SW_WINDOW = 128
SW_BLOCK = 128
N_META = 16
EPS = 1e-6
NEG_INF = -1e30

kernel_name = 'hybrid_natten_swa_encoder'


def rmsnorm(x, g):
    x32 = x.astype(jnp.float32)
    y = x32 * lax.rsqrt(jnp.mean(x32 * x32, axis=-1, keepdims=True) + EPS)
    return y.astype(x.dtype) * g


def alibi_slopes(n):
    return jnp.exp2(-8.0 * (jnp.arange(n, dtype=jnp.float32) + 1.0) / n)


def neighbourhood_attention(q, k, v, qm, km, vm, rpb):
    B, T, H, D = q.shape
    M = km.shape[1]
    rows = T // GRID_W
    kh = min(NA_MAX_ROWS, rows)
    nr = min(kh + 1, rows)
    nblk = rows // NA_QROWS
    nq = NA_QROWS * GRID_W
    nk = nr * GRID_W
    scale = D ** -0.5
    rs = jnp.clip(jnp.arange(rows) - kh // 2, 0, rows - kh)
    cs = jnp.clip(jnp.arange(GRID_W) - NA_COLS // 2, 0, GRID_W - NA_COLS)
    r0 = jnp.arange(nblk) * NA_QROWS
    key_rows = jnp.clip(rs[r0], 0, rows - nr)[:, None] + jnp.arange(nr)[None, :]
    kg = k.reshape(B, rows, GRID_W, H, D)[:, key_rows].reshape(B, nblk, nk, H, D)
    vg = v.reshape(B, rows, GRID_W, H, D)[:, key_rows].reshape(B, nblk, nk, H, D)
    qb = (q * scale).reshape(B, nblk, nq, H, D)
    qr = r0[:, None] + jnp.arange(nq)[None, :] // GRID_W
    qc = jnp.arange(nq) % GRID_W
    kr = jnp.repeat(key_rows, GRID_W, axis=1)
    kc = jnp.tile(jnp.arange(GRID_W), nr)
    rq = rs[qr][:, :, None]
    cq = cs[qc][:, None]
    col_ok = (kc[None, :] >= cq) & (kc[None, :] < cq + NA_COLS)
    valid = (kr[:, None, :] >= rq) & (kr[:, None, :] < rq + kh) & col_ok[None]
    ir = jnp.clip(kr[:, None, :] - qr[:, :, None] + (NA_MAX_ROWS - 1), 0, 2 * NA_MAX_ROWS - 2)
    ic = jnp.clip(kc[None, :] - qc[:, None] + (NA_COLS - 1), 0, 2 * NA_COLS - 2)
    ic = jnp.broadcast_to(ic[None], ir.shape)
    bias = rpb[:, ir, ic].astype(jnp.float32)
    s = jnp.einsum('bnqhd,bnkhd->bhnqk', qb, kg).astype(jnp.float32) + bias[None]
    s = jnp.where(valid[None, None], s, NEG_INF)
    sm = jnp.einsum('bnqhd,bmhd->bhnqm', qb, km).astype(jnp.float32)
    p = jax.nn.softmax(jnp.concatenate([sm, s], axis=-1), axis=-1).astype(v.dtype)
    o = (jnp.einsum('bhnqm,bmhd->bnqhd', p[..., :M], vm)
         + jnp.einsum('bhnqk,bnkhd->bnqhd', p[..., M:], vg)).reshape(B, T, H * D)
    pm = jax.nn.softmax(jnp.einsum('bmhd,bnhd->bhmn', qm * scale, km).astype(jnp.float32), axis=-1).astype(v.dtype)
    om = jnp.einsum('bhmn,bnhd->bmhd', pm, vm).reshape(B, M, H * D)
    return om, o


def window_attention(q, k, v, qm, km, vm, sink, slopes):
    B, T, Hq, D = q.shape
    Hkv = k.shape[2]
    G = Hq // Hkv
    M = km.shape[1]
    nb = T // SW_BLOCK
    scale = D ** -0.5
    slope_kg = slopes.reshape(Hkv, G)
    sink_kg = sink.astype(jnp.float32).reshape(Hkv, G)
    slope = slope_kg[:, :, None, None, None]
    qb = (q * scale).reshape(B, nb, SW_BLOCK, Hkv, G, D)
    pad = ((0, 0), (SW_BLOCK, SW_BLOCK), (0, 0), (0, 0))
    kp = jnp.pad(k, pad).reshape(B, nb + 2, SW_BLOCK, Hkv, D)
    vp = jnp.pad(v, pad).reshape(B, nb + 2, SW_BLOCK, Hkv, D)
    kb = jnp.concatenate([kp[:, :-2], kp[:, 1:-1], kp[:, 2:]], axis=2)
    vb = jnp.concatenate([vp[:, :-2], vp[:, 1:-1], vp[:, 2:]], axis=2)
    qpos = jnp.arange(nb)[:, None] * SW_BLOCK + jnp.arange(SW_BLOCK)[None, :]
    kpos = (jnp.arange(nb)[:, None] - 1) * SW_BLOCK + jnp.arange(3 * SW_BLOCK)[None, :]
    dist = jnp.abs(qpos[:, :, None] - kpos[:, None, :])
    valid = (dist <= SW_WINDOW) & (kpos[:, None, :] >= 0) & (kpos[:, None, :] < T)
    s = jnp.einsum('bnqkgd,bnskd->bkgnqs', qb, kb).astype(jnp.float32) - slope * dist.astype(jnp.float32)
    s = jnp.where(valid, s, NEG_INF)
    mdist = jnp.minimum(M + qpos[:, :, None] - jnp.arange(M)[None, None, :], SW_WINDOW).astype(jnp.float32)
    sm = jnp.einsum('bnqkgd,bmkd->bkgnqm', qb, km).astype(jnp.float32) - slope * mdist
    sk = jnp.broadcast_to(sink_kg[None, :, :, None, None, None], sm.shape[:-1] + (1,))
    p = jax.nn.softmax(jnp.concatenate([sm, s, sk], axis=-1), axis=-1).astype(v.dtype)
    o = (jnp.einsum('bkgnqm,bmkd->bnqkgd', p[..., :M], vm)
         + jnp.einsum('bkgnqs,bnskd->bnqkgd', p[..., M:M + 3 * SW_BLOCK], vb)).reshape(B, T, Hq * D)
    qmb = (qm * scale).reshape(B, M, Hkv, G, D)
    km2 = jnp.concatenate([km, k[:, :SW_BLOCK]], axis=1)
    vm2 = jnp.concatenate([vm, v[:, :SW_BLOCK]], axis=1)
    kmpos = jnp.concatenate([jnp.arange(M), M + jnp.arange(SW_BLOCK)])
    mqd = jnp.abs(jnp.arange(M)[:, None] - kmpos[None, :])
    smq = (jnp.einsum('bmkgd,bskd->bkgms', qmb, km2).astype(jnp.float32)
           - slope_kg[:, :, None, None] * mqd.astype(jnp.float32))
    smq = jnp.where(mqd <= SW_WINDOW, smq, NEG_INF)
    skm = jnp.broadcast_to(sink_kg[None, :, :, None, None], smq.shape[:-1] + (1,))
    pmq = jax.nn.softmax(jnp.concatenate([smq, skm], axis=-1), axis=-1).astype(v.dtype)
    om = jnp.einsum('bkgms,bskd->bmkgd', pmq[..., :-1], vm2).reshape(B, M, Hq * D)
    return om, o


def encoder_layer(x, w_in, w_out, rpb, sink, g_na, g_sw, g_pre_mix, g_post_mix,
                  g_pre_ffn, g_post_ffn, w_gate, w_up, w_down, slopes):
    B, L, _ = x.shape
    M = N_META
    h = rmsnorm(x, g_pre_mix)
    proj = h @ w_in
    cuts = [D_NA, 2 * D_NA, 3 * D_NA, 3 * D_NA + D_SW, 3 * D_NA + D_SW + D_SW_KV]
    qa, ka, va, qs, ks, vs = jnp.split(proj, cuts, axis=-1)
    qa = qa.reshape(B, L, N_NA_HEADS, HEAD_DIM)
    ka = ka.reshape(B, L, N_NA_HEADS, HEAD_DIM)
    va = va.reshape(B, L, N_NA_HEADS, HEAD_DIM)
    qs = qs.reshape(B, L, N_SW_HEADS, HEAD_DIM)
    ks = ks.reshape(B, L, N_SW_KV_HEADS, HEAD_DIM)
    vs = vs.reshape(B, L, N_SW_KV_HEADS, HEAD_DIM)
    oa_m, oa = neighbourhood_attention(qa[:, M:], ka[:, M:], va[:, M:], qa[:, :M], ka[:, :M], va[:, :M], rpb)
    os_m, os_r = window_attention(qs[:, M:], ks[:, M:], vs[:, M:], qs[:, :M], ks[:, :M], vs[:, :M], sink, slopes)
    o_na = jnp.concatenate([oa_m, oa], axis=1)
    o_sw = jnp.concatenate([os_m, os_r], axis=1)
    mix = jnp.concatenate([rmsnorm(o_na, g_na), rmsnorm(o_sw, g_sw)], axis=-1) @ w_out
    x = x + rmsnorm(mix, g_post_mix)
    h = rmsnorm(x, g_pre_ffn)
    f = (jax.nn.silu(h @ w_gate) * (h @ w_up)) @ w_down
    return x + rmsnorm(f, g_post_ffn)


def setup_inputs(seed: int = 0) -> dict:
    key = jax.random.key(seed)
    ks = jax.random.split(key, 16)
    f32 = jnp.float32

    def nrm(k, shape, s):
        return jax.random.normal(k, shape, f32) * s

    def gain(k, shape):
        return 1.0 + 0.05 * jax.random.normal(k, shape, f32)

    return {
        'x_prompt': nrm(ks[0], (BATCH, SEQ, D_MODEL), 1.0),
        'x_sample': nrm(ks[1], (DEC_BATCH, DEC_SEQ, D_MODEL), 1.0),
        'meta_tokens': nrm(ks[2], (N_META, D_MODEL), 1.0),
        'w_in': nrm(ks[3], (DEPTH, D_MODEL, D_IN), D_MODEL ** -0.5),
        'w_out': nrm(ks[4], (DEPTH, D_NA + D_SW, D_MODEL), (D_NA + D_SW) ** -0.5),
        'rpb': nrm(ks[5], (DEPTH, N_NA_HEADS, 2 * NA_MAX_ROWS - 1, 2 * NA_COLS - 1), 0.5),
        'sink': nrm(ks[6], (DEPTH, N_SW_HEADS), 0.5),
        'g_na_out': gain(ks[7], (DEPTH, D_NA)),
        'g_sw_out': gain(ks[8], (DEPTH, D_SW)),
        'g_pre_mix': gain(ks[9], (DEPTH, D_MODEL)),
        'g_post_mix': gain(ks[10], (DEPTH, D_MODEL)),
        'g_pre_ffn': gain(ks[11], (DEPTH, D_MODEL)),
        'g_post_ffn': gain(ks[12], (DEPTH, D_MODEL)),
        'w_gate': nrm(ks[13], (DEPTH, D_MODEL, D_FF), D_MODEL ** -0.5),
        'w_up': nrm(ks[14], (DEPTH, D_MODEL, D_FF), D_MODEL ** -0.5),
        'w_down': nrm(ks[15], (DEPTH, D_FF, D_MODEL), D_FF ** -0.5),
    }


def reference(x_prompt, x_sample, meta_tokens, w_in, w_out, rpb, sink, g_na_out, g_sw_out,
              g_pre_mix, g_post_mix, g_pre_ffn, g_post_ffn, w_gate, w_up, w_down):
    slopes = alibi_slopes(N_SW_HEADS)

    def trunk(x):
        B = x.shape[0]
        meta = jnp.broadcast_to(meta_tokens[None].astype(x.dtype), (B, N_META, D_MODEL))
        h = jnp.concatenate([meta, x], axis=1)
        for l in range(DEPTH):
            h = encoder_layer(h, w_in[l], w_out[l], rpb[l], sink[l], g_na_out[l], g_sw_out[l],
                              g_pre_mix[l], g_post_mix[l], g_pre_ffn[l], g_post_ffn[l],
                              w_gate[l], w_up[l], w_down[l], slopes)
        return h[:, N_META:]

    y_prompt = trunk(x_prompt)
    y_sample = trunk(x_sample)
    return (y_prompt, y_sample)
```

```cpp
#include <hip/hip_runtime.h>
#include <hip/hip_bf16.h>
#include <cstdio>
#include <cstdint>
namespace pg8 {
#define PG8_LAS __attribute__((address_space(3)))
typedef unsigned short bf16_t;
typedef short bf16x8 __attribute__((ext_vector_type(8)));
typedef float f32x4 __attribute__((ext_vector_type(4)));
typedef unsigned u32x4 __attribute__((ext_vector_type(4)));
constexpr int BM = 256, BK = 64, HALF = 128, HTB = HALF * BK * 2  , STAGE_BYTES = 8 * HTB, NXCD = 8, WGM = 8;

__host__ __device__ __forceinline__ int lds_byte(int r, int c) { const int st = (r >> 4) * 2 + (c >> 5), rr = r & 15, cc = c & 31, ob = rr * 64 + cc * 2; return st * 1024 + (ob ^ (((ob >> 9) & 1) << 5)); }
__host__ __device__ __forceinline__ void stage_rc(int b, int& R, int& C) { const int st = b / 1024, sb = b % 1024, swz = sb ^ (((sb >> 9) & 1) << 5); R = (st >> 1) * 16 + swz / 64; C = (st & 1) * 32 + (swz % 64) / 2; }
__host__ __device__ __forceinline__ int perm32(int rho) { const int n = rho >> 4, i = rho & 15; return 8 * (i >> 2) + 4 * n + (i & 3); }

struct Unit { int pm, pn; };
struct Gemm { const bf16_t* A; const bf16_t* Bt; int M, N, K; };

struct StaticOrder {
    int nM, nN, nwg, G, c;
    __host__ __device__ void init(int M, int N, int G_, int c_) { nM = M / BM; nN = N / BM; nwg = nM * nN; G = G_; c = c_; }
    __host__ __device__ bool next(int i, Unit& u) const {
        const long L = (long)i * G + c; if (L >= nwg) return false;
        int wgid = (int)L; { const int q = nwg / NXCD, r = nwg % NXCD, xcd = wgid % NXCD, off = wgid / NXCD; wgid = (xcd < r ? xcd * (q + 1) : r * (q + 1) + (xcd - r) * q) + off; }
        const int nig = WGM * nN, gid = wgid / nig, fm = gid * WGM, gsz = (nM - fm) < WGM ? (nM - fm) : WGM;
        u.pm = fm + ((wgid % nig) % gsz); u.pn = (wgid % nig) / gsz; return true;
    }
    __device__ __forceinline__ void a_ready(const Unit&) const {}
    __device__ __forceinline__ void done(const Unit&) const {}
};

__device__ __forceinline__ unsigned cvt_pk_bf16(float lo, float hi) { unsigned r; asm volatile("v_cvt_pk_bf16_f32 %0, %1, %2" : "=v"(r) : "v"(lo), "v"(hi)); return r; }
typedef float f32x2 __attribute__((ext_vector_type(2)));
struct EpiBf16 {
    static constexpr bool PERM = true, AFTER_DRAIN = false;
    bf16_t* O; int ldc;
    __device__ __forceinline__ void operator()(const f32x4 (&acc)[2][2][4][2], const Unit& u, int wr, int wc, int fr, int fq) const {
        const int row0 = u.pm * BM + wr * 64 + fr, col0 = u.pn * BM + wc * 32 + 8 * fq;
#pragma unroll
        for (int ai = 0; ai < 2; ++ai)
#pragma unroll
            for (int m = 0; m < 4; ++m) { bf16_t* rowp = O + (size_t)(row0 + ai * HALF + m * 16) * ldc + col0;
#pragma unroll
                for (int bj = 0; bj < 2; ++bj) { const f32x4 v0 = acc[ai][bj][m][0], v1 = acc[ai][bj][m][1];
                    u32x4 w; w.x = cvt_pk_bf16(v0[0], v0[1]); w.y = cvt_pk_bf16(v0[2], v0[3]); w.z = cvt_pk_bf16(v1[0], v1[1]); w.w = cvt_pk_bf16(v1[2], v1[3]);
                    *(u32x4*)(rowp + bj * HALF) = w; } }
    }
};
struct EpiF32 {
    static constexpr bool PERM = false, AFTER_DRAIN = false;
    float* C; int ldc;
    __device__ __forceinline__ void operator()(const f32x4 (&acc)[2][2][4][2], const Unit& u, int wr, int wc, int fr, int fq) const {
        const int row0 = u.pm * BM + wr * 64 + fr, col0 = u.pn * BM + wc * 32 + 4 * fq;
#pragma unroll
        for (int ai = 0; ai < 2; ++ai)
#pragma unroll
            for (int m = 0; m < 4; ++m) { float* rowp = C + (size_t)(row0 + ai * HALF + m * 16) * ldc + col0;
#pragma unroll
                for (int bj = 0; bj < 2; ++bj)
#pragma unroll
                    for (int n = 0; n < 2; ++n) *(f32x4*)(rowp + bj * HALF + n * 16) = acc[ai][bj][m][n]; }
    }
};
__device__ __forceinline__ float silu_mul(float g, float u) { return g * u * __builtin_amdgcn_rcpf(1.0f + __builtin_amdgcn_exp2f(g * -1.4426950408889634f)); }
struct EpiSwiGLU {
    static constexpr bool PERM = true, AFTER_DRAIN = false;
    bf16_t* O; int ldc;
    __device__ __forceinline__ void operator()(const f32x4 (&acc)[2][2][4][2], const Unit& u, int wr, int wc, int fr, int fq) const {
        const int row0 = u.pm * BM + wr * 64 + fr, col0 = u.pn * HALF + wc * 32 + 8 * fq;
#pragma unroll
        for (int ai = 0; ai < 2; ++ai)
#pragma unroll
            for (int m = 0; m < 4; ++m) { bf16_t* rowp = O + (size_t)(row0 + ai * HALF + m * 16) * ldc + col0;
                const f32x4 g0 = acc[ai][0][m][0], g1 = acc[ai][0][m][1], u0 = acc[ai][1][m][0], u1 = acc[ai][1][m][1];
                u32x4 w; w.x = cvt_pk_bf16(silu_mul(g0[0], u0[0]), silu_mul(g0[1], u0[1])); w.y = cvt_pk_bf16(silu_mul(g0[2], u0[2]), silu_mul(g0[3], u0[3]));
                w.z = cvt_pk_bf16(silu_mul(g1[0], u1[0]), silu_mul(g1[1], u1[1])); w.w = cvt_pk_bf16(silu_mul(g1[2], u1[2]), silu_mul(g1[3], u1[3]));
                *(u32x4*)rowp = w; }
    }
};

template <class Epi, class Sched, bool ALIGN_EPI = false, bool SP2 = false>
__device__ __forceinline__ void gemm_phase(PG8_LAS unsigned char* lds, const Gemm g, const Sched& S, const Epi& E) {
    int tid = threadIdx.x; asm volatile("" : "+v"(tid));
    const int wid = __builtin_amdgcn_readfirstlane(tid >> 6), lane = tid & 63, wr = wid >> 2, wc = wid & 3, fr = lane & 15, fq = lane >> 4;
    const int K = g.K, nt = K / BK;
    unsigned voffA[2], voffB[2];
#pragma unroll
    for (int i = 0; i < 2; ++i) { int R, C; stage_rc(tid * 16 + i * 8192, R, C); const int Rb = Epi::PERM ? ((R & ~31) + perm32(R & 31)) : R;
        voffA[i] = (unsigned)(R * K + C) * 2u; voffB[i] = (unsigned)(Rb * K + C) * 2u; }
    const size_t kstep = (size_t)(BK * 2);
    const size_t hstep = (size_t)HALF * K * 2;
    const size_t tstep = 2 * hstep;
    const unsigned ldsw = (unsigned)wid * 1024u;
    const int aoff = lds_byte(wr * 64 + fr, fq * 8), boff = lds_byte(wc * 32 + fr, fq * 8);
#define PG8_SA(b, h) (((b) * 2 + (h)) * HTB)
#define PG8_SB(b, h) ((4 + (b) * 2 + (h)) * HTB)
#define PG8_STAGE(bufoff, gbase, voff) do { _Pragma("unroll") for (int _i = 0; _i < 2; ++_i) \
        __builtin_amdgcn_global_load_lds((const unsigned*)((const char*)(gbase) + (voff)[_i]), (PG8_LAS unsigned*)(lds + (bufoff) + ldsw + _i * 8192), 16, 0, 0); } while (0)
#define PG8_LDA(dst, b, h) do { _Pragma("unroll") for (int m = 0; m < 4; ++m) _Pragma("unroll") for (int k = 0; k < 2; ++k) dst[m][k] = *(const PG8_LAS bf16x8*)(lds + PG8_SA(b, h) + aoff + m * 2048 + k * 1024); } while (0)
#define PG8_LDB(dst, b, h) do { _Pragma("unroll") for (int n = 0; n < 2; ++n) _Pragma("unroll") for (int k = 0; k < 2; ++k) dst[n][k] = *(const PG8_LAS bf16x8*)(lds + PG8_SB(b, h) + boff + n * 2048 + k * 1024); } while (0)
#define PG8_MMA(ai, bj, At, Bt) do { __builtin_amdgcn_s_setprio(1); _Pragma("unroll") for (int m = 0; m < 4; ++m) _Pragma("unroll") for (int n = 0; n < 2; ++n) _Pragma("unroll") for (int k = 0; k < 2; ++k) \
        acc[ai][bj][m][n] = __builtin_amdgcn_mfma_f32_16x16x32_bf16(Bt[n][k], At[m][k], acc[ai][bj][m][n], 0, 0, 0); __builtin_amdgcn_s_setprio(0); } while (0)
#define PG8_WAIT_V(n) asm volatile("s_waitcnt vmcnt(" #n ")" ::: "memory")
#define PG8_WAIT_L(n) asm volatile("s_waitcnt lgkmcnt(" #n ")" ::: "memory")
#define PG8_BAR __builtin_amdgcn_s_barrier()
#define PG8_SCHED __builtin_amdgcn_sched_barrier(0)
    Unit cur, nxt; int ui = 0;
    if (!S.next(0, cur)) return;
    f32x4 acc[2][2][4][2];
#pragma unroll
    for (int a = 0; a < 2; ++a)
#pragma unroll
        for (int b = 0; b < 2; ++b)
#pragma unroll
            for (int m = 0; m < 4; ++m)
#pragma unroll
                for (int n = 0; n < 2; ++n) acc[a][b][m][n] = (f32x4){0.f, 0.f, 0.f, 0.f};
    bf16x8 At[4][2], B0[2][2], B1[2][2];
    const char* cA = (const char*)g.A + (size_t)cur.pm * tstep; const char* cB = (const char*)g.Bt + (size_t)cur.pn * tstep;
    S.a_ready(cur);
    if constexpr (SP2) {
        PG8_STAGE(PG8_SB(0, 0), cB, voffB); PG8_STAGE(PG8_SB(0, 1), cB + hstep, voffB); PG8_STAGE(PG8_SA(0, 0), cA, voffA); PG8_STAGE(PG8_SA(0, 1), cA + hstep, voffA);
        if (wr == 1) PG8_BAR;
        PG8_WAIT_V(2); PG8_BAR;
        PG8_STAGE(PG8_SB(1, 0), cB + kstep, voffB); PG8_STAGE(PG8_SA(1, 0), cA + kstep, voffA); PG8_STAGE(PG8_SB(1, 1), cB + hstep + kstep, voffB);
        PG8_WAIT_V(6); PG8_BAR;
    } else {
        PG8_STAGE(PG8_SB(0, 0), cB, voffB); PG8_STAGE(PG8_SA(0, 0), cA, voffA); PG8_STAGE(PG8_SB(0, 1), cB + hstep, voffB); PG8_STAGE(PG8_SA(0, 1), cA + hstep, voffA);
        if (wr == 1) PG8_BAR;
        PG8_WAIT_V(4); PG8_BAR;
        PG8_STAGE(PG8_SB(1, 0), cB + kstep, voffB); PG8_STAGE(PG8_SA(1, 0), cA + kstep, voffA); PG8_STAGE(PG8_SB(1, 1), cB + hstep + kstep, voffB);
        PG8_WAIT_V(6); PG8_BAR;
    }
    for (;;) {
        const bool has_next = S.next(ui + 1, nxt);
        const char* nA = has_next ? (const char*)g.A + (size_t)nxt.pm * tstep : cA; const char* nB = has_next ? (const char*)g.Bt + (size_t)nxt.pn * tstep : cB;
        for (int t = 0; t < nt; t += 2) {
            const bool last = (t == nt - 2);
            const char* a1 = cA + (size_t)(t + 1) * kstep;
            const char* a2 = last ? nA : cA + (size_t)(t + 2) * kstep; const char* b2 = last ? nB : cB + (size_t)(t + 2) * kstep;
            const char* a3 = a2 + kstep; const char* b3 = b2 + kstep;
            if (last && has_next) S.a_ready(nxt);
            if constexpr (SP2) {
            PG8_LDB(B0, 0, 0); PG8_LDB(B1, 0, 1); PG8_SCHED; PG8_LDA(At, 0, 0); PG8_STAGE(PG8_SA(1, 1), a1 + hstep, voffA);
            PG8_WAIT_V(8); PG8_WAIT_L(0); PG8_BAR; PG8_MMA(0, 0, At, B0); PG8_MMA(0, 1, At, B1); PG8_BAR; PG8_SCHED;
            PG8_LDA(At, 0, 1); PG8_STAGE(PG8_SB(0, 0), b2, voffB); PG8_STAGE(PG8_SB(0, 1), b2 + hstep, voffB); PG8_STAGE(PG8_SA(0, 0), a2, voffA);
            PG8_WAIT_V(8); PG8_WAIT_L(0); PG8_BAR; PG8_MMA(1, 0, At, B0); PG8_MMA(1, 1, At, B1); PG8_BAR; PG8_SCHED;
            PG8_LDB(B0, 1, 0); PG8_LDB(B1, 1, 1); PG8_SCHED; PG8_LDA(At, 1, 0); PG8_STAGE(PG8_SA(0, 1), a2 + hstep, voffA);
            PG8_WAIT_V(8); PG8_WAIT_L(0); PG8_BAR; PG8_MMA(0, 0, At, B0); PG8_MMA(0, 1, At, B1); PG8_BAR; PG8_SCHED;
            PG8_LDA(At, 1, 1); PG8_STAGE(PG8_SB(1, 0), b3, voffB); PG8_STAGE(PG8_SB(1, 1), b3 + hstep, voffB); PG8_STAGE(PG8_SA(1, 0), a3, voffA);
            PG8_WAIT_V(8); PG8_WAIT_L(0); PG8_BAR; PG8_MMA(1, 0, At, B0); PG8_MMA(1, 1, At, B1); PG8_BAR; PG8_SCHED;
            } else {
            PG8_LDB(B0, 0, 0); PG8_SCHED; PG8_LDA(At, 0, 0); PG8_STAGE(PG8_SA(1, 1), a1 + hstep, voffA);
            PG8_WAIT_L(8); PG8_BAR; PG8_WAIT_L(0); PG8_MMA(0, 0, At, B0); PG8_BAR; PG8_SCHED;
            PG8_LDB(B1, 0, 1); PG8_STAGE(PG8_SB(0, 0), b2, voffB);
            PG8_BAR; PG8_WAIT_L(0); PG8_MMA(0, 1, At, B1); PG8_BAR;
            PG8_LDA(At, 0, 1); PG8_STAGE(PG8_SA(0, 0), a2, voffA);
            PG8_BAR; PG8_WAIT_L(0); PG8_MMA(1, 0, At, B0); PG8_BAR; PG8_SCHED;
            PG8_STAGE(PG8_SB(0, 1), b2 + hstep, voffB);
            PG8_WAIT_V(6); PG8_BAR; PG8_MMA(1, 1, At, B1); PG8_BAR;
            PG8_LDB(B0, 1, 0); PG8_SCHED; PG8_LDA(At, 1, 0); PG8_STAGE(PG8_SA(0, 1), a2 + hstep, voffA);
            PG8_WAIT_L(8); PG8_BAR; PG8_WAIT_L(0); PG8_MMA(0, 0, At, B0); PG8_BAR; PG8_SCHED;
            PG8_LDB(B1, 1, 1); PG8_STAGE(PG8_SB(1, 0), b3, voffB);
            PG8_BAR; PG8_WAIT_L(0); PG8_MMA(0, 1, At, B1); PG8_BAR;
            PG8_LDA(At, 1, 1); PG8_STAGE(PG8_SA(1, 0), a3, voffA);
            PG8_BAR; PG8_WAIT_L(0); PG8_MMA(1, 0, At, B0); PG8_BAR; PG8_SCHED;
            PG8_STAGE(PG8_SB(1, 1), b3 + hstep, voffB);
            PG8_WAIT_V(6); PG8_BAR; PG8_MMA(1, 1, At, B1); PG8_BAR;
            }
        }
        if constexpr (ALIGN_EPI) { if (wr == 0) PG8_BAR; }
        if constexpr (!Epi::AFTER_DRAIN) { E(acc, cur, wr, wc, fr, fq); S.done(cur); }
        if (!has_next) break;
#pragma unroll
        for (int a = 0; a < 2; ++a)
#pragma unroll
            for (int b = 0; b < 2; ++b)
#pragma unroll
                for (int m = 0; m < 4; ++m)
#pragma unroll
                    for (int n = 0; n < 2; ++n) acc[a][b][m][n] = (f32x4){0.f, 0.f, 0.f, 0.f};
        cur = nxt; cA = nA; cB = nB; ++ui;
        if constexpr (ALIGN_EPI) { if (wr == 1) PG8_BAR; }
    }
    PG8_WAIT_V(0);
    if constexpr (!ALIGN_EPI) { if (wr == 0) PG8_BAR; }
    PG8_BAR;
    if constexpr (Epi::AFTER_DRAIN) { E.fused(acc, cur, wr, wc, fr, fq, lds, wid, lane); S.done(cur); }
#undef PG8_SA
#undef PG8_SB
#undef PG8_STAGE
#undef PG8_LDA
#undef PG8_LDB
#undef PG8_MMA
#undef PG8_WAIT_V
#undef PG8_WAIT_L
#undef PG8_BAR
#undef PG8_SCHED
}
}
namespace att {
#define ALDS __attribute__((address_space(3)))
using bf16 = __hip_bfloat16;
using bf16x8 = __attribute__((ext_vector_type(8))) short;
using s16x4  = __attribute__((ext_vector_type(4))) short;
using f32x16 = __attribute__((ext_vector_type(16))) float;
using u32x4  = __attribute__((ext_vector_type(4))) unsigned;
constexpr int LDP = 9216;
constexpr int LDO = 4096;
constexpr int META_ROW = 24576;
constexpr int SHM_V = 16384, SHM_K = 16384;
constexpr int OFF_WS = 65536, OFF_TAB = 65536 + 2048, ATT_LDS = OFF_TAB + 15 * 128 * 4;
constexpr float LOG2E = 1.4426950408889634f;
constexpr float THRX = 8.0f;
constexpr float NEG = -1e30f;
#define KSWZ(row, colB) ((row) * 256 + ((colB) ^ (((row) & 7) << 4)))
#define SBAR() __builtin_amdgcn_sched_barrier(0)
__device__ __forceinline__ int crow(int r, int hi) { return (r & 3) + 8 * (r >> 2) + 4 * hi; }
__device__ __forceinline__ unsigned cvtpk(float lo, float hi) { unsigned r; asm volatile("v_cvt_pk_bf16_f32 %0, %1, %2" : "=v"(r) : "v"(lo), "v"(hi)); return r; }

struct UnitP { int seqbase, T, head, blk; };

__device__ __forceinline__ void partialSM(f32x16& p0, f32x16& p1, float& m_reg, float& alpha) {
  float pmax = p0[0];
#pragma unroll
  for (int r = 1; r < 16; ++r) pmax = fmaxf(pmax, p0[r]);
#pragma unroll
  for (int r = 0; r < 16; ++r) pmax = fmaxf(pmax, p1[r]);
  { auto rr = __builtin_amdgcn_permlane32_swap(__float_as_uint(pmax), __float_as_uint(pmax), false, false);
    pmax = fmaxf(__uint_as_float(rr[0]), __uint_as_float(rr[1])); }
  float mn;
  if (__builtin_expect(__all(pmax - m_reg <= THRX), 1)) { mn = m_reg; alpha = 1.f; }
  else { mn = fmaxf(m_reg, pmax); alpha = __builtin_amdgcn_exp2f(m_reg - mn); m_reg = mn; }
#pragma unroll
  for (int r = 0; r < 16; ++r) p0[r] = p0[r] - mn;
#pragma unroll
  for (int r = 0; r < 16; ++r) p1[r] = p1[r] - mn;
#pragma unroll
  for (int r = 0; r < 16; ++r) p0[r] = __builtin_amdgcn_exp2f(p0[r]);
}
__device__ __forceinline__ void finishSM(f32x16& p0, f32x16& p1, float alpha, float& l_reg, bf16x8& pa0, bf16x8& pa1, bf16x8& pa2, bf16x8& pa3) {
#pragma unroll
  for (int r = 0; r < 16; ++r) p1[r] = __builtin_amdgcn_exp2f(p1[r]);
  float ps = 0;
#pragma unroll
  for (int r = 0; r < 16; ++r) ps += p0[r];
#pragma unroll
  for (int r = 0; r < 16; ++r) ps += p1[r];
  { auto rr = __builtin_amdgcn_permlane32_swap(__float_as_uint(ps), __float_as_uint(ps), false, false);
    ps = __uint_as_float(rr[0]) + __uint_as_float(rr[1]); }
  l_reg = l_reg * alpha + ps;
#define PK4(P, BASE, OUT) do { unsigned a0 = cvtpk(P[BASE + 0], P[BASE + 1]), a1 = cvtpk(P[BASE + 2], P[BASE + 3]);   \
    unsigned b0 = cvtpk(P[BASE + 4], P[BASE + 5]), b1 = cvtpk(P[BASE + 6], P[BASE + 7]);                              \
    auto r0 = __builtin_amdgcn_permlane32_swap(a0, b0, false, false); auto r1 = __builtin_amdgcn_permlane32_swap(a1, b1, false, false); \
    u32x4 w = {r0[0], r1[0], r0[1], r1[1]}; OUT = *reinterpret_cast<bf16x8*>(&w); } while (0)
  PK4(p0, 0, pa0); PK4(p0, 8, pa1); PK4(p1, 0, pa2); PK4(p1, 8, pa3);
#undef PK4
}
__device__ __forceinline__ void qkt(f32x16& p0, f32x16& p1, const ALDS char* Ks, const bf16x8* qr, int r32, int hi) {
  p0 = f32x16{}; p1 = f32x16{};
#pragma unroll
  for (int d0 = 0; d0 < 8; ++d0) { int cb = (d0 * 16 + hi * 8) * 2;
    bf16x8 b0 = *(const ALDS bf16x8*)(Ks + KSWZ(r32, cb));
    bf16x8 b1 = *(const ALDS bf16x8*)(Ks + KSWZ(32 + r32, cb));
    p0 = __builtin_amdgcn_mfma_f32_32x32x16_bf16(b0, qr[d0], p0, 0, 0, 0);
    p1 = __builtin_amdgcn_mfma_f32_32x32x16_bf16(b1, qr[d0], p1, 0, 0, 0); }
}
__device__ __forceinline__ int v_st(int k, int c) { const int kk = (k & ~0xC) | ((k & 4) << 1) | ((k & 8) >> 1); return ((kk >> 3) * 4 + (c >> 5)) * 512 + ((kk & 7) * 32 + (c & 31)) * 2; }
__device__ __forceinline__ int v_rd_base(int lane) { return ((lane & 3) << 3) | (((lane >> 2) & 3) << 6) | (((lane >> 4) & 1) << 5) | (((lane >> 5) & 1) << 8); }
constexpr int v_rd_off(int d0, int ks, int half) { return d0 * 512 + ks * 4096 + half * 2048; }
template <int OFF> __device__ __forceinline__ s16x4 tr_read(int vb) {
  s16x4 r; asm volatile("ds_read_b64_tr_b16 %0, %1 offset:%2" : "=&v"(r) : "v"(vb), "i"(OFF) : "memory"); return r;
}
template <int D0> __device__ __forceinline__ void pv_one(f32x16& od, int vb, bf16x8 pa0, bf16x8 pa1, bf16x8 pa2, bf16x8 pa3) {
  const s16x4 l0 = tr_read<v_rd_off(D0, 0, 0)>(vb), h0 = tr_read<v_rd_off(D0, 0, 1)>(vb), l1 = tr_read<v_rd_off(D0, 1, 0)>(vb), h1 = tr_read<v_rd_off(D0, 1, 1)>(vb);
  const s16x4 l2 = tr_read<v_rd_off(D0, 2, 0)>(vb), h2 = tr_read<v_rd_off(D0, 2, 1)>(vb), l3 = tr_read<v_rd_off(D0, 3, 0)>(vb), h3 = tr_read<v_rd_off(D0, 3, 1)>(vb);
  asm volatile("s_waitcnt lgkmcnt(0)" ::: "memory"); SBAR();
#define PK(L, H) (bf16x8){L[0], L[1], L[2], L[3], H[0], H[1], H[2], H[3]}
  od = __builtin_amdgcn_mfma_f32_32x32x16_bf16(pa0, PK(l0, h0), od, 0, 0, 0);
  od = __builtin_amdgcn_mfma_f32_32x32x16_bf16(pa1, PK(l1, h1), od, 0, 0, 0);
  od = __builtin_amdgcn_mfma_f32_32x32x16_bf16(pa2, PK(l2, h2), od, 0, 0, 0);
  od = __builtin_amdgcn_mfma_f32_32x32x16_bf16(pa3, PK(l3, h3), od, 0, 0, 0);
#undef PK
}
__device__ __forceinline__ void pv_d0(f32x16* o, int vb, bf16x8 pa0, bf16x8 pa1, bf16x8 pa2, bf16x8 pa3) {
  pv_one<0>(o[0], vb, pa0, pa1, pa2, pa3); pv_one<1>(o[1], vb, pa0, pa1, pa2, pa3); pv_one<2>(o[2], vb, pa0, pa1, pa2, pa3); pv_one<3>(o[3], vb, pa0, pa1, pa2, pa3);
}
__device__ __forceinline__ float bf_lo(unsigned w) { return __uint_as_float(w << 16); }
__device__ __forceinline__ float bf_hi(unsigned w) { return __uint_as_float(w & 0xffff0000u); }

template <int KIND> __device__ __forceinline__ int tile_row(const UnitP& u, int j) {
  if (j == 0) return META_ROW;
  if (KIND == 0) { const int rows = u.T >> 6; int rs0 = 4 * u.blk - 4; rs0 = rs0 < 0 ? 0 : (rs0 > rows - 8 ? rows - 8 : rs0);
    int kr = rs0 + j - 1; kr = kr > rows - 1 ? rows - 1 : kr; return u.seqbase + 64 * kr; }
  else { int ks = 64 * u.blk + 64 * (j - 3); ks = ks < 0 ? 0 : (ks > u.T - 64 ? u.T - 64 : ks); return u.seqbase + ks; }
}

template <int KIND>
__device__ __forceinline__ void attn_unit(const UnitP u, const bf16* __restrict__ P, bf16* __restrict__ O, float* __restrict__ ssq,
                                          const float* __restrict__ rpb, const float* __restrict__ sinkp, ALDS char* lds) {
  constexpr int NT = (KIND == 0) ? 12 : 6;
  int tid = threadIdx.x; asm volatile("" : "+v"(tid));
  const int wid = __builtin_amdgcn_readfirstlane(tid >> 6), lane = tid & 63, r32 = lane & 31, hi = lane >> 5;
  ALDS char* V_lds = lds; ALDS char* K_lds = lds + 2 * SHM_V;
  ALDS float* wsf = (ALDS float*)(lds + OFF_WS) + wid * 64; ALDS float* li_l = wsf; ALDS float* al_l = wsf + 32;
  ALDS float* tab = (ALDS float*)(lds + OFF_TAB);
  int qrow, qcol, kcol, vcol, ocol, sidx;
  int Rq = 0, qc = 0, rsR = 0, rs0 = 0, rows = 0, ucol = 0, tq = 0; float slope2 = 0.f, sink2 = 0.f;
  if (KIND == 0) {
    rows = u.T >> 6; Rq = 4 * u.blk + (wid >> 1); qc = 32 * (wid & 1) + r32;
    qrow = u.seqbase + 64 * Rq + qc; qcol = 128 * u.head; kcol = 2048 + 128 * u.head; vcol = 4096 + 128 * u.head; ocol = 128 * u.head; sidx = u.head;
    rs0 = 4 * u.blk - 4; rs0 = rs0 < 0 ? 0 : (rs0 > rows - 8 ? rows - 8 : rs0);
    rsR = Rq - 4; rsR = rsR < 0 ? 0 : (rsR > rows - 8 ? rows - 8 : rsR);
    int cs = qc - 8; cs = cs < 0 ? 0 : (cs > 48 ? 48 : cs); ucol = 4 * hi - cs;
  } else {
    const int hq = 4 * u.head + (wid >> 1); tq = 64 * u.blk + 32 * (wid & 1) + r32;
    qrow = u.seqbase + tq; qcol = 6144 + 128 * hq; kcol = 8192 + 128 * u.head; vcol = 8704 + 128 * u.head; ocol = 2048 + 128 * hq; sidx = 16 + hq;
    slope2 = __builtin_amdgcn_exp2f(-0.5f * (float)(hq + 1)) * LOG2E; sink2 = sinkp[hq] * LOG2E;
  }
  const int orow0 = qrow - r32;
  if (KIND == 0) {
    for (int idx = tid; idx < 15 * 128; idx += 512) { const int ir = idx >> 7, e = (idx & 127) - 48;
      tab[idx] = (e >= 0 && e <= 30) ? rpb[u.head * 465 + ir * 31 + e] * LOG2E : 0.f; }
  } else {
    for (int idx = tid; idx < 4 * 384; idx += 512) { const int hh = idx / 384, i = idx - hh * 384; int d = 191 - i; d = d < 0 ? -d : d;
      tab[idx] = (d <= 128) ? -(__builtin_amdgcn_exp2f(-0.5f * (float)(4 * u.head + hh + 1)) * LOG2E) * (float)d : NEG; }
  }
  float m_reg = -1e30f, l_reg = 0; f32x16 o[4] = {}; bf16x8 qr[8];
  { const bf16* Qw = P + (size_t)qrow * LDP + qcol + hi * 8;
#pragma unroll
    for (int d0 = 0; d0 < 8; ++d0) qr[d0] = *reinterpret_cast<const bf16x8*>(Qw + d0 * 16); }
  const int sr = tid >> 4, sc = (tid & 15) * 8, vst0 = v_st(sr, sc), vst1 = v_st(32 + sr, sc);
  const int vb0 = (int)(unsigned)(__SIZE_TYPE__)V_lds + v_rd_base(lane);
  bf16x8 vs0, vs1, ks0, ks1;
#define SLOAD(j) do { const bf16* tb_ = P + (size_t)(tile_row<KIND>(u, (j)) + sr) * LDP + sc; \
    vs0 = *reinterpret_cast<const bf16x8*>(tb_ + vcol); vs1 = *reinterpret_cast<const bf16x8*>(tb_ + (size_t)32 * LDP + vcol); \
    ks0 = *reinterpret_cast<const bf16x8*>(tb_ + kcol); ks1 = *reinterpret_cast<const bf16x8*>(tb_ + (size_t)32 * LDP + kcol); } while (0)
#define SWRITE(b) do { *(ALDS bf16x8*)(V_lds + (b) * SHM_V + vst0) = vs0; *(ALDS bf16x8*)(V_lds + (b) * SHM_V + vst1) = vs1; const int kc_ = sc * 2; \
    *(ALDS bf16x8*)(K_lds + (b) * SHM_K + KSWZ(sr, kc_)) = ks0; *(ALDS bf16x8*)(K_lds + (b) * SHM_K + KSWZ(32 + sr, kc_)) = ks1; } while (0)
  f32x16 p0, p1; bf16x8 pa0, pa1, pa2, pa3;
  SLOAD(0); SWRITE(0); SLOAD(1); __syncthreads();
#pragma unroll 1
  for (int j = 0; j < NT; ++j) {
    const int b = j & 1;
    if (j + 1 < NT) { SWRITE(b ^ 1); if (j + 2 < NT) SLOAD(j + 2); }
    SBAR();
    qkt(p0, p1, K_lds + b * SHM_K, qr, r32, hi);
    if (j == 0) {
#pragma unroll
      for (int r = 0; r < 8; ++r) { if (KIND == 1) { const int md_ = 16 + tq - crow(r, hi); p0[r] = p0[r] - slope2 * (float)(md_ > 128 ? 128 : md_); } }
#pragma unroll
      for (int r = 8; r < 16; ++r) p0[r] = NEG;
#pragma unroll
      for (int r = 0; r < 16; ++r) p1[r] = NEG;
    } else if (KIND == 0) {
      const int kr_ = rs0 + j - 1; const bool wok_ = (kr_ < rows) && (kr_ >= rsR) && (kr_ < rsR + 8);
      if (wok_) { const ALDS float* tb_ = tab + (kr_ - Rq + 7) * 128 + (63 - qc + 4 * hi);
#pragma unroll
        for (int r = 0; r < 16; ++r) { const int kc0_ = (r & 3) + 8 * (r >> 2);
          p0[r] = ((unsigned)(kc0_ + ucol) < 16u) ? p0[r] + tb_[kc0_] : NEG;
          p1[r] = ((unsigned)(kc0_ + 32 + ucol) < 16u) ? p1[r] + tb_[kc0_ + 32] : NEG; } }
      else {
#pragma unroll
        for (int r = 0; r < 16; ++r) { p0[r] = NEG; p1[r] = NEG; } }
    } else {
      const int ks_ = 64 * u.blk + 64 * (j - 3);
      if (ks_ >= 0 && ks_ < u.T) { const ALDS float* tb_ = tab + (wid >> 1) * 384 + (191 - (tq - ks_ - 4 * hi));
#pragma unroll
        for (int r = 0; r < 16; ++r) { const int kc0_ = (r & 3) + 8 * (r >> 2);
          p0[r] = p0[r] + tb_[kc0_];
          p1[r] = p1[r] + tb_[kc0_ + 32]; } }
      else {
#pragma unroll
        for (int r = 0; r < 16; ++r) { p0[r] = NEG; p1[r] = NEG; } }
    }
    float alpha;
    { float pmax = p0[0];
#pragma unroll
      for (int r = 1; r < 16; ++r) pmax = fmaxf(pmax, p0[r]);
#pragma unroll
      for (int r = 0; r < 16; ++r) pmax = fmaxf(pmax, p1[r]);
      { auto rr = __builtin_amdgcn_permlane32_swap(__float_as_uint(pmax), __float_as_uint(pmax), false, false);
        pmax = fmaxf(__uint_as_float(rr[0]), __uint_as_float(rr[1])); }
      float mn;
      if (__all(pmax - m_reg <= THRX)) { mn = m_reg; alpha = 1.f; }
      else { mn = fmaxf(m_reg, pmax); alpha = __builtin_amdgcn_exp2f(m_reg - mn); m_reg = mn; }
      float ps = 0.f;
#pragma unroll
      for (int r = 0; r < 16; ++r) { p0[r] = __builtin_amdgcn_exp2f(p0[r] - mn); ps += p0[r]; }
#pragma unroll
      for (int r = 0; r < 16; ++r) { p1[r] = __builtin_amdgcn_exp2f(p1[r] - mn); ps += p1[r]; }
      { auto rr = __builtin_amdgcn_permlane32_swap(__float_as_uint(ps), __float_as_uint(ps), false, false);
        ps = __uint_as_float(rr[0]) + __uint_as_float(rr[1]); }
      l_reg = l_reg * alpha + ps; }
#define PK4(PP, BASE, OUT) do { unsigned a0 = cvtpk(PP[BASE + 0], PP[BASE + 1]), a1 = cvtpk(PP[BASE + 2], PP[BASE + 3]);   \
    unsigned b0 = cvtpk(PP[BASE + 4], PP[BASE + 5]), b1 = cvtpk(PP[BASE + 6], PP[BASE + 7]);                              \
    auto r0 = __builtin_amdgcn_permlane32_swap(a0, b0, false, false); auto r1 = __builtin_amdgcn_permlane32_swap(a1, b1, false, false); \
    u32x4 w = {r0[0], r1[0], r0[1], r1[1]}; OUT = *reinterpret_cast<bf16x8*>(&w); } while (0)
    PK4(p0, 0, pa0); PK4(p0, 8, pa1); PK4(p1, 0, pa2); PK4(p1, 8, pa3);
#undef PK4
    if (__any(alpha < 1.f)) { if (hi == 0) al_l[r32] = alpha; asm volatile("s_waitcnt lgkmcnt(0)" ::: "memory");
#pragma unroll
      for (int r = 0; r < 16; ++r) { const float a_ = al_l[crow(r, hi)];
#pragma unroll
        for (int d = 0; d < 4; ++d) o[d][r] *= a_; } }
    SBAR();
    pv_d0(o, vb0 + b * SHM_V, pa0, pa1, pa2, pa3);
    __syncthreads();
  }
  if (KIND == 1) l_reg += __builtin_amdgcn_exp2f(sink2 - m_reg);
  if (hi == 0) li_l[r32] = l_reg; asm volatile("s_waitcnt lgkmcnt(0)" ::: "memory");
  { ALDS unsigned short* stg = (ALDS unsigned short*)(lds + wid * 8192);
#pragma unroll
    for (int r = 0; r < 16; ++r) { const int orow = crow(r, hi); const float rl = __builtin_amdgcn_rcpf(li_l[orow]);
#pragma unroll
      for (int d0 = 0; d0 < 4; ++d0) stg[orow * 128 + d0 * 32 + r32] = (unsigned short)(cvtpk(o[d0][r] * rl, 0.f) & 0xffffu); }
    asm volatile("s_waitcnt lgkmcnt(0)" ::: "memory");
    const int row = lane >> 1, half = lane & 1; float ss = 0.f;
    bf16* og = O + (size_t)(orow0 + row) * LDO + ocol + half * 64;
#pragma unroll
    for (int i = 0; i < 8; ++i) { const u32x4 v = *(const ALDS u32x4*)(stg + row * 128 + half * 64 + i * 8);
      ss += bf_lo(v.x) * bf_lo(v.x) + bf_hi(v.x) * bf_hi(v.x) + bf_lo(v.y) * bf_lo(v.y) + bf_hi(v.y) * bf_hi(v.y)
          + bf_lo(v.z) * bf_lo(v.z) + bf_hi(v.z) * bf_hi(v.z) + bf_lo(v.w) * bf_lo(v.w) + bf_hi(v.w) * bf_hi(v.w);
      *(u32x4*)(og + i * 8) = v; }
    ss += __shfl_xor(ss, 1);
    if (half == 0) ssq[(size_t)(orow0 + row) * 32 + sidx] = ss; }
  __syncthreads();
#undef SLOAD
#undef SWRITE
}
#undef KSWZ
#undef SBAR
}

#define GAS __attribute__((address_space(1)))
#define LAS __attribute__((address_space(3)))
typedef unsigned short bf16;
typedef unsigned v4u __attribute__((ext_vector_type(4)));
typedef float f32x4 __attribute__((ext_vector_type(4)));
typedef short bf16x8 __attribute__((ext_vector_type(8)));
typedef GAS unsigned gu32;
typedef GAS unsigned long long gu64;
#define RLX_AGENT __ATOMIC_RELAXED, __HIP_MEMORY_SCOPE_AGENT
#define LDS_WAIT() asm volatile("s_waitcnt lgkmcnt(0)" ::: "memory")
#define VM_WAIT() asm volatile("s_waitcnt vmcnt(0)" ::: "memory")
__device__ __forceinline__ unsigned long long rt() { return __builtin_amdgcn_s_memrealtime(); }
__device__ __forceinline__ unsigned f2bf(float f) { unsigned u = __builtin_bit_cast(unsigned, f); return (u + 0x7fffu + ((u >> 16) & 1u)) >> 16; }
__device__ __forceinline__ unsigned pk2(float lo, float hi) { return f2bf(lo) | (f2bf(hi) << 16); }

#define XB_TMO      128
#define XB_XCNT(j)  (256  + 64 * (j))
#define XB_XSUB(j)  (1280 + 64 * (j))
#define XB_XGEN(j)  (2304 + 64 * (j))
#define XB_TOP      3328
#define XB_TOPGEN   3392
#define XCD_BAR_WORDS 3456
#define XB_SPIN_CAP (1u << 18)

__device__ __forceinline__ unsigned xb_ld(unsigned* p)              { return __hip_atomic_load(p, __ATOMIC_RELAXED, __HIP_MEMORY_SCOPE_AGENT); }
__device__ __forceinline__ unsigned xb_add(unsigned* p, unsigned v) { return __hip_atomic_fetch_add(p, v, __ATOMIC_RELAXED, __HIP_MEMORY_SCOPE_AGENT); }
__device__ __forceinline__ unsigned xb_xcc_id() { return (unsigned)__builtin_amdgcn_s_getreg((3 << 11) | 20) & 0xFu; }
#define XB_SPIN(cond, bar) do { unsigned _sp = 0; while (cond) { __builtin_amdgcn_s_sleep(1); \
    if ((++_sp & 255u) == 0u) { if (xb_ld(&(bar)[XB_TMO])) break; if (_sp > XB_SPIN_CAP) { atomicAdd(&(bar)[XB_TMO], 1u); break; } } } } while (0)

struct XcdBarrier {
    unsigned* bar; unsigned x;
    volatile LAS unsigned* st;
};

__device__ __forceinline__ XcdBarrier xcd_barrier_post(unsigned* bar, volatile LAS unsigned* st) {
    XcdBarrier b; b.bar = bar; b.x = xb_xcc_id(); b.st = st;
    if (threadIdx.x == 0) (void)xb_add(&bar[XB_XCNT(b.x)], 1u);
    return b;
}
__device__ __forceinline__ void xcd_barrier_complete(unsigned* bar, unsigned x, unsigned& nloc, unsigned& nx) {
    const unsigned G = gridDim.x * gridDim.y * gridDim.z;
    unsigned sum, cnt, mine, sp = 0u;
    for (;;) {
        sum = 0u; cnt = 0u; mine = 0u;
#pragma unroll
        for (unsigned j = 0; j < 16; ++j) { const unsigned c = xb_ld(&bar[XB_XCNT(j)]); sum += c; cnt += (c > 0u) ? 1u : 0u; mine = (j == x) ? c : mine; }
        if (sum == G) break;
        __builtin_amdgcn_s_sleep(1);
        if ((++sp & 255u) == 0u) { if (xb_ld(&bar[XB_TMO])) break; if (sp > XB_SPIN_CAP) { atomicAdd(&bar[XB_TMO], 1u); break; } }
    }
    nloc = mine > 0u ? mine : 1u; nx = cnt > 0u ? cnt : 1u;
}

__device__ __forceinline__ void xcd_barrier(const XcdBarrier& b) {
    asm volatile("s_waitcnt vmcnt(0)" ::: "memory");
    __syncthreads();
    if (threadIdx.x == 0) {
        unsigned* bar = b.bar;
        __builtin_amdgcn_s_waitcnt(0);
        unsigned nloc = b.st[0], nx = b.st[1];
        if (nloc == 0u) { xcd_barrier_complete(bar, b.x, nloc, nx); b.st[0] = nloc; b.st[1] = nx; }
        const unsigned old = xb_add(&bar[XB_XSUB(b.x)], 1u);
        const unsigned gen = old / nloc;
        if (old + 1u == (gen + 1u) * nloc) {
            __builtin_amdgcn_fence(__ATOMIC_RELEASE, "agent");
            asm volatile("s_waitcnt vmcnt(0)" ::: "memory");
            const unsigned og = xb_add(&bar[XB_TOP], 1u);
            const unsigned tg = og / nx;
            if (og + 1u == (tg + 1u) * nx) xb_add(&bar[XB_TOPGEN], 1u);
            else XB_SPIN(xb_ld(&bar[XB_TOPGEN]) == tg, bar);
            __builtin_amdgcn_fence(__ATOMIC_ACQUIRE, "agent");
            xb_add(&bar[XB_XGEN(b.x)], 1u);
            asm volatile("s_waitcnt vmcnt(0)" ::: "memory");
        } else {
            XB_SPIN(xb_ld(&bar[XB_XGEN(b.x)]) == gen, bar);
            __builtin_amdgcn_fence(__ATOMIC_ACQUIRE, "agent");
            asm volatile("s_waitcnt vmcnt(0)" ::: "memory");
        }
    }
    __syncthreads();
}

constexpr int NWAVES = 8;
constexpr int DM = 4096, TP = 16384, TS = 4096, MREAL = 24576, NMETA = 16, MPAD = 24832;
constexpr int DIN = 9216, DFF = 11008, NGU = 2 * DFF;
constexpr float EPS = 1e-6f;
constexpr float QSCALE = 0.08838834764831845f * 1.4426950408889634f;

constexpr size_t MiB = 1u << 20;
constexpr size_t WS_CTL = 0, CTL_ZERO_BYTES = 1 * MiB;
constexpr size_t WS_SSQ = 1 * MiB;
constexpr size_t WS_WIN = 4 * MiB;
constexpr size_t WS_WOUT = WS_WIN + (size_t)DIN * DM * 2;
constexpr size_t WS_WGU = WS_WOUT + (size_t)DM * DM * 2;
constexpr size_t WS_WDN = WS_WGU + (size_t)NGU * DM * 2;
constexpr size_t WS_A = WS_WDN + (size_t)DM * DFF * 2;
constexpr size_t WS_B = WS_A + (size_t)MPAD * DM * 2;
constexpr size_t WS_END = WS_B + (size_t)MREAL * DFF * 2;
static_assert((size_t)MPAD * DIN * 2 <= (size_t)MREAL * DFF * 2, "proj fits the act region");
constexpr int CW_BAR = 4096;

constexpr int RING_OFF = 0, RING_BYTES = 131072;
constexpr int LDSCTL_OFF = RING_BYTES, MISC_OFF = LDSCTL_OFF + 320;
constexpr int LDS_BYTES = 147456;
static_assert(MISC_OFF + 128 <= LDS_BYTES && att::ATT_LDS <= RING_BYTES, "LDS map");

struct Frame {
    LAS unsigned char* lds;
    volatile LAS unsigned* MISC;
    gu32* ctl;
    int tid, lane, wave;
    int vcu, G;
};
__device__ __forceinline__ float wave_sum(float v) {
#pragma unroll
    for (int o = 1; o < 64; o <<= 1) v += __shfl_xor(v, o);
    return v;
}
__device__ __forceinline__ void p0_transpose_item(const float* __restrict__ W, int K, int N, bf16* __restrict__ WT, int k0, int n0, int dst_row0, float scale, LAS float* scr, int lane) {
#pragma unroll 8
    for (int i = 0; i < 32; ++i) { const int kk = 2 * i + (lane >> 5); scr[kk * 33 + (lane & 31)] = W[(size_t)(k0 + kk) * N + n0 + (lane & 31)]; }
    LDS_WAIT(); asm volatile("" ::: "memory");
    const int c = lane & 7;
#pragma unroll
    for (int j = 0; j < 4; ++j) { const int n = (lane >> 3) + 8 * j; const LAS float* s = scr + (8 * c) * 33 + n;
        v4u o; o.x = pk2(s[0 * 33] * scale, s[1 * 33] * scale); o.y = pk2(s[2 * 33] * scale, s[3 * 33] * scale); o.z = pk2(s[4 * 33] * scale, s[5 * 33] * scale); o.w = pk2(s[6 * 33] * scale, s[7 * 33] * scale);
        *(GAS v4u*)(WT + (size_t)(dst_row0 + n) * K + k0 + 8 * c) = o; }
    LDS_WAIT(); asm volatile("" ::: "memory");
}
__device__ __forceinline__ const float* x_row(const float* xp, const float* xs, const float* meta, int m) {
    return m < TP ? xp + (size_t)m * DM : (m < MREAL ? xs + (size_t)(m - TP) * DM : meta + (size_t)(m - MREAL) * DM);
}

struct Args { const float* in[16]; float* out; unsigned char* ws; };
__global__ void __launch_bounds__(NWAVES * 64, 2) enc_fwd(Args args) {
    extern __shared__ __attribute__((aligned(16))) unsigned char lds[];
    Frame F;
    F.lds = (LAS unsigned char*)lds;
    F.MISC = (volatile LAS unsigned*)(F.lds + MISC_OFF);
    F.tid = threadIdx.x; F.lane = F.tid & 63; F.wave = __builtin_amdgcn_readfirstlane(F.tid >> 6);
    F.G = gridDim.x; { const int bx = blockIdx.x; F.vcu = (F.G % 8 == 0) ? (bx % 8) * (F.G / 8) + bx / 8 : bx; }
    unsigned char* ws = args.ws;
    F.ctl = (gu32*)(ws + WS_CTL);
    const float* x_prompt = args.in[0]; const float* x_sample = args.in[1]; const float* meta = args.in[2];
    const float* w_in = args.in[3]; const float* w_out = args.in[4]; const float* rpb = args.in[5]; const float* sink = args.in[6];
    const float* g_na = args.in[7]; const float* g_sw = args.in[8]; const float* g_pre_mix = args.in[9]; const float* g_post_mix = args.in[10];
    const float* g_pre_ffn = args.in[11]; const float* g_post_ffn = args.in[12]; const float* w_gate = args.in[13]; const float* w_up = args.in[14]; const float* w_down = args.in[15];
    float* out = args.out;
    bf16* Win_t = (bf16*)(ws + WS_WIN); bf16* Wout_t = (bf16*)(ws + WS_WOUT); bf16* Wgu_t = (bf16*)(ws + WS_WGU); bf16* Wdn_t = (bf16*)(ws + WS_WDN);
    bf16* Abuf = (bf16*)(ws + WS_A); bf16* Bbuf = (bf16*)(ws + WS_B); float* ssq = (float*)(ws + WS_SSQ);
    for (int u = F.tid; u < (LDS_BYTES - LDSCTL_OFF) / 4; u += NWAVES * 64) ((LAS unsigned*)(F.lds + LDSCTL_OFF))[u] = 0u;
    __syncthreads();
    XcdBarrier bar = xcd_barrier_post((unsigned*)(F.ctl + CW_BAR), F.MISC + 8);
    const int gw = F.vcu * NWAVES + F.wave, NGW = F.G * NWAVES;

    {
        LAS float* scr = (LAS float*)(F.lds + RING_OFF + F.wave * 16384);
        constexpr int NB_IN = DIN / 32, NB_DM = DM / 32, NB_FF = DFF / 32;
        constexpr int I_IN = (DM / 64) * NB_IN, I_OUT = (DM / 64) * NB_DM, I_G = (DM / 64) * NB_FF, I_D = (DFF / 64) * NB_DM;
        constexpr int NITEMS = I_IN + I_OUT + 2 * I_G + I_D;
        for (int it = gw; it < NITEMS; it += NGW) {
            int r = it;
            if (r < I_IN) { const int kb = r / NB_IN, nb = r % NB_IN, n0 = 32 * nb; const bool isq = (n0 < 2048) || (n0 >= 6144 && n0 < 8192);
                p0_transpose_item(w_in, DM, DIN, Win_t, 64 * kb, n0, n0, isq ? QSCALE : 1.0f, scr, F.lane); continue; } r -= I_IN;
            if (r < I_OUT) { const int kb = r / NB_DM, nb = r % NB_DM; p0_transpose_item(w_out, DM, DM, Wout_t, 64 * kb, 32 * nb, 32 * nb, 1.0f, scr, F.lane); continue; } r -= I_OUT;
            if (r < I_G) { const int kb = r / NB_FF, nb = r % NB_FF, n0 = 32 * nb; p0_transpose_item(w_gate, DM, DFF, Wgu_t, 64 * kb, n0, (n0 >> 7) * 256 + (n0 & 127), 1.0f, scr, F.lane); continue; } r -= I_G;
            if (r < I_G) { const int kb = r / NB_FF, nb = r % NB_FF, n0 = 32 * nb; p0_transpose_item(w_up, DM, DFF, Wgu_t, 64 * kb, n0, (n0 >> 7) * 256 + 128 + (n0 & 127), 1.0f, scr, F.lane); continue; } r -= I_G;
            { const int kb = r / NB_DM, nb = r % NB_DM; p0_transpose_item(w_down, DFF, DM, Wdn_t, 64 * kb, 32 * nb, 32 * nb, 1.0f, scr, F.lane); }
        }
        for (int m = gw; m < MPAD; m += NGW) {
            GAS unsigned long long* o8 = (GAS unsigned long long*)(Abuf + (size_t)m * DM) + F.lane;
            if (m >= MREAL + NMETA) {
#pragma unroll
                for (int j = 0; j < 16; ++j) o8[64 * j] = 0ull;
                continue; }
            const GAS f32x4* xr = (const GAS f32x4*)x_row(x_prompt, x_sample, meta, m) + F.lane;
            f32x4 v[16]; float s = 0.f;
#pragma unroll
            for (int j = 0; j < 16; ++j) { v[j] = xr[64 * j]; s += (v[j].x * v[j].x + v[j].y * v[j].y) + (v[j].z * v[j].z + v[j].w * v[j].w); }
            const float rs = 1.0f / sqrtf(wave_sum(s) * (1.0f / DM) + EPS);
#pragma unroll
            for (int j = 0; j < 16; ++j) { const f32x4 g = ((const GAS f32x4*)g_pre_mix)[F.lane + 64 * j];
                o8[64 * j] = (unsigned long long)pk2(v[j].x * rs * g.x, v[j].y * rs * g.y) | ((unsigned long long)pk2(v[j].z * rs * g.z, v[j].w * rs * g.w) << 32); }
        }
    }
    xcd_barrier(bar);

    {
        pg8::Gemm g{Abuf, Win_t, MPAD, DIN, DM}; pg8::StaticOrder S; S.init(MPAD, DIN, F.G, (int)blockIdx.x);
        pg8::EpiBf16 E{Bbuf, DIN};
        pg8::gemm_phase<pg8::EpiBf16, pg8::StaticOrder, true, true>(F.lds + RING_OFF, g, S, E);
    }
    xcd_barrier(bar);

    {
        const att::bf16* Pp = (const att::bf16*)Bbuf; att::bf16* Op = (att::bf16*)Abuf;
        for (int uidx = F.vcu; uidx < 1536; uidx += F.G) {
            att::UnitP u;
            if (uidx < 1024) { u.seqbase = 0; u.T = TP; u.head = uidx >> 6; u.blk = uidx & 63; }
            else { const int v = uidx - 1024; u.seqbase = TP + TS * (v >> 8); u.T = TS; u.head = (v & 255) >> 4; u.blk = v & 15; }
            att::attn_unit<0>(u, Pp, Op, ssq, rpb, sink, (LAS char*)F.lds + RING_OFF);
        }
        for (int uidx = F.vcu; uidx < 1536; uidx += F.G) {
            att::UnitP u;
            if (uidx < 1024) { u.seqbase = 0; u.T = TP; u.head = uidx >> 8; u.blk = uidx & 255; }
            else { const int v = uidx - 1024; u.seqbase = TP + TS * (v >> 8); u.T = TS; u.head = (v & 255) >> 6; u.blk = v & 63; }
            att::attn_unit<1>(u, Pp, Op, ssq, rpb, sink, (LAS char*)F.lds + RING_OFF);
        }
    }
    xcd_barrier(bar);

    for (int m = gw; m < MREAL; m += NGW) {
        float sv = (F.lane < 32) ? ssq[(size_t)m * 32 + F.lane] : 0.f;
        sv += __shfl_xor(sv, 1); sv += __shfl_xor(sv, 2); sv += __shfl_xor(sv, 4); sv += __shfl_xor(sv, 8);
        const float rs_na = 1.0f / sqrtf(__shfl(sv, 0) * (1.0f / 2048.0f) + EPS), rs_sw = 1.0f / sqrtf(__shfl(sv, 16) * (1.0f / 2048.0f) + EPS);
        GAS v4u* row = (GAS v4u*)(Abuf + (size_t)m * DM) + F.lane;
#pragma unroll
        for (int j = 0; j < 8; ++j) { const v4u w = row[64 * j]; const float rs = j < 4 ? rs_na : rs_sw;
            const float* gp = (j < 4 ? g_na : g_sw) + 8 * (F.lane + 64 * (j & 3));
            const f32x4 ga = *(const GAS f32x4*)gp, gb = *(const GAS f32x4*)(gp + 4);
            v4u o; o.x = pk2(att::bf_lo(w.x) * rs * ga.x, att::bf_hi(w.x) * rs * ga.y); o.y = pk2(att::bf_lo(w.y) * rs * ga.z, att::bf_hi(w.y) * rs * ga.w);
            o.z = pk2(att::bf_lo(w.z) * rs * gb.x, att::bf_hi(w.z) * rs * gb.y); o.w = pk2(att::bf_lo(w.w) * rs * gb.z, att::bf_hi(w.w) * rs * gb.w);
            row[64 * j] = o; }
    }
    xcd_barrier(bar);

    {
        pg8::Gemm g{Abuf, Wout_t, MREAL, DM, DM}; pg8::StaticOrder S; S.init(MREAL, DM, F.G, (int)blockIdx.x);
        pg8::EpiF32 E{out, DM};
        pg8::gemm_phase<pg8::EpiF32, pg8::StaticOrder, true, true>(F.lds + RING_OFF, g, S, E);
    }
    xcd_barrier(bar);

    for (int m = gw; m < MREAL; m += NGW) {
        const GAS f32x4* mr = (const GAS f32x4*)(out + (size_t)m * DM) + F.lane;
        const GAS f32x4* xr = (const GAS f32x4*)x_row(x_prompt, x_sample, meta, m) + F.lane;
        f32x4 v[16]; float s = 0.f;
#pragma unroll
        for (int j = 0; j < 16; ++j) { v[j] = mr[64 * j]; s += (v[j].x * v[j].x + v[j].y * v[j].y) + (v[j].z * v[j].z + v[j].w * v[j].w); }
        const float rs1 = 1.0f / sqrtf(wave_sum(s) * (1.0f / DM) + EPS); float s2 = 0.f;
#pragma unroll
        for (int j = 0; j < 16; ++j) { const f32x4 g = ((const GAS f32x4*)g_post_mix)[F.lane + 64 * j]; const f32x4 xv = xr[64 * j];
            v[j].x = xv.x + v[j].x * rs1 * g.x; v[j].y = xv.y + v[j].y * rs1 * g.y; v[j].z = xv.z + v[j].z * rs1 * g.z; v[j].w = xv.w + v[j].w * rs1 * g.w;
            s2 += (v[j].x * v[j].x + v[j].y * v[j].y) + (v[j].z * v[j].z + v[j].w * v[j].w); }
        const float rs2 = 1.0f / sqrtf(wave_sum(s2) * (1.0f / DM) + EPS);
        GAS unsigned long long* o8 = (GAS unsigned long long*)(Abuf + (size_t)m * DM) + F.lane;
#pragma unroll
        for (int j = 0; j < 16; ++j) { const f32x4 g = ((const GAS f32x4*)g_pre_ffn)[F.lane + 64 * j];
            o8[64 * j] = (unsigned long long)pk2(v[j].x * rs2 * g.x, v[j].y * rs2 * g.y) | ((unsigned long long)pk2(v[j].z * rs2 * g.z, v[j].w * rs2 * g.w) << 32); }
    }
    xcd_barrier(bar);

    {
        pg8::Gemm g{Abuf, Wgu_t, MREAL, NGU, DM}; pg8::StaticOrder S; S.init(MREAL, NGU, F.G, (int)blockIdx.x);
        pg8::EpiSwiGLU E{Bbuf, DFF};
        pg8::gemm_phase<pg8::EpiSwiGLU, pg8::StaticOrder, true, true>(F.lds + RING_OFF, g, S, E);
    }
    xcd_barrier(bar);

    {
        pg8::Gemm g{Bbuf, Wdn_t, MREAL, DM, DFF}; pg8::StaticOrder S; S.init(MREAL, DM, F.G, (int)blockIdx.x);
        pg8::EpiBf16 E{Abuf, DM};
        pg8::gemm_phase<pg8::EpiBf16, pg8::StaticOrder, true, true>(F.lds + RING_OFF, g, S, E);
    }
    xcd_barrier(bar);

    for (int m = gw; m < MREAL; m += NGW) {
        GAS f32x4* mr = (GAS f32x4*)(out + (size_t)m * DM) + F.lane;
        const GAS f32x4* xr = (const GAS f32x4*)x_row(x_prompt, x_sample, meta, m) + F.lane;
        const GAS unsigned long long* fr = (const GAS unsigned long long*)(Abuf + (size_t)m * DM) + F.lane;
        f32x4 v[16]; unsigned long long fw[16]; float s = 0.f, sf = 0.f;
#pragma unroll
        for (int j = 0; j < 16; ++j) { v[j] = mr[64 * j]; fw[j] = fr[64 * j]; }
#pragma unroll
        for (int j = 0; j < 16; ++j) { s += (v[j].x * v[j].x + v[j].y * v[j].y) + (v[j].z * v[j].z + v[j].w * v[j].w);
            const unsigned lo = (unsigned)fw[j], hi = (unsigned)(fw[j] >> 32); const float a = att::bf_lo(lo), b = att::bf_hi(lo), c = att::bf_lo(hi), d = att::bf_hi(hi);
            sf += (a * a + b * b) + (c * c + d * d); }
        const float rs1 = 1.0f / sqrtf(wave_sum(s) * (1.0f / DM) + EPS), rs3 = 1.0f / sqrtf(wave_sum(sf) * (1.0f / DM) + EPS);
#pragma unroll
        for (int j = 0; j < 16; ++j) { const f32x4 g1 = ((const GAS f32x4*)g_post_mix)[F.lane + 64 * j], g3 = ((const GAS f32x4*)g_post_ffn)[F.lane + 64 * j]; const f32x4 xv = xr[64 * j];
            const unsigned lo = (unsigned)fw[j], hi = (unsigned)(fw[j] >> 32);
            f32x4 y; y.x = xv.x + v[j].x * rs1 * g1.x + att::bf_lo(lo) * rs3 * g3.x; y.y = xv.y + v[j].y * rs1 * g1.y + att::bf_hi(lo) * rs3 * g3.y;
            y.z = xv.z + v[j].z * rs1 * g1.z + att::bf_lo(hi) * rs3 * g3.z; y.w = xv.w + v[j].w * rs1 * g1.w + att::bf_hi(hi) * rs3 * g3.w;
            mr[64 * j] = y; }
    }
}

extern "C" void kernel_launch(void* const* d_in, const int* in_sizes, int n_in, void* d_out, int out_size, void* d_ws, size_t ws_size, hipStream_t stream) {
    static int grid = 0;
    if (grid == 0) {
        if (n_in != 16 || in_sizes[0] != TP * DM || in_sizes[1] != 2 * TS * DM || out_size != MREAL * DM || ws_size < WS_END) {
            fprintf(stderr, "kernel_launch: shape mismatch: n_in %d in0 %d in1 %d out %d ws %zu (need %zu); nothing launched\n", n_in, n_in > 0 ? in_sizes[0] : -1, n_in > 1 ? in_sizes[1] : -1, out_size, ws_size, (size_t)WS_END); grid = -1; return; }
        int dev = 0, cus = 0, per_cu = 0;
        if (hipGetDevice(&dev) != hipSuccess || hipDeviceGetAttribute(&cus, hipDeviceAttributeMultiprocessorCount, dev) != hipSuccess) { fprintf(stderr, "kernel_launch: device query failed\n"); grid = -1; return; }
        if (hipFuncSetAttribute((const void*)enc_fwd, hipFuncAttributeMaxDynamicSharedMemorySize, LDS_BYTES) != hipSuccess) { fprintf(stderr, "kernel_launch: hipFuncSetAttribute failed\n"); grid = -1; return; }
        if (hipOccupancyMaxActiveBlocksPerMultiprocessor(&per_cu, (const void*)enc_fwd, NWAVES * 64, LDS_BYTES) != hipSuccess || per_cu < 1)
            fprintf(stderr, "kernel_launch: note: occupancy query reports %d workgroups per CU\n", per_cu);
        (void)hipGetLastError();
        grid = cus;
    }
    if (grid < 0) return;
    if (hipMemsetAsync((char*)d_ws + WS_CTL, 0, CTL_ZERO_BYTES, stream) != hipSuccess) { fprintf(stderr, "kernel_launch: memset failed\n"); return; }
    Args a{};
    for (int i = 0; i < 16; ++i) a.in[i] = (const float*)d_in[i];
    a.out = (float*)d_out; a.ws = (unsigned char*)d_ws;
    hipLaunchKernelGGL(enc_fwd, dim3(grid), dim3(NWAVES * 64), LDS_BYTES, stream, a);
    const hipError_t le = hipPeekAtLastError();
    if (le != hipSuccess) fprintf(stderr, "kernel_launch: launch failed: %s\n", hipGetErrorName(le));
}
```

```cpp
#include <hip/hip_runtime.h>
#include <hip/hip_bf16.h>
#include <cstdio>
#include <cstdint>
namespace pg8 {
#define PG8_LAS __attribute__((address_space(3)))
typedef unsigned short bf16_t;
typedef short bf16x8 __attribute__((ext_vector_type(8)));
typedef float f32x4 __attribute__((ext_vector_type(4)));
typedef unsigned u32x4 __attribute__((ext_vector_type(4)));
constexpr int BM = 256, BK = 64, HALF = 128, HTB = HALF * BK * 2  , STAGE_BYTES = 8 * HTB, NXCD = 8, WGM = 8;

__host__ __device__ __forceinline__ int lds_byte(int r, int c) { const int st = (r >> 4) * 2 + (c >> 5), rr = r & 15, cc = c & 31, ob = rr * 64 + cc * 2; return st * 1024 + (ob ^ (((ob >> 9) & 1) << 5)); }
__host__ __device__ __forceinline__ void stage_rc(int b, int& R, int& C) { const int st = b / 1024, sb = b % 1024, swz = sb ^ (((sb >> 9) & 1) << 5); R = (st >> 1) * 16 + swz / 64; C = (st & 1) * 32 + (swz % 64) / 2; }
__host__ __device__ __forceinline__ int perm32(int rho) { const int n = rho >> 4, i = rho & 15; return 8 * (i >> 2) + 4 * n + (i & 3); }

struct Unit { int pm, pn; };
struct Gemm { const bf16_t* A; const bf16_t* Bt; int M, N, K; };

struct StaticOrder {
    int nM, nN, nwg, G, c, wgm;
    __host__ __device__ void init(int M, int N, int G_, int c_, int wgm_ = WGM) { nM = M / BM; nN = N / BM; nwg = nM * nN; G = G_; c = c_; wgm = wgm_; }
    __host__ __device__ bool next(int i, Unit& u) const {
        const long L = (long)i * G + c; if (L >= nwg) return false;
        int wgid = (int)L; { const int q = nwg / NXCD, r = nwg % NXCD, xcd = wgid % NXCD, off = wgid / NXCD; wgid = (xcd < r ? xcd * (q + 1) : r * (q + 1) + (xcd - r) * q) + off; }
        const int nig = wgm * nN, gid = wgid / nig, fm = gid * wgm, gsz = (nM - fm) < wgm ? (nM - fm) : wgm;
        u.pm = fm + ((wgid % nig) % gsz); u.pn = (wgid % nig) / gsz; return true;
    }
    __device__ __forceinline__ void a_ready(const Unit&) const {}
    __device__ __forceinline__ void done(const Unit&) const {}
};

__device__ __forceinline__ unsigned cvt_pk_bf16(float lo, float hi) { unsigned r; asm volatile("v_cvt_pk_bf16_f32 %0, %1, %2" : "=v"(r) : "v"(lo), "v"(hi)); return r; }
typedef float f32x2 __attribute__((ext_vector_type(2)));
struct EpiBf16 {
    static constexpr bool PERM = true, AFTER_DRAIN = false, HAS_MID = false, I8 = false;
    bf16_t* O; int ldc;
    __device__ __forceinline__ void operator()(const f32x4 (&acc)[2][2][4][2], const Unit& u, int wr, int wc, int fr, int fq) const {
        const int row0 = u.pm * BM + wr * 64 + fr, col0 = u.pn * BM + wc * 32 + 8 * fq;
#pragma unroll
        for (int ai = 0; ai < 2; ++ai)
#pragma unroll
            for (int m = 0; m < 4; ++m) { bf16_t* rowp = O + (size_t)(row0 + ai * HALF + m * 16) * ldc + col0;
#pragma unroll
                for (int bj = 0; bj < 2; ++bj) { const f32x4 v0 = acc[ai][bj][m][0], v1 = acc[ai][bj][m][1];
                    u32x4 w; w.x = cvt_pk_bf16(v0[0], v0[1]); w.y = cvt_pk_bf16(v0[2], v0[3]); w.z = cvt_pk_bf16(v1[0], v1[1]); w.w = cvt_pk_bf16(v1[2], v1[3]);
                    *(u32x4*)(rowp + bj * HALF) = w; } }
    }
};
struct EpiF32 {
    static constexpr bool PERM = false, AFTER_DRAIN = false, HAS_MID = false, I8 = false;
    float* C; int ldc;
    __device__ __forceinline__ void operator()(const f32x4 (&acc)[2][2][4][2], const Unit& u, int wr, int wc, int fr, int fq) const {
        const int row0 = u.pm * BM + wr * 64 + fr, col0 = u.pn * BM + wc * 32 + 4 * fq;
#pragma unroll
        for (int ai = 0; ai < 2; ++ai)
#pragma unroll
            for (int m = 0; m < 4; ++m) { float* rowp = C + (size_t)(row0 + ai * HALF + m * 16) * ldc + col0;
#pragma unroll
                for (int bj = 0; bj < 2; ++bj)
#pragma unroll
                    for (int n = 0; n < 2; ++n) *(f32x4*)(rowp + bj * HALF + n * 16) = acc[ai][bj][m][n]; }
    }
};
__device__ __forceinline__ float silu_mul(float g, float u) { return g * u * __builtin_amdgcn_rcpf(1.0f + __builtin_amdgcn_exp2f(g * -1.4426950408889634f)); }
struct EpiSwiGLU {
    static constexpr bool PERM = true, AFTER_DRAIN = false, HAS_MID = false, I8 = false;
    bf16_t* O; int ldc;
    __device__ __forceinline__ void operator()(const f32x4 (&acc)[2][2][4][2], const Unit& u, int wr, int wc, int fr, int fq) const {
        const int row0 = u.pm * BM + wr * 64 + fr, col0 = u.pn * HALF + wc * 32 + 8 * fq;
#pragma unroll
        for (int ai = 0; ai < 2; ++ai)
#pragma unroll
            for (int m = 0; m < 4; ++m) { bf16_t* rowp = O + (size_t)(row0 + ai * HALF + m * 16) * ldc + col0;
                const f32x4 g0 = acc[ai][0][m][0], g1 = acc[ai][0][m][1], u0 = acc[ai][1][m][0], u1 = acc[ai][1][m][1];
                u32x4 w; w.x = cvt_pk_bf16(silu_mul(g0[0], u0[0]), silu_mul(g0[1], u0[1])); w.y = cvt_pk_bf16(silu_mul(g0[2], u0[2]), silu_mul(g0[3], u0[3]));
                w.z = cvt_pk_bf16(silu_mul(g1[0], u1[0]), silu_mul(g1[1], u1[1])); w.w = cvt_pk_bf16(silu_mul(g1[2], u1[2]), silu_mul(g1[3], u1[3]));
                *(u32x4*)rowp = w; }
    }
};

struct EpiF32Norm2 {
    static constexpr bool PERM = false, AFTER_DRAIN = false, HAS_MID = true, I8 = false;
    float* C; int ldc; const float* acc2; float inv_cnt, eps;
    __device__ __forceinline__ void mid(f32x4 (&acc)[2][2][4][2], const Unit& u, int wr, int fr) const {
        const int row0 = u.pm * BM + wr * 64 + fr;
#pragma unroll
        for (int ai = 0; ai < 2; ++ai)
#pragma unroll
            for (int m = 0; m < 4; ++m) { const f32x2 s = *(const f32x2*)(acc2 + 2 * (size_t)(row0 + ai * HALF + m * 16));
                const float ratio = __builtin_amdgcn_sqrtf((s.y * inv_cnt + eps) * __builtin_amdgcn_rcpf(s.x * inv_cnt + eps));
#pragma unroll
                for (int bj = 0; bj < 2; ++bj)
#pragma unroll
                    for (int n = 0; n < 2; ++n) acc[ai][bj][m][n] *= ratio; }
    }
    __device__ __forceinline__ void operator()(const f32x4 (&acc)[2][2][4][2], const Unit& u, int wr, int wc, int fr, int fq) const {
        const int row0 = u.pm * BM + wr * 64 + fr, col0 = u.pn * BM + wc * 32 + 4 * fq;
#pragma unroll
        for (int ai = 0; ai < 2; ++ai)
#pragma unroll
            for (int m = 0; m < 4; ++m) { const int row = row0 + ai * HALF + m * 16; float* rowp = C + (size_t)row * ldc + col0;
                const float rsb = __builtin_amdgcn_rsqf(acc2[2 * (size_t)row + 1] * inv_cnt + eps);
#pragma unroll
                for (int bj = 0; bj < 2; ++bj)
#pragma unroll
                    for (int n = 0; n < 2; ++n) *(f32x4*)(rowp + bj * HALF + n * 16) = acc[ai][bj][m][n] * rsb; }
    }
};

struct EpiBf16Norm2 {
    static constexpr bool PERM = true, AFTER_DRAIN = false, HAS_MID = true, I8 = false;
    bf16_t* O; int ldc; const float* acc2; float inv_cnt, eps;
    __device__ __forceinline__ void mid(f32x4 (&acc)[2][2][4][2], const Unit& u, int wr, int fr) const {
        const int row0 = u.pm * BM + wr * 64 + fr;
#pragma unroll
        for (int ai = 0; ai < 2; ++ai)
#pragma unroll
            for (int m = 0; m < 4; ++m) { const f32x2 s = *(const f32x2*)(acc2 + 2 * (size_t)(row0 + ai * HALF + m * 16));
                const float ratio = __builtin_amdgcn_sqrtf((s.y * inv_cnt + eps) * __builtin_amdgcn_rcpf(s.x * inv_cnt + eps));
#pragma unroll
                for (int bj = 0; bj < 2; ++bj)
#pragma unroll
                    for (int n = 0; n < 2; ++n) acc[ai][bj][m][n] *= ratio; }
    }
    __device__ __forceinline__ void operator()(const f32x4 (&acc)[2][2][4][2], const Unit& u, int wr, int wc, int fr, int fq) const {
        const int row0 = u.pm * BM + wr * 64 + fr, col0 = u.pn * BM + wc * 32 + 8 * fq;
#pragma unroll
        for (int ai = 0; ai < 2; ++ai)
#pragma unroll
            for (int m = 0; m < 4; ++m) { const int row = row0 + ai * HALF + m * 16; bf16_t* rowp = O + (size_t)row * ldc + col0;
                const float rsb = __builtin_amdgcn_rsqf(acc2[2 * (size_t)row + 1] * inv_cnt + eps);
#pragma unroll
                for (int bj = 0; bj < 2; ++bj) { const f32x4 v0 = acc[ai][bj][m][0] * rsb, v1 = acc[ai][bj][m][1] * rsb;
                    u32x4 w; w.x = cvt_pk_bf16(v0[0], v0[1]); w.y = cvt_pk_bf16(v0[2], v0[3]); w.z = cvt_pk_bf16(v1[0], v1[1]); w.w = cvt_pk_bf16(v1[2], v1[3]);
                    *(u32x4*)(rowp + bj * HALF) = w; } }
    }
};

typedef int i32x4e __attribute__((ext_vector_type(4)));
struct EpiSwiGLUI8 {
    static constexpr bool PERM = true, AFTER_DRAIN = false, HAS_MID = false, I8 = true;
    bf16_t* O; int ldc; const float* sa; const float* sbmax;
    __device__ __forceinline__ void operator()(const i32x4e (&acc)[2][2][4][2], const Unit& u, int wr, int wc, int fr, int fq) const {
        const int row0 = u.pm * BM + wr * 64 + fr, col0 = u.pn * HALF + wc * 32 + 8 * fq, brow0 = u.pn * BM + wc * 32 + 8 * fq;
        const f32x4 sg0 = *(const f32x4*)(sbmax + brow0) * (1.0f / 127.0f), sg1 = *(const f32x4*)(sbmax + brow0 + 4) * (1.0f / 127.0f);
        const f32x4 su0 = *(const f32x4*)(sbmax + brow0 + HALF) * (1.0f / 127.0f), su1 = *(const f32x4*)(sbmax + brow0 + HALF + 4) * (1.0f / 127.0f);
#pragma unroll
        for (int ai = 0; ai < 2; ++ai)
#pragma unroll
            for (int m = 0; m < 4; ++m) { const int row = row0 + ai * HALF + m * 16; bf16_t* rowp = O + (size_t)row * ldc + col0; const float s = sa[row];
                const f32x4 g0 = __builtin_convertvector(acc[ai][0][m][0], f32x4) * (sg0 * s), g1 = __builtin_convertvector(acc[ai][0][m][1], f32x4) * (sg1 * s);
                const f32x4 u0 = __builtin_convertvector(acc[ai][1][m][0], f32x4) * (su0 * s), u1 = __builtin_convertvector(acc[ai][1][m][1], f32x4) * (su1 * s);
                u32x4 w; w.x = cvt_pk_bf16(silu_mul(g0[0], u0[0]), silu_mul(g0[1], u0[1])); w.y = cvt_pk_bf16(silu_mul(g0[2], u0[2]), silu_mul(g0[3], u0[3]));
                w.z = cvt_pk_bf16(silu_mul(g1[0], u1[0]), silu_mul(g1[1], u1[1])); w.w = cvt_pk_bf16(silu_mul(g1[2], u1[2]), silu_mul(g1[3], u1[3]));
                *(u32x4*)rowp = w; }
    }
};


struct EpiBf16I8Norm2 {
    static constexpr bool PERM = true, AFTER_DRAIN = false, HAS_MID = true, I8 = true;
    bf16_t* O; int ldc; const float* scl; const float* sbmax;
    __device__ __forceinline__ void mid(i32x4e (&acc)[2][2][4][2], const Unit& u, int wr, int fr) const {
        const int row0 = u.pm * BM + wr * 64 + fr;
#pragma unroll
        for (int ai = 0; ai < 2; ++ai)
#pragma unroll
            for (int m = 0; m < 4; ++m) { const f32x2 s = *(const f32x2*)(scl + 2 * (size_t)(row0 + ai * HALF + m * 16));
                const float ratio = s.x * __builtin_amdgcn_rcpf(s.y);
#pragma unroll
                for (int bj = 0; bj < 2; ++bj)
#pragma unroll
                    for (int n = 0; n < 2; ++n) { const f32x4 t = __builtin_convertvector(acc[ai][bj][m][n], f32x4) * ratio;
                        acc[ai][bj][m][n] = (i32x4e){(int)__builtin_rintf(t[0]), (int)__builtin_rintf(t[1]), (int)__builtin_rintf(t[2]), (int)__builtin_rintf(t[3])}; } }
    }
    __device__ __forceinline__ void operator()(const i32x4e (&acc)[2][2][4][2], const Unit& u, int wr, int wc, int fr, int fq) const {
        const int row0 = u.pm * BM + wr * 64 + fr, col0 = u.pn * BM + wc * 32 + 8 * fq;
        f32x4 sb[2][2];
#pragma unroll
        for (int bj = 0; bj < 2; ++bj)
#pragma unroll
            for (int n = 0; n < 2; ++n) sb[bj][n] = *(const f32x4*)(sbmax + col0 + bj * HALF + 4 * n) * (1.0f / 127.0f);
#pragma unroll
        for (int ai = 0; ai < 2; ++ai)
#pragma unroll
            for (int m = 0; m < 4; ++m) { const int row = row0 + ai * HALF + m * 16; bf16_t* rowp = O + (size_t)row * ldc + col0; const float s = scl[2 * (size_t)row + 1];
#pragma unroll
                for (int bj = 0; bj < 2; ++bj) { const f32x4 v0 = __builtin_convertvector(acc[ai][bj][m][0], f32x4) * (sb[bj][0] * s), v1 = __builtin_convertvector(acc[ai][bj][m][1], f32x4) * (sb[bj][1] * s);
                    u32x4 w; w.x = cvt_pk_bf16(v0[0], v0[1]); w.y = cvt_pk_bf16(v0[2], v0[3]); w.z = cvt_pk_bf16(v1[0], v1[1]); w.w = cvt_pk_bf16(v1[2], v1[3]);
                    *(u32x4*)(rowp + bj * HALF) = w; } }
    }
};

struct EpiBf16I8 {
    static constexpr bool PERM = true, AFTER_DRAIN = false, HAS_MID = false, I8 = true;
    bf16_t* O; int ldc; const float* sa; const float* sbmax;
    __device__ __forceinline__ void operator()(const i32x4e (&acc)[2][2][4][2], const Unit& u, int wr, int wc, int fr, int fq) const {
        const int row0 = u.pm * BM + wr * 64 + fr, col0 = u.pn * BM + wc * 32 + 8 * fq;
        f32x4 sb[2][2];
#pragma unroll
        for (int bj = 0; bj < 2; ++bj)
#pragma unroll
            for (int n = 0; n < 2; ++n) sb[bj][n] = *(const f32x4*)(sbmax + col0 + bj * HALF + 4 * n) * (1.0f / 127.0f);
#pragma unroll
        for (int ai = 0; ai < 2; ++ai)
#pragma unroll
            for (int m = 0; m < 4; ++m) { const int row = row0 + ai * HALF + m * 16; bf16_t* rowp = O + (size_t)row * ldc + col0; const float s = sa[row];
#pragma unroll
                for (int bj = 0; bj < 2; ++bj) { const f32x4 v0 = __builtin_convertvector(acc[ai][bj][m][0], f32x4) * (sb[bj][0] * s), v1 = __builtin_convertvector(acc[ai][bj][m][1], f32x4) * (sb[bj][1] * s);
                    u32x4 w; w.x = cvt_pk_bf16(v0[0], v0[1]); w.y = cvt_pk_bf16(v0[2], v0[3]); w.z = cvt_pk_bf16(v1[0], v1[1]); w.w = cvt_pk_bf16(v1[2], v1[3]);
                    *(u32x4*)(rowp + bj * HALF) = w; } }
    }
};

struct EpiBf16Blk {
    static constexpr bool PERM = true, AFTER_DRAIN = false, HAS_MID = false, I8 = false;
    bf16_t* O; int rows;
    __device__ __forceinline__ void operator()(const f32x4 (&acc)[2][2][4][2], const Unit& u, int wr, int wc, int fr, int fq) const {
        const int row0 = u.pm * BM + wr * 64 + fr, cin = wc * 32 + 8 * fq;
#pragma unroll
        for (int ai = 0; ai < 2; ++ai)
#pragma unroll
            for (int m = 0; m < 4; ++m) {
#pragma unroll
                for (int bj = 0; bj < 2; ++bj) { bf16_t* p = O + ((size_t)(u.pn * 2 + bj) * rows + (row0 + ai * HALF + m * 16)) * 128 + cin;
                    const f32x4 v0 = acc[ai][bj][m][0], v1 = acc[ai][bj][m][1];
                    u32x4 w; w.x = cvt_pk_bf16(v0[0], v0[1]); w.y = cvt_pk_bf16(v0[2], v0[3]); w.z = cvt_pk_bf16(v1[0], v1[1]); w.w = cvt_pk_bf16(v1[2], v1[3]);
                    *(u32x4*)p = w; } }
    }
};

typedef int i32x4 __attribute__((ext_vector_type(4)));
template <bool I8> struct AccSel { typedef f32x4 T; };
template <> struct AccSel<true> { typedef i32x4 T; };
template <bool I8> __device__ __forceinline__ typename AccSel<I8>::T mma16(bf16x8 b, bf16x8 a, typename AccSel<I8>::T c) {
    if constexpr (I8) return __builtin_amdgcn_mfma_i32_16x16x64_i8(__builtin_bit_cast(i32x4, b), __builtin_bit_cast(i32x4, a), c, 0, 0, 0);
    else return __builtin_amdgcn_mfma_f32_16x16x32_bf16(b, a, c, 0, 0, 0);
}
template <class Epi, class Sched, bool ALIGN_EPI = false, bool SP2 = false>
__device__ __forceinline__ void gemm_phase(PG8_LAS unsigned char* lds, const Gemm g, const Sched& S, const Epi& E, const int wave_id  ) {
    unsigned zero_ = 0u; asm volatile("" : "+s"(zero_));
    int tid = wave_id * 64 + (int)__builtin_amdgcn_mbcnt_hi(~0u, __builtin_amdgcn_mbcnt_lo(~0u, zero_)); asm volatile("" : "+v"(tid));
    const int wid = __builtin_amdgcn_readfirstlane(tid >> 6), lane = tid & 63, wr = wid >> 2, wc = wid & 3, fr = lane & 15, fq = lane >> 4;
    const int K = g.K, nt = K / BK;
    unsigned voffA[2], voffB[2];
#pragma unroll
    for (int i = 0; i < 2; ++i) { int R, C; stage_rc(tid * 16 + i * 8192, R, C); const int Rb = Epi::PERM ? ((R & ~31) + perm32(R & 31)) : R;
        voffA[i] = (unsigned)(R * K + C) * 2u; voffB[i] = (unsigned)(Rb * K + C) * 2u; }
    const size_t kstep = (size_t)(BK * 2);
    const size_t hstep = (size_t)HALF * K * 2;
    const size_t tstep = 2 * hstep;
    const unsigned ldsw = (unsigned)wid * 1024u;
    const int aoff = lds_byte(wr * 64 + fr, fq * 8), boff = lds_byte(wc * 32 + fr, fq * 8);
#define PG8_SA(b, h) (((b) * 2 + (h)) * HTB)
#define PG8_SB(b, h) ((4 + (b) * 2 + (h)) * HTB)
#define PG8_STAGE(bufoff, gbase, voff) do { _Pragma("unroll") for (int _i = 0; _i < 2; ++_i) \
        __builtin_amdgcn_global_load_lds((const unsigned*)((const char*)(gbase) + (voff)[_i]), (PG8_LAS unsigned*)(lds + (bufoff) + ldsw + _i * 8192), 16, 0, 0); } while (0)
#define PG8_LDA(dst, b, h) do { _Pragma("unroll") for (int m = 0; m < 4; ++m) _Pragma("unroll") for (int k = 0; k < 2; ++k) dst[m][k] = *(const PG8_LAS bf16x8*)(lds + PG8_SA(b, h) + aoff + m * 2048 + k * 1024); } while (0)
#define PG8_LDB(dst, b, h) do { _Pragma("unroll") for (int n = 0; n < 2; ++n) _Pragma("unroll") for (int k = 0; k < 2; ++k) dst[n][k] = *(const PG8_LAS bf16x8*)(lds + PG8_SB(b, h) + boff + n * 2048 + k * 1024); } while (0)
#define PG8_MMA(ai, bj, At, Bt) do { __builtin_amdgcn_s_setprio(1); _Pragma("unroll") for (int m = 0; m < 4; ++m) _Pragma("unroll") for (int n = 0; n < 2; ++n) _Pragma("unroll") for (int k = 0; k < 2; ++k) \
        acc[ai][bj][m][n] = mma16<Epi::I8>(Bt[n][k], At[m][k], acc[ai][bj][m][n]); __builtin_amdgcn_s_setprio(0); } while (0)
#define PG8_WAIT_V(n) asm volatile("s_waitcnt vmcnt(" #n ")" ::: "memory")
#define PG8_WAIT_L(n) asm volatile("s_waitcnt lgkmcnt(" #n ")" ::: "memory")
#define PG8_BAR __builtin_amdgcn_s_barrier()
#define PG8_SCHED __builtin_amdgcn_sched_barrier(0)
    Unit cur, nxt; int ui = 0;
    if (!S.next(0, cur)) return;
    typedef typename AccSel<Epi::I8>::T acc_t;
    acc_t acc[2][2][4][2];
#pragma unroll
    for (int a = 0; a < 2; ++a)
#pragma unroll
        for (int b = 0; b < 2; ++b)
#pragma unroll
            for (int m = 0; m < 4; ++m)
#pragma unroll
                for (int n = 0; n < 2; ++n) acc[a][b][m][n] = acc_t{};
    bf16x8 At[4][2], B0[2][2], B1[2][2];
    const char* cA = (const char*)g.A + (size_t)cur.pm * tstep; const char* cB = (const char*)g.Bt + (size_t)cur.pn * tstep;
    S.a_ready(cur);
    if constexpr (SP2) {
        PG8_STAGE(PG8_SB(0, 0), cB, voffB); PG8_STAGE(PG8_SB(0, 1), cB + hstep, voffB); PG8_STAGE(PG8_SA(0, 0), cA, voffA); PG8_STAGE(PG8_SA(0, 1), cA + hstep, voffA);
        if (wr == 1) PG8_BAR;
        PG8_WAIT_V(2); PG8_BAR;
        PG8_STAGE(PG8_SB(1, 0), cB + kstep, voffB); PG8_STAGE(PG8_SA(1, 0), cA + kstep, voffA); PG8_STAGE(PG8_SB(1, 1), cB + hstep + kstep, voffB);
        PG8_WAIT_V(6); PG8_BAR;
    } else {
        PG8_STAGE(PG8_SB(0, 0), cB, voffB); PG8_STAGE(PG8_SA(0, 0), cA, voffA); PG8_STAGE(PG8_SB(0, 1), cB + hstep, voffB); PG8_STAGE(PG8_SA(0, 1), cA + hstep, voffA);
        if (wr == 1) PG8_BAR;
        PG8_WAIT_V(4); PG8_BAR;
        PG8_STAGE(PG8_SB(1, 0), cB + kstep, voffB); PG8_STAGE(PG8_SA(1, 0), cA + kstep, voffA); PG8_STAGE(PG8_SB(1, 1), cB + hstep + kstep, voffB);
        PG8_WAIT_V(6); PG8_BAR;
    }
    for (;;) {
        const bool has_next = S.next(ui + 1, nxt);
        const char* nA = has_next ? (const char*)g.A + (size_t)nxt.pm * tstep : cA; const char* nB = has_next ? (const char*)g.Bt + (size_t)nxt.pn * tstep : cB;
        for (int t = 0; t < nt; t += 2) {
            const bool last = (t == nt - 2);
            const char* a1 = cA + (size_t)(t + 1) * kstep;
            const char* a2 = last ? nA : cA + (size_t)(t + 2) * kstep; const char* b2 = last ? nB : cB + (size_t)(t + 2) * kstep;
            const char* a3 = a2 + kstep; const char* b3 = b2 + kstep;
            if (last && has_next) S.a_ready(nxt);
            if constexpr (Epi::HAS_MID) { if (t == (nt >> 1)) { unsigned z2_ = 0u; asm volatile("" : "+s"(z2_)); const int l2_ = (int)__builtin_amdgcn_mbcnt_hi(~0u, __builtin_amdgcn_mbcnt_lo(~0u, z2_)); E.mid(acc, cur, wr, l2_ & 15); } }
            if constexpr (SP2) {
            PG8_LDB(B0, 0, 0); PG8_LDB(B1, 0, 1); PG8_SCHED; PG8_LDA(At, 0, 0); PG8_STAGE(PG8_SA(1, 1), a1 + hstep, voffA);
            PG8_WAIT_V(8); PG8_WAIT_L(0); PG8_BAR; PG8_MMA(0, 0, At, B0); PG8_MMA(0, 1, At, B1); PG8_BAR; PG8_SCHED;
            PG8_LDA(At, 0, 1); PG8_STAGE(PG8_SB(0, 0), b2, voffB); PG8_STAGE(PG8_SB(0, 1), b2 + hstep, voffB); PG8_STAGE(PG8_SA(0, 0), a2, voffA);
            PG8_WAIT_V(8); PG8_WAIT_L(0); PG8_BAR; PG8_MMA(1, 0, At, B0); PG8_MMA(1, 1, At, B1); PG8_BAR; PG8_SCHED;
            PG8_LDB(B0, 1, 0); PG8_LDB(B1, 1, 1); PG8_SCHED; PG8_LDA(At, 1, 0); PG8_STAGE(PG8_SA(0, 1), a2 + hstep, voffA);
            PG8_WAIT_V(8); PG8_WAIT_L(0); PG8_BAR; PG8_MMA(0, 0, At, B0); PG8_MMA(0, 1, At, B1); PG8_BAR; PG8_SCHED;
            PG8_LDA(At, 1, 1); PG8_STAGE(PG8_SB(1, 0), b3, voffB); PG8_STAGE(PG8_SB(1, 1), b3 + hstep, voffB); PG8_STAGE(PG8_SA(1, 0), a3, voffA);
            PG8_WAIT_V(8); PG8_WAIT_L(0); PG8_BAR; PG8_MMA(1, 0, At, B0); PG8_MMA(1, 1, At, B1); PG8_BAR; PG8_SCHED;
            } else {
            PG8_LDB(B0, 0, 0); PG8_SCHED; PG8_LDA(At, 0, 0); PG8_STAGE(PG8_SA(1, 1), a1 + hstep, voffA);
            PG8_WAIT_L(8); PG8_BAR; PG8_WAIT_L(0); PG8_MMA(0, 0, At, B0); PG8_BAR; PG8_SCHED;
            PG8_LDB(B1, 0, 1); PG8_STAGE(PG8_SB(0, 0), b2, voffB);
            PG8_BAR; PG8_WAIT_L(0); PG8_MMA(0, 1, At, B1); PG8_BAR;
            PG8_LDA(At, 0, 1); PG8_STAGE(PG8_SA(0, 0), a2, voffA);
            PG8_BAR; PG8_WAIT_L(0); PG8_MMA(1, 0, At, B0); PG8_BAR; PG8_SCHED;
            PG8_STAGE(PG8_SB(0, 1), b2 + hstep, voffB);
            PG8_WAIT_V(6); PG8_BAR; PG8_MMA(1, 1, At, B1); PG8_BAR;
            PG8_LDB(B0, 1, 0); PG8_SCHED; PG8_LDA(At, 1, 0); PG8_STAGE(PG8_SA(0, 1), a2 + hstep, voffA);
            PG8_WAIT_L(8); PG8_BAR; PG8_WAIT_L(0); PG8_MMA(0, 0, At, B0); PG8_BAR; PG8_SCHED;
            PG8_LDB(B1, 1, 1); PG8_STAGE(PG8_SB(1, 0), b3, voffB);
            PG8_BAR; PG8_WAIT_L(0); PG8_MMA(0, 1, At, B1); PG8_BAR;
            PG8_LDA(At, 1, 1); PG8_STAGE(PG8_SA(1, 0), a3, voffA);
            PG8_BAR; PG8_WAIT_L(0); PG8_MMA(1, 0, At, B0); PG8_BAR; PG8_SCHED;
            PG8_STAGE(PG8_SB(1, 1), b3 + hstep, voffB);
            PG8_WAIT_V(6); PG8_BAR; PG8_MMA(1, 1, At, B1); PG8_BAR;
            }
        }
        if constexpr (ALIGN_EPI) { if (wr == 0) PG8_BAR; }
        if constexpr (!Epi::AFTER_DRAIN) { unsigned z3_ = 0u; asm volatile("" : "+s"(z3_)); const int l3_ = (int)__builtin_amdgcn_mbcnt_hi(~0u, __builtin_amdgcn_mbcnt_lo(~0u, z3_));
            E(acc, cur, wr, wc, l3_ & 15, l3_ >> 4); S.done(cur); }
        if (!has_next) break;
#pragma unroll
        for (int a = 0; a < 2; ++a)
#pragma unroll
            for (int b = 0; b < 2; ++b)
#pragma unroll
                for (int m = 0; m < 4; ++m)
#pragma unroll
                    for (int n = 0; n < 2; ++n) acc[a][b][m][n] = acc_t{};
        cur = nxt; cA = nA; cB = nB; ++ui;
        if constexpr (ALIGN_EPI) { if (wr == 1) PG8_BAR; }
    }
    PG8_WAIT_V(0);
    if constexpr (!ALIGN_EPI) { if (wr == 0) PG8_BAR; }
    PG8_BAR;
    if constexpr (Epi::AFTER_DRAIN) { E.fused(acc, cur, wr, wc, fr, fq, lds, wid, lane); S.done(cur); }
#undef PG8_SA
#undef PG8_SB
#undef PG8_STAGE
#undef PG8_LDA
#undef PG8_LDB
#undef PG8_MMA
#undef PG8_WAIT_V
#undef PG8_WAIT_L
#undef PG8_BAR
#undef PG8_SCHED
}
}
namespace att {
#define ALDS __attribute__((address_space(3)))
using bf16 = __hip_bfloat16;
using bf16x8 = __attribute__((ext_vector_type(8))) short;
using s16x4  = __attribute__((ext_vector_type(4))) short;
using f32x16 = __attribute__((ext_vector_type(16))) float;
using u32x4  = __attribute__((ext_vector_type(4))) unsigned;
constexpr int LDP = 9216;
constexpr int PROWS = 24832;
constexpr int LDO = 4096;
constexpr int META_ROW = 24576;
constexpr int SHM_V = 16384, SHM_K = 16384;
constexpr int OFF_WS = 65536, OFF_TAB = 65536 + 2048, ATT_LDS = OFF_TAB + 15 * 128 * 4;
constexpr float LOG2E = 1.4426950408889634f;
constexpr float THRX = 8.0f;
constexpr float NEG = -1e30f;
#define KSWZ(row, colB) ((row) * 256 + ((colB) ^ (((row) & 7) << 4)))
#define SBAR() __builtin_amdgcn_sched_barrier(0)
__device__ __forceinline__ int crow(int r, int hi) { return (r & 3) + 8 * (r >> 2) + 4 * hi; }
__device__ __forceinline__ unsigned cvtpk(float lo, float hi) { unsigned r; asm volatile("v_cvt_pk_bf16_f32 %0, %1, %2" : "=v"(r) : "v"(lo), "v"(hi)); return r; }

struct UnitP { int seqbase, T, head, blk; };

__device__ __forceinline__ void partialSM(f32x16& p0, f32x16& p1, float& m_reg, float& alpha) {
  float pmax = p0[0];
#pragma unroll
  for (int r = 1; r < 16; ++r) pmax = fmaxf(pmax, p0[r]);
#pragma unroll
  for (int r = 0; r < 16; ++r) pmax = fmaxf(pmax, p1[r]);
  { auto rr = __builtin_amdgcn_permlane32_swap(__float_as_uint(pmax), __float_as_uint(pmax), false, false);
    pmax = fmaxf(__uint_as_float(rr[0]), __uint_as_float(rr[1])); }
  float mn;
  if (__builtin_expect(__all(pmax - m_reg <= THRX), 1)) { mn = m_reg; alpha = 1.f; }
  else { mn = fmaxf(m_reg, pmax); alpha = __builtin_amdgcn_exp2f(m_reg - mn); m_reg = mn; }
#pragma unroll
  for (int r = 0; r < 16; ++r) p0[r] = p0[r] - mn;
#pragma unroll
  for (int r = 0; r < 16; ++r) p1[r] = p1[r] - mn;
#pragma unroll
  for (int r = 0; r < 16; ++r) p0[r] = __builtin_amdgcn_exp2f(p0[r]);
}
__device__ __forceinline__ void finishSM(f32x16& p0, f32x16& p1, float alpha, float& l_reg, bf16x8& pa0, bf16x8& pa1, bf16x8& pa2, bf16x8& pa3) {
#pragma unroll
  for (int r = 0; r < 16; ++r) p1[r] = __builtin_amdgcn_exp2f(p1[r]);
  float ps = 0;
#pragma unroll
  for (int r = 0; r < 16; ++r) ps += p0[r];
#pragma unroll
  for (int r = 0; r < 16; ++r) ps += p1[r];
  { auto rr = __builtin_amdgcn_permlane32_swap(__float_as_uint(ps), __float_as_uint(ps), false, false);
    ps = __uint_as_float(rr[0]) + __uint_as_float(rr[1]); }
  l_reg = l_reg * alpha + ps;
#define PK4(P, BASE, OUT) do { unsigned a0 = cvtpk(P[BASE + 0], P[BASE + 1]), a1 = cvtpk(P[BASE + 2], P[BASE + 3]);   \
    unsigned b0 = cvtpk(P[BASE + 4], P[BASE + 5]), b1 = cvtpk(P[BASE + 6], P[BASE + 7]);                              \
    auto r0 = __builtin_amdgcn_permlane32_swap(a0, b0, false, false); auto r1 = __builtin_amdgcn_permlane32_swap(a1, b1, false, false); \
    u32x4 w = {r0[0], r1[0], r0[1], r1[1]}; OUT = *reinterpret_cast<bf16x8*>(&w); } while (0)
  PK4(p0, 0, pa0); PK4(p0, 8, pa1); PK4(p1, 0, pa2); PK4(p1, 8, pa3);
#undef PK4
}
__device__ __forceinline__ void qkt(f32x16& p0, f32x16& p1, const ALDS char* Ks, const bf16x8* qr, int r32, int hi) {
  p0 = f32x16{}; p1 = f32x16{};
#pragma unroll
  for (int d0 = 0; d0 < 8; ++d0) { int cb = (d0 * 16 + hi * 8) * 2;
    bf16x8 b0 = *(const ALDS bf16x8*)(Ks + KSWZ(r32, cb));
    bf16x8 b1 = *(const ALDS bf16x8*)(Ks + KSWZ(32 + r32, cb));
    p0 = __builtin_amdgcn_mfma_f32_32x32x16_bf16(b0, qr[d0], p0, 0, 0, 0);
    p1 = __builtin_amdgcn_mfma_f32_32x32x16_bf16(b1, qr[d0], p1, 0, 0, 0); }
}
__device__ __forceinline__ int v_st(int k, int c) { const int kk = (k & ~0xC) | ((k & 4) << 1) | ((k & 8) >> 1); return ((kk >> 3) * 4 + (c >> 5)) * 512 + ((kk & 7) * 32 + (c & 31)) * 2; }
__device__ __forceinline__ int v_rd_base(int lane) { return ((lane & 3) << 3) | (((lane >> 2) & 3) << 6) | (((lane >> 4) & 1) << 5) | (((lane >> 5) & 1) << 8); }
constexpr int v_rd_off(int d0, int ks, int half) { return d0 * 512 + ks * 4096 + half * 2048; }
template <int OFF> __device__ __forceinline__ s16x4 tr_read(int vb) {
  s16x4 r; asm volatile("ds_read_b64_tr_b16 %0, %1 offset:%2" : "=&v"(r) : "v"(vb), "i"(OFF) : "memory"); return r;
}
template <int D0> __device__ __forceinline__ void pv_one(f32x16& od, int vb, bf16x8 pa0, bf16x8 pa1, bf16x8 pa2, bf16x8 pa3) {
  const s16x4 l0 = tr_read<v_rd_off(D0, 0, 0)>(vb), h0 = tr_read<v_rd_off(D0, 0, 1)>(vb), l1 = tr_read<v_rd_off(D0, 1, 0)>(vb), h1 = tr_read<v_rd_off(D0, 1, 1)>(vb);
  const s16x4 l2 = tr_read<v_rd_off(D0, 2, 0)>(vb), h2 = tr_read<v_rd_off(D0, 2, 1)>(vb), l3 = tr_read<v_rd_off(D0, 3, 0)>(vb), h3 = tr_read<v_rd_off(D0, 3, 1)>(vb);
  asm volatile("s_waitcnt lgkmcnt(0)" ::: "memory"); SBAR();
#define PK(L, H) (bf16x8){L[0], L[1], L[2], L[3], H[0], H[1], H[2], H[3]}
  od = __builtin_amdgcn_mfma_f32_32x32x16_bf16(pa0, PK(l0, h0), od, 0, 0, 0);
  od = __builtin_amdgcn_mfma_f32_32x32x16_bf16(pa1, PK(l1, h1), od, 0, 0, 0);
  od = __builtin_amdgcn_mfma_f32_32x32x16_bf16(pa2, PK(l2, h2), od, 0, 0, 0);
  od = __builtin_amdgcn_mfma_f32_32x32x16_bf16(pa3, PK(l3, h3), od, 0, 0, 0);
#undef PK
}
__device__ __forceinline__ void pv_d0(f32x16* o, int vb, bf16x8 pa0, bf16x8 pa1, bf16x8 pa2, bf16x8 pa3) {
  pv_one<0>(o[0], vb, pa0, pa1, pa2, pa3); pv_one<1>(o[1], vb, pa0, pa1, pa2, pa3); pv_one<2>(o[2], vb, pa0, pa1, pa2, pa3); pv_one<3>(o[3], vb, pa0, pa1, pa2, pa3);
}
__device__ __forceinline__ float bf_lo(unsigned w) { return __uint_as_float(w << 16); }
__device__ __forceinline__ float bf_hi(unsigned w) { return __uint_as_float(w & 0xffff0000u); }

template <int KIND> __device__ __forceinline__ int tile_row(const UnitP& u, int j) {
  if (j == 0) return META_ROW;
  if (KIND == 0) { const int rows = u.T >> 6; int rs0 = 4 * u.blk - 4; rs0 = rs0 < 0 ? 0 : (rs0 > rows - 8 ? rows - 8 : rs0);
    int kr = rs0 + j - 1; kr = kr > rows - 1 ? rows - 1 : kr; return u.seqbase + 64 * kr; }
  else { int ks = 64 * u.blk + 64 * (j - 3); ks = ks < 0 ? 0 : (ks > u.T - 64 ? u.T - 64 : ks); return u.seqbase + ks; }
}


__device__ __forceinline__ void qkt1(f32x16& p, const ALDS char* Ks, const bf16x8* qr, int koff  , int r32, int hi) {
  p = f32x16{};
#pragma unroll
  for (int d0 = 0; d0 < 8; ++d0) { const int cb = (d0 * 16 + hi * 8) * 2;
    const bf16x8 b0 = *(const ALDS bf16x8*)(Ks + koff + (cb ^ ((r32 & 7) << 4)));
    p = __builtin_amdgcn_mfma_f32_32x32x16_bf16(b0, qr[d0], p, 0, 0, 0); }
}
__device__ __forceinline__ void partialSM1(f32x16& p, float& m_reg, float& alpha) {
  float pmax = p[0];
#pragma unroll
  for (int r = 1; r < 16; ++r) pmax = fmaxf(pmax, p[r]);
  { auto rr = __builtin_amdgcn_permlane32_swap(__float_as_uint(pmax), __float_as_uint(pmax), false, false);
    pmax = fmaxf(__uint_as_float(rr[0]), __uint_as_float(rr[1])); }
  float mn;
  if (__builtin_expect(__all(pmax - m_reg <= THRX), 1)) { mn = m_reg; alpha = 1.f; }
  else { mn = fmaxf(m_reg, pmax); alpha = __builtin_amdgcn_exp2f(m_reg - mn); m_reg = mn; }
#pragma unroll
  for (int r = 0; r < 16; ++r) p[r] = p[r] - mn;
#pragma unroll
  for (int r = 0; r < 8; ++r) p[r] = __builtin_amdgcn_exp2f(p[r]);
}
__device__ __forceinline__ void finishSM1(f32x16& p, float alpha, float& l_reg, bf16x8& pa0, bf16x8& pa1) {
#pragma unroll
  for (int r = 8; r < 16; ++r) p[r] = __builtin_amdgcn_exp2f(p[r]);
  float ps = 0;
#pragma unroll
  for (int r = 0; r < 16; ++r) ps += p[r];
  { auto rr = __builtin_amdgcn_permlane32_swap(__float_as_uint(ps), __float_as_uint(ps), false, false);
    ps = __uint_as_float(rr[0]) + __uint_as_float(rr[1]); }
  l_reg = l_reg * alpha + ps;
#define PK4(P, BASE, OUT) do { unsigned a0 = cvtpk(P[BASE + 0], P[BASE + 1]), a1 = cvtpk(P[BASE + 2], P[BASE + 3]);   \
    unsigned b0 = cvtpk(P[BASE + 4], P[BASE + 5]), b1 = cvtpk(P[BASE + 6], P[BASE + 7]);                              \
    auto r0 = __builtin_amdgcn_permlane32_swap(a0, b0, false, false); auto r1 = __builtin_amdgcn_permlane32_swap(a1, b1, false, false); \
    u32x4 w = {r0[0], r1[0], r0[1], r1[1]}; OUT = *reinterpret_cast<bf16x8*>(&w); } while (0)
  PK4(p, 0, pa0); PK4(p, 8, pa1);
#undef PK4
}
template <int D0> __device__ __forceinline__ void pv2_one(f32x16& od, int vbA, int vbB, bf16x8 pa0, bf16x8 pa1) {
  const s16x4 l0 = tr_read<D0 * 512>(vbA), h0 = tr_read<D0 * 512 + 2048>(vbA), l1 = tr_read<D0 * 512>(vbB), h1 = tr_read<D0 * 512 + 2048>(vbB);
  asm volatile("s_waitcnt lgkmcnt(0)" ::: "memory"); SBAR();
#define PK(L, H) (bf16x8){L[0], L[1], L[2], L[3], H[0], H[1], H[2], H[3]}
  od = __builtin_amdgcn_mfma_f32_32x32x16_bf16(pa0, PK(l0, h0), od, 0, 0, 0);
  od = __builtin_amdgcn_mfma_f32_32x32x16_bf16(pa1, PK(l1, h1), od, 0, 0, 0);
#undef PK
}
__device__ __forceinline__ void pv2(f32x16* o, int vbA, int vbB, bf16x8 pa0, bf16x8 pa1) {
  pv2_one<0>(o[0], vbA, vbB, pa0, pa1); pv2_one<1>(o[1], vbA, vbB, pa0, pa1); pv2_one<2>(o[2], vbA, vbB, pa0, pa1); pv2_one<3>(o[3], vbA, vbB, pa0, pa1);
}

constexpr int RB = 32768, NRB = 3, D_OFF_WS = NRB * RB, D_OFF_TAB = D_OFF_WS + 2048, D_ATT_LDS = D_OFF_TAB + 15 * 128 * 4;
struct DmaSrc { const bf16* k[2]; const bf16* v[2]; };
__device__ __forceinline__ DmaSrc dma_src(const bf16* P, int kcol, int vcol, int wid, int lane) {
  DmaSrc s;
#pragma unroll
  for (int i = 0; i < 2; ++i) {
    const int piece = i * 8 + wid;
    { const int row = piece * 4 + (lane >> 4), chunk = (lane & 15) ^ (row & 7); s.k[i] = P + ((size_t)(kcol >> 7) * PROWS + row) * 128 + chunk * 8; }
    { const int sub = piece * 2 + (lane >> 5), kk = (sub >> 2) * 8 + ((lane >> 2) & 7), c = (sub & 3) * 32 + (lane & 3) * 8;
      const int k = (kk & ~0xC) | ((kk & 4) << 1) | ((kk & 8) >> 1); s.v[i] = P + ((size_t)(vcol >> 7) * PROWS + k) * 128 + c; }
  }
  return s;
}
#define DMA_WAIT_BAR(last) do { if (last) asm volatile("s_waitcnt vmcnt(0) lgkmcnt(0)" ::: "memory"); else asm volatile("s_waitcnt vmcnt(4) lgkmcnt(0)" ::: "memory"); \
    __builtin_amdgcn_s_barrier(); asm volatile("" ::: "memory"); } while (0)
#define PK4(P, BASE, OUT) do { unsigned a0 = cvtpk(P[BASE + 0], P[BASE + 1]), a1 = cvtpk(P[BASE + 2], P[BASE + 3]);   \
    unsigned b0 = cvtpk(P[BASE + 4], P[BASE + 5]), b1 = cvtpk(P[BASE + 6], P[BASE + 7]);                              \
    auto r0 = __builtin_amdgcn_permlane32_swap(a0, b0, false, false); auto r1 = __builtin_amdgcn_permlane32_swap(a1, b1, false, false); \
    u32x4 w = {r0[0], r1[0], r0[1], r1[1]}; OUT = *reinterpret_cast<bf16x8*>(&w); } while (0)
#define ATT_EPILOGUE(OROW_EXPR, SSQ_IDX) do { \
  unsigned ze_ = 0u; asm volatile("" : "+s"(ze_)); const int lane_e = (int)__builtin_amdgcn_mbcnt_hi(~0u, __builtin_amdgcn_mbcnt_lo(~0u, ze_)), r32e = lane_e & 31, hie = lane_e >> 5; \
  if (hie == 0) li_l[r32e] = l_reg; asm volatile("s_waitcnt lgkmcnt(0)" ::: "memory"); \
  ALDS unsigned short* stg = (ALDS unsigned short*)(lds + wid * 8192); \
  _Pragma("unroll") for (int r = 0; r < 16; ++r) { const int orow = crow(r, hie); const float rl = __builtin_amdgcn_rcpf(li_l[orow]); \
    _Pragma("unroll") for (int d0 = 0; d0 < 4; ++d0) stg[orow * 128 + d0 * 32 + r32e] = (unsigned short)(cvtpk(o[d0][r] * rl, 0.f) & 0xffffu); } \
  asm volatile("s_waitcnt lgkmcnt(0)" ::: "memory"); \
  const int q = lane_e >> 1, half = lane_e & 1; float ss = 0.f; \
  const size_t orow_g = (size_t)(OROW_EXPR); \
  bf16* og = O + orow_g * LDO + ocol + half * 64; \
  _Pragma("unroll") for (int i = 0; i < 8; ++i) { const u32x4 v = *(const ALDS u32x4*)(stg + q * 128 + half * 64 + i * 8); \
    ss += bf_lo(v.x) * bf_lo(v.x) + bf_hi(v.x) * bf_hi(v.x) + bf_lo(v.y) * bf_lo(v.y) + bf_hi(v.y) * bf_hi(v.y) \
        + bf_lo(v.z) * bf_lo(v.z) + bf_hi(v.z) * bf_hi(v.z) + bf_lo(v.w) * bf_lo(v.w) + bf_hi(v.w) * bf_hi(v.w); \
    *(u32x4*)(og + i * 8) = v; } \
  ss += __builtin_bit_cast(float, __builtin_amdgcn_update_dpp(0, __builtin_bit_cast(int, ss), 0xB1, 0xF, 0xF, false)); \
  if (half == 0 && do_ssq) atomicAdd(ssq + orow_g * 2 + (SSQ_IDX), ss); } while (0)


constexpr int P_VOFF = 0, P_KOFF = 4 * 16384, P_OFF_WS = P_KOFF + 3 * 16384, P_OFF_TAB = P_OFF_WS + 2048, P_ATT_LDS = P_OFF_TAB + 15 * 128 * 4;
__device__ __forceinline__ void dma_tile_kv(const DmaSrc& s, size_t rowoff, ALDS char* vslot, ALDS char* kslot, int wid) {
#pragma unroll
  for (int i = 0; i < 2; ++i) {
    __builtin_amdgcn_global_load_lds((const unsigned*)(s.v[i] + rowoff), (ALDS unsigned*)(vslot + (i * 8 + wid) * 1024), 16, 0, 0);
    __builtin_amdgcn_global_load_lds((const unsigned*)(s.k[i] + rowoff), (ALDS unsigned*)(kslot + (i * 8 + wid) * 1024), 16, 0, 0);
  }
}
#define RESC4(a) do { if (__any((a) < 1.f)) { if (hi == 0) al_l[r32] = (a); asm volatile("s_waitcnt lgkmcnt(0)" ::: "memory"); \
    _Pragma("unroll") for (int r = 0; r < 16; ++r) { const float a_ = al_l[crow(r, hi)]; _Pragma("unroll") for (int d = 0; d < 4; ++d) o[d][r] *= a_; } } } while (0)
#define STEP_ENTER(TR, j) do { DMA_WAIT_BAR((j) + 1 >= NT); \
    if ((j) + 2 < NT) { const int k2_ = k3 == 0 ? 2 : k3 - 1; dma_tile_kv(src, (size_t)TR(u, (j) + 2) * 128, lds + P_VOFF + (((j) + 2) & 3) * 16384, lds + P_KOFF + k2_ * 16384, wid); } } while (0)
#define STEP_LEAVE() do { k3 = k3 == 2 ? 0 : k3 + 1; } while (0)

__device__ __forceinline__ void attn_unit_na4(const UnitP u, const bf16* __restrict__ P, bf16* __restrict__ O, float* __restrict__ ssq,
                                              const float* __restrict__ rpb, ALDS char* lds, const int wave_id, const bool do_ssq = true) {
  constexpr int NT = 12;
  unsigned zero_ = 0u; asm volatile("" : "+s"(zero_));
  int tid = wave_id * 64 + (int)__builtin_amdgcn_mbcnt_hi(~0u, __builtin_amdgcn_mbcnt_lo(~0u, zero_)); asm volatile("" : "+v"(tid));
  const int wid = __builtin_amdgcn_readfirstlane(tid >> 6), lane = tid & 63, r32 = lane & 31, hi = lane >> 5;
  ALDS float* wsf = (ALDS float*)(lds + P_OFF_WS) + wid * 64; ALDS float* li_l = wsf; ALDS float* al_l = wsf + 32;
  ALDS float* tab = (ALDS float*)(lds + P_OFF_TAB);
  const int rows = u.T >> 6, rp = wid >> 2, cg = wid & 3, R0 = 4 * u.blk + 2 * rp;
  const int kbA = cg == 0 ? 0 : cg - 1, kbB = cg == 0 ? 3 : cg;
  const int qi = r32 & 15, Rq = R0 + (r32 >> 4);
  const int qc = cg == 0 ? (qi < 8 ? qi : 48 + qi) : 16 * cg - 8 + qi;
  const int qrow = u.seqbase + 64 * Rq + qc;
  const int kcol = 2048 + 128 * u.head, vcol = 4096 + 128 * u.head, ocol = 128 * u.head;
  int rs0 = 4 * u.blk - 4; rs0 = rs0 < 0 ? 0 : (rs0 > rows - 8 ? rows - 8 : rs0);
  const int koffT = ((r32 < 16 ? 16 * kbA : 16 * kbB - 16) + r32) * 256;
  const DmaSrc src = dma_src(P, kcol, vcol, wid, lane);
  dma_tile_kv(src, (size_t)tile_row<0>(u, 0) * 128, lds + P_VOFF, lds + P_KOFF, wid); dma_tile_kv(src, (size_t)tile_row<0>(u, 1) * 128, lds + P_VOFF + 16384, lds + P_KOFF + 16384, wid);
  for (int idx = tid; idx < 15 * 128; idx += 512) { const int ir = idx >> 7, e = (idx & 127) - 48;
    tab[idx] = (e >= 0 && e <= 30) ? rpb[u.head * 465 + ir * 31 + e] * LOG2E : 0.f; }
  float m_reg = -1e30f, l_reg = 0; f32x16 o[4] = {}; bf16x8 qr[8];
  { const bf16* Qw = P + ((size_t)u.head * PROWS + qrow) * 128 + hi * 8;
#pragma unroll
    for (int d0 = 0; d0 < 8; ++d0) qr[d0] = *reinterpret_cast<const bf16x8*>(Qw + d0 * 16); }
#pragma unroll
  for (int d0 = 0; d0 < 8; ++d0) asm volatile("" :: "v"(qr[d0]));
  asm volatile("s_waitcnt vmcnt(0)" ::: "memory");
  const int vrd = (int)(unsigned)(__SIZE_TYPE__)lds + P_VOFF + v_rd_base(lane);
#define APPLY4(PP, j) do { int qc_ = qc, Rq_ = Rq; asm volatile("" : "+v"(qc_), "+v"(Rq_)); \
    const int kr_ = rs0 + (j) - 1; int rsR_ = Rq_ - 4; rsR_ = rsR_ < 0 ? 0 : (rsR_ > rows - 8 ? rows - 8 : rsR_); int cs_ = qc_ - 8; cs_ = cs_ < 0 ? 0 : (cs_ > 48 ? 48 : cs_); \
    const bool rv_ = (kr_ < rows) && (kr_ >= rsR_) && (kr_ < rsR_ + 8); \
    int ir_ = kr_ - Rq_ + 7; ir_ = ir_ < 0 ? 0 : (ir_ > 14 ? 14 : ir_); \
    const ALDS float* tA_ = tab + ir_ * 128 + (63 - qc_ + 16 * kbA + 4 * hi); const ALDS float* tB_ = tA_ + 16 * (kbB - kbA); \
    const int uA_ = rv_ ? 16 * kbA + 4 * hi - cs_ : 4096, uB_ = rv_ ? 16 * kbB + 4 * hi - cs_ : 4096; \
    _Pragma("unroll") for (int r = 0; r < 8; ++r) { const int of_ = (r & 3) + 8 * (r >> 2); PP[r] = ((unsigned)(of_ + uA_) < 16u) ? PP[r] + tA_[of_] : NEG; } \
    _Pragma("unroll") for (int r = 8; r < 16; ++r) { const int of_ = (r & 3) + 8 * ((r >> 2) - 2); PP[r] = ((unsigned)(of_ + uB_) < 16u) ? PP[r] + tB_[of_] : NEG; } } while (0)
  f32x16 pA, pB; float alA, alB; bf16x8 pa0, pa1;
  int k3 = 0;
  STEP_ENTER(tile_row<0>, 0);
  qkt1(pA, lds + P_KOFF, qr, r32 * 256, r32, hi);
#pragma unroll
  for (int r = 8; r < 16; ++r) pA[r] = NEG;
  partialSM1(pA, m_reg, alA);
  STEP_LEAVE();
#pragma unroll 1
  for (int j = 1; j + 1 < NT; j += 2) {
    STEP_ENTER(tile_row<0>, j);
    { const int vb = vrd + ((j - 1) & 3) * 16384;
      SBAR(); qkt1(pB, lds + P_KOFF + k3 * 16384, qr, koffT, r32, hi);
      finishSM1(pA, alA, l_reg, pa0, pa1); SBAR();
      if (j == 1) pv2(o, vb, vb + 4096, pa0, pa1); else pv2(o, vb + kbA * 4096, vb + kbB * 4096, pa0, pa1);
      APPLY4(pB, j); partialSM1(pB, m_reg, alB);
      RESC4(alB); }
    STEP_LEAVE();
    STEP_ENTER(tile_row<0>, j + 1);
    { const int vb = vrd + (j & 3) * 16384;
      SBAR(); qkt1(pA, lds + P_KOFF + k3 * 16384, qr, koffT, r32, hi);
      finishSM1(pB, alB, l_reg, pa0, pa1); SBAR();
      pv2(o, vb + kbA * 4096, vb + kbB * 4096, pa0, pa1);
      APPLY4(pA, j + 1); partialSM1(pA, m_reg, alA);
      RESC4(alA); }
    STEP_LEAVE();
  }
  STEP_ENTER(tile_row<0>, NT - 1);
  { const int vb = vrd + ((NT - 2) & 3) * 16384, vbl = vrd + ((NT - 1) & 3) * 16384;
    SBAR(); qkt1(pB, lds + P_KOFF + k3 * 16384, qr, koffT, r32, hi);
    finishSM1(pA, alA, l_reg, pa0, pa1); SBAR();
    pv2(o, vb + kbA * 4096, vb + kbB * 4096, pa0, pa1);
    APPLY4(pB, NT - 1); partialSM1(pB, m_reg, alB);
    RESC4(alB);
    finishSM1(pB, alB, l_reg, pa0, pa1); SBAR();
    pv2(o, vbl + kbA * 4096, vbl + kbB * 4096, pa0, pa1); }
#undef APPLY4
  asm volatile("s_waitcnt lgkmcnt(0)" ::: "memory"); __builtin_amdgcn_s_barrier(); asm volatile("" ::: "memory");
  ATT_EPILOGUE(u.seqbase + 64 * (R0 + (q >> 4)) + (cg == 0 ? ((q & 15) < 8 ? (q & 15) : 48 + (q & 15)) : 16 * cg - 8 + (q & 15)), 0);
  asm volatile("s_waitcnt lgkmcnt(0)" ::: "memory"); __builtin_amdgcn_s_barrier(); asm volatile("" ::: "memory");
}
__device__ __forceinline__ void attn_unit_sw4(const UnitP u, const bf16* __restrict__ P, bf16* __restrict__ O, float* __restrict__ ssq,
                                              const float* __restrict__ sinkp, ALDS char* lds, const int wave_id, const bool do_ssq = true) {
  constexpr int NT = 6;
  unsigned zero_ = 0u; asm volatile("" : "+s"(zero_));
  int tid = wave_id * 64 + (int)__builtin_amdgcn_mbcnt_hi(~0u, __builtin_amdgcn_mbcnt_lo(~0u, zero_)); asm volatile("" : "+v"(tid));
  const int wid = __builtin_amdgcn_readfirstlane(tid >> 6), lane = tid & 63, r32 = lane & 31, hi = lane >> 5;
  ALDS float* wsf = (ALDS float*)(lds + P_OFF_WS) + wid * 64; ALDS float* li_l = wsf; ALDS float* al_l = wsf + 32;
  ALDS float* tab = (ALDS float*)(lds + P_OFF_TAB);
  const int hq = 4 * u.head + (wid >> 1), tq = 64 * u.blk + 32 * (wid & 1) + r32;
  const int orow0 = u.seqbase + 64 * u.blk + 32 * (wid & 1), qrow = orow0 + r32;
  const int kcol = 8192 + 128 * u.head, vcol = 8704 + 128 * u.head, ocol = 2048 + 128 * hq;
  const float slope2 = __builtin_amdgcn_exp2f(-0.5f * (float)(hq + 1)) * LOG2E, sink2 = sinkp[hq] * LOG2E;
  const DmaSrc src = dma_src(P, kcol, vcol, wid, lane);
  dma_tile_kv(src, (size_t)tile_row<1>(u, 0) * 128, lds + P_VOFF, lds + P_KOFF, wid); dma_tile_kv(src, (size_t)tile_row<1>(u, 1) * 128, lds + P_VOFF + 16384, lds + P_KOFF + 16384, wid);
  for (int idx = tid; idx < 4 * 384; idx += 512) { const int hh = idx / 384, i = idx - hh * 384; int d = 191 - i; d = d < 0 ? -d : d;
    tab[idx] = (d <= 128) ? -(__builtin_amdgcn_exp2f(-0.5f * (float)(4 * u.head + hh + 1)) * LOG2E) * (float)d : NEG; }
  float m_reg = -1e30f, l_reg = 0; f32x16 o[4] = {}; bf16x8 qr[8];
  { const bf16* Qw = P + ((size_t)(48 + hq) * PROWS + qrow) * 128 + hi * 8;
#pragma unroll
    for (int d0 = 0; d0 < 8; ++d0) qr[d0] = *reinterpret_cast<const bf16x8*>(Qw + d0 * 16); }
#pragma unroll
  for (int d0 = 0; d0 < 8; ++d0) asm volatile("" :: "v"(qr[d0]));
  asm volatile("s_waitcnt vmcnt(0)" ::: "memory");
  const int vrd = (int)(unsigned)(__SIZE_TYPE__)lds + P_VOFF + v_rd_base(lane);
#define APPLYS(P0, P1, j) do { const int ks_ = 64 * u.blk + 64 * ((j) - 3); \
    if (ks_ >= 0 && ks_ < u.T) { int tq_ = tq; asm volatile("" : "+v"(tq_)); const ALDS float* tb_ = tab + (wid >> 1) * 384 + (191 - (tq_ - ks_ - 4 * hi)); \
      _Pragma("unroll") for (int r = 0; r < 16; ++r) { const int kc0_ = (r & 3) + 8 * (r >> 2); P0[r] = P0[r] + tb_[kc0_]; P1[r] = P1[r] + tb_[kc0_ + 32]; } } \
    else { _Pragma("unroll") for (int r = 0; r < 16; ++r) { P0[r] = NEG; P1[r] = NEG; } } } while (0)
  f32x16 pA0, pA1, pB0, pB1; float alA, alB; bf16x8 pa0, pa1, pa2, pa3;
  int k3 = 0;
  const bool lead = wid < 4;
#define SW_STEP_A(N0, N1, alN, O0, O1, alO, vb, jj) do { SBAR(); qkt(N0, N1, lds + P_KOFF + k3 * 16384, qr, r32, hi); \
      finishSM(O0, O1, alO, l_reg, pa0, pa1, pa2, pa3); SBAR(); \
      pv_d0(o, vb, pa0, pa1, pa2, pa3); \
      APPLYS(N0, N1, jj); partialSM(N0, N1, m_reg, alN); \
      RESC4(alN); } while (0)
#define SW_STEP_B(N0, N1, alN, O0, O1, alO, vb, jj) do { SBAR(); finishSM(O0, O1, alO, l_reg, pa0, pa1, pa2, pa3); SBAR(); \
      qkt(N0, N1, lds + P_KOFF + k3 * 16384, qr, r32, hi); SBAR(); \
      APPLYS(N0, N1, jj); partialSM(N0, N1, m_reg, alN); SBAR(); \
      pv_d0(o, vb, pa0, pa1, pa2, pa3); \
      RESC4(alN); } while (0)
  STEP_ENTER(tile_row<1>, 0);
  qkt(pA0, pA1, lds + P_KOFF, qr, r32, hi);
#pragma unroll
  for (int r = 0; r < 8; ++r) { const int md_ = 16 + tq - crow(r, hi); pA0[r] = pA0[r] - slope2 * (float)(md_ > 128 ? 128 : md_); }
#pragma unroll
  for (int r = 8; r < 16; ++r) pA0[r] = NEG;
#pragma unroll
  for (int r = 0; r < 16; ++r) pA1[r] = NEG;
  partialSM(pA0, pA1, m_reg, alA);
  STEP_LEAVE();
  if (lead) {
#pragma unroll 1
    for (int j = 1; j + 1 < NT; j += 2) {
      STEP_ENTER(tile_row<1>, j);
      { const int vb = vrd + ((j - 1) & 3) * 16384; SW_STEP_A(pB0, pB1, alB, pA0, pA1, alA, vb, j); }
      STEP_LEAVE();
      STEP_ENTER(tile_row<1>, j + 1);
      { const int vb = vrd + (j & 3) * 16384; SW_STEP_A(pA0, pA1, alA, pB0, pB1, alB, vb, j + 1); }
      STEP_LEAVE();
    }
    STEP_ENTER(tile_row<1>, NT - 1);
    { const int vb = vrd + ((NT - 2) & 3) * 16384, vbl = vrd + ((NT - 1) & 3) * 16384;
      SW_STEP_A(pB0, pB1, alB, pA0, pA1, alA, vb, NT - 1);
      finishSM(pB0, pB1, alB, l_reg, pa0, pa1, pa2, pa3); SBAR();
      pv_d0(o, vbl, pa0, pa1, pa2, pa3); }
  } else {
#pragma unroll 1
    for (int j = 1; j + 1 < NT; j += 2) {
      STEP_ENTER(tile_row<1>, j);
      { const int vb = vrd + ((j - 1) & 3) * 16384; SW_STEP_B(pB0, pB1, alB, pA0, pA1, alA, vb, j); }
      STEP_LEAVE();
      STEP_ENTER(tile_row<1>, j + 1);
      { const int vb = vrd + (j & 3) * 16384; SW_STEP_B(pA0, pA1, alA, pB0, pB1, alB, vb, j + 1); }
      STEP_LEAVE();
    }
    STEP_ENTER(tile_row<1>, NT - 1);
    { const int vb = vrd + ((NT - 2) & 3) * 16384, vbl = vrd + ((NT - 1) & 3) * 16384;
      SW_STEP_B(pB0, pB1, alB, pA0, pA1, alA, vb, NT - 1);
      finishSM(pB0, pB1, alB, l_reg, pa0, pa1, pa2, pa3); SBAR();
      pv_d0(o, vbl, pa0, pa1, pa2, pa3); }
  }
#undef APPLYS
#undef SW_STEP_A
#undef SW_STEP_B
  l_reg += __builtin_amdgcn_exp2f(sink2 - m_reg);
  asm volatile("s_waitcnt lgkmcnt(0)" ::: "memory"); __builtin_amdgcn_s_barrier(); asm volatile("" ::: "memory");
  ATT_EPILOGUE(orow0 + q, 1);
  asm volatile("s_waitcnt lgkmcnt(0)" ::: "memory"); __builtin_amdgcn_s_barrier(); asm volatile("" ::: "memory");
}
#undef RESC4
#undef STEP_ENTER
#undef STEP_LEAVE
#undef PK4
#undef DMA_WAIT_BAR
#undef ATT_EPILOGUE
#undef KSWZ
#undef SBAR
}

#define GAS __attribute__((address_space(1)))
#define LAS __attribute__((address_space(3)))
typedef unsigned short bf16;
typedef unsigned v4u __attribute__((ext_vector_type(4)));
typedef float f32x4 __attribute__((ext_vector_type(4)));
typedef short bf16x8 __attribute__((ext_vector_type(8)));
typedef GAS unsigned gu32;
typedef GAS unsigned long long gu64;
#define RLX_AGENT __ATOMIC_RELAXED, __HIP_MEMORY_SCOPE_AGENT
#define LDS_WAIT() asm volatile("s_waitcnt lgkmcnt(0)" ::: "memory")
#define VM_WAIT() asm volatile("s_waitcnt vmcnt(0)" ::: "memory")
__device__ __forceinline__ unsigned long long rt() { return __builtin_amdgcn_s_memrealtime(); }
__device__ __forceinline__ unsigned f2bf(float f) { unsigned u = __builtin_bit_cast(unsigned, f); return (u + 0x7fffu + ((u >> 16) & 1u)) >> 16; }
__device__ __forceinline__ unsigned pk2(float lo, float hi) { return f2bf(lo) | (f2bf(hi) << 16); }

#define XB_TMO      128
#define XB_XCNT(j)  (256  + 64 * (j))
#define XB_XSUB(j)  (1280 + 64 * (j))
#define XB_XGEN(j)  (2304 + 64 * (j))
#define XB_TOP      3328
#define XB_TOPGEN   3392
#define XCD_BAR_WORDS 3456
#define XB_SPIN_CAP (1u << 18)

__device__ __forceinline__ unsigned xb_ld(unsigned* p)              { return __hip_atomic_load(p, __ATOMIC_RELAXED, __HIP_MEMORY_SCOPE_AGENT); }
__device__ __forceinline__ unsigned xb_add(unsigned* p, unsigned v) { return __hip_atomic_fetch_add(p, v, __ATOMIC_RELAXED, __HIP_MEMORY_SCOPE_AGENT); }
__device__ __forceinline__ unsigned xb_xcc_id() { return (unsigned)__builtin_amdgcn_s_getreg((3 << 11) | 20) & 0xFu; }
#define XB_SPIN(cond, bar) do { unsigned _sp = 0; while (cond) { __builtin_amdgcn_s_sleep(1); \
    if ((++_sp & 255u) == 0u) { if (xb_ld(&(bar)[XB_TMO])) break; if (_sp > XB_SPIN_CAP) { atomicAdd(&(bar)[XB_TMO], 1u); break; } } } } while (0)

struct XcdBarrier {
    unsigned* bar; unsigned x; bool t0;
    volatile LAS unsigned* st;
};

__device__ __forceinline__ XcdBarrier xcd_barrier_post(unsigned* bar, volatile LAS unsigned* st, bool t0) {
    XcdBarrier b; b.bar = bar; b.x = xb_xcc_id(); b.st = st; b.t0 = t0;
    if (t0) (void)xb_add(&bar[XB_XCNT(b.x)], 1u);
    return b;
}
__device__ __forceinline__ void xcd_barrier_complete(unsigned* bar, unsigned x, unsigned& nloc, unsigned& nx) {
    const unsigned G = gridDim.x * gridDim.y * gridDim.z;
    unsigned sum, cnt, mine, sp = 0u;
    for (;;) {
        sum = 0u; cnt = 0u; mine = 0u;
#pragma unroll
        for (unsigned j = 0; j < 16; ++j) { const unsigned c = xb_ld(&bar[XB_XCNT(j)]); sum += c; cnt += (c > 0u) ? 1u : 0u; mine = (j == x) ? c : mine; }
        if (sum == G) break;
        __builtin_amdgcn_s_sleep(1);
        if ((++sp & 255u) == 0u) { if (xb_ld(&bar[XB_TMO])) break; if (sp > XB_SPIN_CAP) { atomicAdd(&bar[XB_TMO], 1u); break; } }
    }
    nloc = mine > 0u ? mine : 1u; nx = cnt > 0u ? cnt : 1u;
}

__device__ __forceinline__ void xcd_barrier(const XcdBarrier& b) {
    asm volatile("s_waitcnt vmcnt(0)" ::: "memory");
    __syncthreads();
    if (b.t0) {
        unsigned* bar = b.bar;
        __builtin_amdgcn_s_waitcnt(0);
        unsigned nloc = b.st[0], nx = b.st[1];
        if (nloc == 0u) { xcd_barrier_complete(bar, b.x, nloc, nx); b.st[0] = nloc; b.st[1] = nx; }
        const unsigned old = xb_add(&bar[XB_XSUB(b.x)], 1u);
        const unsigned gen = old / nloc;
        if (old + 1u == (gen + 1u) * nloc) {
            __builtin_amdgcn_fence(__ATOMIC_RELEASE, "agent");
            asm volatile("s_waitcnt vmcnt(0)" ::: "memory");
            const unsigned og = xb_add(&bar[XB_TOP], 1u);
            const unsigned tg = og / nx;
            if (og + 1u == (tg + 1u) * nx) xb_add(&bar[XB_TOPGEN], 1u);
            else XB_SPIN(xb_ld(&bar[XB_TOPGEN]) == tg, bar);
            __builtin_amdgcn_fence(__ATOMIC_ACQUIRE, "agent");
            xb_add(&bar[XB_XGEN(b.x)], 1u);
            asm volatile("s_waitcnt vmcnt(0)" ::: "memory");
        } else {
            XB_SPIN(xb_ld(&bar[XB_XGEN(b.x)]) == gen, bar);
            __builtin_amdgcn_fence(__ATOMIC_ACQUIRE, "agent");
            asm volatile("s_waitcnt vmcnt(0)" ::: "memory");
        }
    }
    __syncthreads();
}
#ifndef P4_INT8
#define P4_INT8 0
#endif
#ifndef WGM_P7
#define WGM_P7 2
#endif
#ifndef WGM_P1
#define WGM_P1 4
#endif
#ifndef WGM_P4
#define WGM_P4 4
#endif
#ifndef REP_P2
#define REP_P2 1
#endif
#ifndef REP_P6
#define REP_P6 1
#endif
#ifndef REP_P0
#define REP_P0 1
#endif
#ifndef REP_NA
#define REP_NA 1
#endif
#ifndef REP_SW
#define REP_SW 1
#endif
constexpr int NWAVES = 8;
constexpr int DM = 4096, TP = 16384, TS = 4096, MREAL = 24576, NMETA = 16, MPAD = 24832;
constexpr int DIN = 9216, DFF = 11008, NGU = 2 * DFF;
constexpr float EPS = 1e-6f;
constexpr float QSCALE = 0.08838834764831845f * 1.4426950408889634f;

constexpr size_t MiB = 1u << 20;
constexpr size_t WS_CTL = 0, CTL_ZERO_BYTES = 1 * MiB;
constexpr size_t WS_ACC2 = 256 * 1024;
constexpr size_t WS_WIN = 4 * MiB;
constexpr size_t WS_WOUT = WS_WIN + (size_t)DIN * DM * 2;
constexpr size_t WS_WGU = WS_WOUT + (size_t)DM * DM * 2;
constexpr size_t WS_WDN = WS_WGU + (size_t)NGU * DM * 2;
constexpr size_t WS_A = WS_WDN + (size_t)DM * DFF * 2;
constexpr size_t WS_B = WS_A + (size_t)MPAD * DM * 2;
constexpr size_t WS_END = WS_B + (size_t)MREAL * DFF * 2;
static_assert((size_t)MPAD * DIN * 2 <= (size_t)MREAL * DFF * 2, "proj fits the act region");
constexpr size_t WS_RSX = 768 * 1024;
constexpr size_t WS_ACTMAX = 896 * 1024;
constexpr size_t WS_CMAXD = 480 * 1024;
constexpr size_t WS_ACT8 = WS_WIN;
constexpr size_t WS_CMAXO = 736 * 1024;
constexpr size_t WS_ONSC = 1 * MiB;
constexpr size_t WS_ON8 = WS_B + 256 * MiB;
constexpr size_t WS_SCALEA = 512 * 1024;
constexpr size_t WS_COLMAX = 640 * 1024;
constexpr int CW_BAR = 4096;
static_assert(WS_ACC2 + (size_t)MREAL * 2 * 4 <= WS_SCALEA && WS_SCALEA + (size_t)MREAL * 4 <= WS_COLMAX && WS_COLMAX + (size_t)NGU * 4 <= WS_CMAXO && WS_CMAXO + (size_t)DM * 4 <= WS_RSX && WS_ACC2 + (size_t)MREAL * 8 <= WS_CMAXD && WS_CMAXD + (size_t)DM * 4 <= WS_SCALEA && WS_ACT8 + (size_t)MREAL * DFF <= WS_WDN && WS_RSX + (size_t)MREAL * 4 <= WS_ACTMAX && WS_ACTMAX + (size_t)MREAL * 4 <= CTL_ZERO_BYTES && WS_ONSC + (size_t)MREAL * 8 <= WS_WIN && (size_t)MREAL * DM * 2 <= 256 * MiB && 256 * MiB + (size_t)MREAL * DM <= (size_t)MREAL * DFF * 2 && WS_RSX + (size_t)MREAL * 4 <= CTL_ZERO_BYTES && (size_t)MREAL * DM <= (size_t)(DIN + DM) * DM * 2 && (CW_BAR + XCD_BAR_WORDS) * 4 <= (int)WS_ACC2, "control region map");

constexpr int RING_OFF = 0, RING_BYTES = 131072;
constexpr int LDSCTL_OFF = RING_BYTES, MISC_OFF = LDSCTL_OFF + 320;
constexpr int OG_OFF = 94208;
constexpr int SLAB_RED_OFF = 90112;
#ifndef SLAB0
#define SLAB0 412
#endif
constexpr int P0_SCR = 8448, GAIN_OFF = 69632;
constexpr int LDS_BYTES = 147456;
static_assert(MISC_OFF + 128 <= LDS_BYTES && NWAVES * P0_SCR <= GAIN_OFF && GAIN_OFF + 16384 <= RING_BYTES && att::P_ATT_LDS <= RING_BYTES && att::PROWS == MPAD, "LDS map");

__device__ __forceinline__ unsigned pkbf(float lo, float hi) { return pg8::cvt_pk_bf16(lo, hi); }
__device__ __forceinline__ int lane_id() { unsigned z = 0u; asm volatile("" : "+s"(z)); return (int)__builtin_amdgcn_mbcnt_hi(~0u, __builtin_amdgcn_mbcnt_lo(~0u, z)); }
struct Frame {
    LAS unsigned char* lds;
    volatile LAS unsigned* MISC;
    int wave;
    int vcu, G;
};
template <int PAT> __device__ __forceinline__ float swz_xor(float v) { return __builtin_bit_cast(float, __builtin_amdgcn_ds_swizzle(__builtin_bit_cast(int, v), PAT)); }
__device__ __forceinline__ float wave_sum(float v) {
    v += swz_xor<(1 << 10) | 0x1f>(v); v += swz_xor<(2 << 10) | 0x1f>(v); v += swz_xor<(4 << 10) | 0x1f>(v); v += swz_xor<(8 << 10) | 0x1f>(v); v += swz_xor<(16 << 10) | 0x1f>(v);
    const auto rr = __builtin_amdgcn_permlane32_swap(__float_as_uint(v), __float_as_uint(v), false, false);
    return __uint_as_float(rr[0]) + __uint_as_float(rr[1]);
}
__device__ __forceinline__ float wave_max(float v) {
    v = fmaxf(v, swz_xor<(1 << 10) | 0x1f>(v)); v = fmaxf(v, swz_xor<(2 << 10) | 0x1f>(v)); v = fmaxf(v, swz_xor<(4 << 10) | 0x1f>(v)); v = fmaxf(v, swz_xor<(8 << 10) | 0x1f>(v)); v = fmaxf(v, swz_xor<(16 << 10) | 0x1f>(v));
    const auto rr = __builtin_amdgcn_permlane32_swap(__float_as_uint(v), __float_as_uint(v), false, false);
    return fmaxf(__uint_as_float(rr[0]), __uint_as_float(rr[1]));
}
struct WItem { const float* W; bf16* WT; const float* kscale; float* cmax; int K, N, k0, n0, dst_row0, mode; float scale; int had; };
__device__ __forceinline__ void witem_load(f32x4 (&v)[8], const WItem& it, int lane) {
    const float* p = it.W + (size_t)(it.k0 + (lane >> 3)) * it.N + it.n0 + 4 * (lane & 7);
#pragma unroll
    for (int i = 0; i < 8; ++i) v[i] = __builtin_nontemporal_load((const GAS f32x4*)(p + (size_t)(8 * i) * it.N));
}
__device__ __forceinline__ void witem_store(const f32x4 (&v)[8], const WItem& it, LAS float* scr, int lane) {
#pragma unroll
    for (int i = 0; i < 8; ++i) { LAS float* d = scr + (8 * i + (lane >> 3)) * 33 + 4 * (lane & 7); d[0] = v[i].x; d[1] = v[i].y; d[2] = v[i].z; d[3] = v[i].w; }
    LDS_WAIT(); asm volatile("" ::: "memory");
    const int c = lane & 7;
    f32x4 ka = (f32x4){it.scale, it.scale, it.scale, it.scale}, kb = ka;
    if (it.kscale) { ka = *(const GAS f32x4*)(it.kscale + it.k0 + 8 * c) * it.scale; kb = *(const GAS f32x4*)(it.kscale + it.k0 + 8 * c + 4) * it.scale; }
#pragma unroll
    for (int j = 0; j < 4; ++j) { const int n = (lane >> 3) + 8 * j; const LAS float* s = scr + (8 * c) * 33 + n;
        float x[8] = {s[0 * 33] * ka.x, s[1 * 33] * ka.y, s[2 * 33] * ka.z, s[3 * 33] * ka.w, s[4 * 33] * kb.x, s[5 * 33] * kb.y, s[6 * 33] * kb.z, s[7 * 33] * kb.w};
        if (it.had) {
#pragma unroll
            for (int b = 1; b < 8; b <<= 1)
#pragma unroll
                for (int i = 0; i < 8; ++i) if (!(i & b)) { const float a = x[i], e = x[i | b]; x[i] = a + e; x[i | b] = a - e; }
#pragma unroll
            for (int i = 0; i < 8; ++i) { const float p = __builtin_bit_cast(float, __builtin_amdgcn_update_dpp(0, __builtin_bit_cast(int, x[i]), 0xB1, 0xF, 0xF, false)); x[i] = (lane & 1) ? p - x[i] : x[i] + p; }
#pragma unroll
            for (int i = 0; i < 8; ++i) { const float p = __builtin_bit_cast(float, __builtin_amdgcn_update_dpp(0, __builtin_bit_cast(int, x[i]), 0x4E, 0xF, 0xF, false)); x[i] = (lane & 2) ? p - x[i] : x[i] + p; } }
        if (it.mode == 1) {
            float m = fmaxf(fmaxf(fmaxf(fabsf(x[0]), fabsf(x[1])), fmaxf(fabsf(x[2]), fabsf(x[3]))), fmaxf(fmaxf(fabsf(x[4]), fabsf(x[5])), fmaxf(fabsf(x[6]), fabsf(x[7]))));
            m = fmaxf(m, __builtin_bit_cast(float, __builtin_amdgcn_update_dpp(0, __builtin_bit_cast(int, m), 0xB1, 0xF, 0xF, false)));
            m = fmaxf(m, __builtin_bit_cast(float, __builtin_amdgcn_update_dpp(0, __builtin_bit_cast(int, m), 0x4E, 0xF, 0xF, false)));
            m = fmaxf(m, swz_xor<(4 << 10) | 0x1f>(m));
            if (c == 0) atomicMax((unsigned*)it.cmax + it.dst_row0 + n, __builtin_bit_cast(unsigned, m));
        } else if (it.mode == 2) {
            const float cm = it.cmax[it.dst_row0 + n], inv = cm > 0.f ? 127.0f / cm : 0.f;
#define WQ_(v) __builtin_bit_cast(unsigned, __builtin_fmaf((v), inv, 12582912.0f))
            const unsigned lo = __builtin_amdgcn_perm(__builtin_amdgcn_perm(WQ_(x[3]), WQ_(x[2]), 0x0c0c0400u), __builtin_amdgcn_perm(WQ_(x[1]), WQ_(x[0]), 0x0c0c0400u), 0x05040100u);
            const unsigned hi = __builtin_amdgcn_perm(__builtin_amdgcn_perm(WQ_(x[7]), WQ_(x[6]), 0x0c0c0400u), __builtin_amdgcn_perm(WQ_(x[5]), WQ_(x[4]), 0x0c0c0400u), 0x05040100u);
#undef WQ_
            *(GAS unsigned long long*)((GAS unsigned char*)it.WT + (size_t)(it.dst_row0 + n) * it.K + it.k0 + 8 * c) = (unsigned long long)lo | ((unsigned long long)hi << 32);
        } else {
        v4u o; o.x = pkbf(x[0], x[1]); o.y = pkbf(x[2], x[3]); o.z = pkbf(x[4], x[5]); o.w = pkbf(x[6], x[7]);
        *(GAS v4u*)(it.WT + (size_t)(it.dst_row0 + n) * it.K + it.k0 + 8 * c) = o; } }
    LDS_WAIT(); asm volatile("" ::: "memory");
}
constexpr int NB_IN = DIN / 32, NB_DM = DM / 32, NB_FF = DFF / 32;
constexpr int I_IN = (DM / 64) * NB_IN, I_OUT = P4_INT8 ? 0   : (DM / 64) * NB_DM, I_D = (DFF / 64) * NB_DM;
constexpr int WI_N = I_IN + I_OUT + I_D, WI_A = I_IN + I_OUT;
struct WPtrs { const float *w_in, *w_out, *w_down, *g_na, *g_sw; bf16 *Win_t, *Wout_t, *Wdn_t; float* cmaxd; int dn_mode; };
__device__ __forceinline__ WItem witem_decode(const WPtrs& P, int it) {
    WItem w; int r = it; w.kscale = nullptr; w.cmax = nullptr; w.mode = 0; w.scale = 1.0f; w.had = 0;
    if (r < I_IN) { const int kb = r / NB_IN, nb = r % NB_IN, n0 = 32 * nb; const bool isq = (n0 < 2048) || (n0 >= 6144 && n0 < 8192);
        w.W = P.w_in; w.WT = P.Win_t; w.K = DM; w.N = DIN; w.k0 = 64 * kb; w.n0 = n0; w.dst_row0 = n0; w.scale = isq ? QSCALE : 1.0f; return w; } r -= I_IN;
    if (r < I_OUT) { const int kb = r / NB_DM, nb = r % NB_DM; w.W = P.w_out; w.WT = P.Wout_t; w.K = DM; w.N = DM; w.k0 = 64 * kb; w.n0 = 32 * nb; w.dst_row0 = 32 * nb;
        w.kscale = (64 * kb < 2048) ? P.g_na : P.g_sw - 2048; return w; } r -= I_OUT;
    { const int kb = r / NB_DM, nb = r % NB_DM; w.W = P.w_down; w.WT = P.Wdn_t; w.K = DFF; w.N = DM; w.k0 = 64 * kb; w.n0 = 32 * nb; w.dst_row0 = 32 * nb; w.had = 1; w.scale = 1.0f / 32.0f; w.mode = P.dn_mode; w.cmax = P.cmaxd; return w; }
}
constexpr int NSLAB = 2 * NB_FF;
template <bool KSC> __device__ __forceinline__ void w8_slab(const float* W, int ldn, const float* ksc, unsigned char* WT8, float* cmax, int n0, int dst_row0, LAS float* red  , int wave, int lane) {
    const int r8 = lane >> 3, c8 = lane & 7;
    const float* p = W + (size_t)(512 * wave + 64 * r8) * ldn + n0 + 4 * c8;
    unsigned st[128]; f32x4 mx = (f32x4){0.f, 0.f, 0.f, 0.f};
#pragma unroll
    for (int b = 0; b < 4; ++b) { f32x4 v[16];
#pragma unroll
        for (int i = 0; i < 16; ++i) v[i] = __builtin_nontemporal_load((const GAS f32x4*)(p + (size_t)(16 * b + i) * ldn));
        if constexpr (KSC) { const GAS f32x4* gp = (const GAS f32x4*)(ksc + 512 * wave + 64 * r8 + 16 * b);
#pragma unroll
            for (int i4 = 0; i4 < 4; ++i4) { const f32x4 g = gp[i4]; v[4 * i4] *= g.x; v[4 * i4 + 1] *= g.y; v[4 * i4 + 2] *= g.z; v[4 * i4 + 3] *= g.w; } }
#pragma unroll
        for (int i = 0; i < 16; ++i) { mx.x = fmaxf(mx.x, fabsf(v[i].x)); mx.y = fmaxf(mx.y, fabsf(v[i].y)); mx.z = fmaxf(mx.z, fabsf(v[i].z)); mx.w = fmaxf(mx.w, fabsf(v[i].w));
            st[2 * (16 * b + i)] = pkbf(v[i].x, v[i].y); st[2 * (16 * b + i) + 1] = pkbf(v[i].z, v[i].w); } }
#define SLAB_RED(PAT) do { mx.x = fmaxf(mx.x, swz_xor<PAT>(mx.x)); mx.y = fmaxf(mx.y, swz_xor<PAT>(mx.y)); mx.z = fmaxf(mx.z, swz_xor<PAT>(mx.z)); mx.w = fmaxf(mx.w, swz_xor<PAT>(mx.w)); } while (0)
    SLAB_RED((8 << 10) | 0x1f); SLAB_RED((16 << 10) | 0x1f);
#undef SLAB_RED
    { const auto r0 = __builtin_amdgcn_permlane32_swap(__float_as_uint(mx.x), __float_as_uint(mx.x), false, false); mx.x = fmaxf(__uint_as_float(r0[0]), __uint_as_float(r0[1]));
      const auto r1 = __builtin_amdgcn_permlane32_swap(__float_as_uint(mx.y), __float_as_uint(mx.y), false, false); mx.y = fmaxf(__uint_as_float(r1[0]), __uint_as_float(r1[1]));
      const auto r2 = __builtin_amdgcn_permlane32_swap(__float_as_uint(mx.z), __float_as_uint(mx.z), false, false); mx.z = fmaxf(__uint_as_float(r2[0]), __uint_as_float(r2[1]));
      const auto r3 = __builtin_amdgcn_permlane32_swap(__float_as_uint(mx.w), __float_as_uint(mx.w), false, false); mx.w = fmaxf(__uint_as_float(r3[0]), __uint_as_float(r3[1])); }
    if (r8 == 0) *(LAS f32x4*)(red + 32 * wave + 4 * c8) = mx;
    __syncthreads();
    f32x4 cm = *(const LAS f32x4*)(red + 4 * c8);
#pragma unroll
    for (int w = 1; w < 8; ++w) { const f32x4 o = *(const LAS f32x4*)(red + 32 * w + 4 * c8); cm.x = fmaxf(cm.x, o.x); cm.y = fmaxf(cm.y, o.y); cm.z = fmaxf(cm.z, o.z); cm.w = fmaxf(cm.w, o.w); }
    cm *= 1.00390625f;
    if (wave == 0 && r8 == 0) *(GAS f32x4*)(cmax + dst_row0 + 4 * c8) = cm;
    const float i0 = cm.x > 0.f ? 127.0f / cm.x : 0.f, i1 = cm.y > 0.f ? 127.0f / cm.y : 0.f, i2 = cm.z > 0.f ? 127.0f / cm.z : 0.f, i3 = cm.w > 0.f ? 127.0f / cm.w : 0.f;
    GAS unsigned char* dst = (GAS unsigned char*)WT8 + (size_t)(dst_row0 + 4 * c8) * DM + 512 * wave + 64 * r8;
#define SLAB_Q(word, hi, inv) __builtin_bit_cast(unsigned, __builtin_fmaf(__builtin_bit_cast(float, (hi) ? ((word) & 0xffff0000u) : ((word) << 16)), (inv), 12582912.0f))
#define SLAB_PK(a, b, c, d) __builtin_amdgcn_perm(__builtin_amdgcn_perm((d), (c), 0x0c0c0400u), __builtin_amdgcn_perm((b), (a), 0x0c0c0400u), 0x05040100u)
#pragma unroll
    for (int j = 0; j < 4; ++j) { const float inv = j == 0 ? i0 : (j == 1 ? i1 : (j == 2 ? i2 : i3));
#pragma unroll
        for (int q = 0; q < 4; ++q) { v4u o;
#pragma unroll
            for (int d = 0; d < 4; ++d) { const int i = 16 * q + 4 * d;
                const unsigned a = SLAB_Q(st[2 * (i + 0) + (j >> 1)], j & 1, inv), b = SLAB_Q(st[2 * (i + 1) + (j >> 1)], j & 1, inv), c = SLAB_Q(st[2 * (i + 2) + (j >> 1)], j & 1, inv), e = SLAB_Q(st[2 * (i + 3) + (j >> 1)], j & 1, inv);
                const unsigned w = SLAB_PK(a, b, c, e);
                if (d == 0) o.x = w; else if (d == 1) o.y = w; else if (d == 2) o.z = w; else o.w = w; }
            *(GAS v4u*)(dst + (size_t)j * DM + 16 * q) = o; } }
#undef SLAB_Q
#undef SLAB_PK
    __syncthreads();
}
__device__ __forceinline__ void wgu_slab(const float* w_gate, const float* w_up, unsigned char* WT8, float* cmax, int s, LAS float* red, int wave, int lane) {
    const int mat = s >= NB_FF ? 1 : 0, n0 = 32 * (s - mat * NB_FF), dst_row0 = (n0 >> 7) * 256 + mat * 128 + (n0 & 127);
    w8_slab<false>(mat ? w_up : w_gate, DFF, nullptr, WT8, cmax, n0, dst_row0, red, wave, lane);
}
constexpr int NSLAB_O = DM / 32;
__device__ __forceinline__ void wout_slab(const float* w_out, const LAS float* og  , unsigned char* WT8, float* cmax, int s, LAS float* red, int wave, int lane) {
    const int r8 = lane >> 3, c8 = lane & 7, n0 = 32 * s, kb = 2048 * (wave >> 2) + 32 * (wave & 3) + 4 * r8;
    const unsigned voff = ((unsigned)kb * DM + n0 + 4 * c8) * 4u;
    const LAS float* gl = og + kb;
    unsigned st[128]; f32x4 mx = (f32x4){0.f, 0.f, 0.f, 0.f};
#pragma unroll
    for (int b = 0; b < 4; ++b) { f32x4 v[16];
#pragma unroll
        for (int i = 0; i < 16; ++i) v[i] = __builtin_nontemporal_load((const GAS f32x4*)((const GAS char*)w_out + (size_t)(128 * i + b) * DM * 4 + voff));
#pragma unroll
        for (int i = 0; i < 16; ++i) { const float g = gl[128 * i + b] * (1.0f / 8.0f); v[i] *= g; }
        asm volatile("" ::: "memory");
#pragma unroll
        for (int s2 = 2; s2 < 16; s2 <<= 1)
#pragma unroll
            for (int i = 0; i < 16; ++i) if (!(i & s2)) { const f32x4 a = v[i], c = v[i | s2]; v[i] = a + c; v[i | s2] = a - c; }
#pragma unroll
        for (int i = 0; i < 16; ++i) { mx.x = fmaxf(mx.x, fabsf(v[i].x)); mx.y = fmaxf(mx.y, fabsf(v[i].y)); mx.z = fmaxf(mx.z, fabsf(v[i].z)); mx.w = fmaxf(mx.w, fabsf(v[i].w));
            st[2 * (16 * b + i)] = pkbf(v[i].x, v[i].y); st[2 * (16 * b + i) + 1] = pkbf(v[i].z, v[i].w); } }
#define SLAB_RED(PAT) do { mx.x = fmaxf(mx.x, swz_xor<PAT>(mx.x)); mx.y = fmaxf(mx.y, swz_xor<PAT>(mx.y)); mx.z = fmaxf(mx.z, swz_xor<PAT>(mx.z)); mx.w = fmaxf(mx.w, swz_xor<PAT>(mx.w)); } while (0)
    SLAB_RED((8 << 10) | 0x1f); SLAB_RED((16 << 10) | 0x1f);
#undef SLAB_RED
    { const auto r0 = __builtin_amdgcn_permlane32_swap(__float_as_uint(mx.x), __float_as_uint(mx.x), false, false); mx.x = fmaxf(__uint_as_float(r0[0]), __uint_as_float(r0[1]));
      const auto r1 = __builtin_amdgcn_permlane32_swap(__float_as_uint(mx.y), __float_as_uint(mx.y), false, false); mx.y = fmaxf(__uint_as_float(r1[0]), __uint_as_float(r1[1]));
      const auto r2 = __builtin_amdgcn_permlane32_swap(__float_as_uint(mx.z), __float_as_uint(mx.z), false, false); mx.z = fmaxf(__uint_as_float(r2[0]), __uint_as_float(r2[1]));
      const auto r3 = __builtin_amdgcn_permlane32_swap(__float_as_uint(mx.w), __float_as_uint(mx.w), false, false); mx.w = fmaxf(__uint_as_float(r3[0]), __uint_as_float(r3[1])); }
    if (r8 == 0) *(LAS f32x4*)(red + 32 * wave + 4 * c8) = mx;
    __syncthreads();
    f32x4 cm = *(const LAS f32x4*)(red + 4 * c8);
#pragma unroll
    for (int w = 1; w < 8; ++w) { const f32x4 o = *(const LAS f32x4*)(red + 32 * w + 4 * c8); cm.x = fmaxf(cm.x, o.x); cm.y = fmaxf(cm.y, o.y); cm.z = fmaxf(cm.z, o.z); cm.w = fmaxf(cm.w, o.w); }
    cm *= 1.00390625f;
    if (wave == 0 && r8 == 0) *(GAS f32x4*)(cmax + n0 + 4 * c8) = cm;
    const float i0 = cm.x > 0.f ? 127.0f / cm.x : 0.f, i1 = cm.y > 0.f ? 127.0f / cm.y : 0.f, i2 = cm.z > 0.f ? 127.0f / cm.z : 0.f, i3 = cm.w > 0.f ? 127.0f / cm.w : 0.f;
    GAS unsigned char* dst = (GAS unsigned char*)WT8 + (size_t)(n0 + 4 * c8) * DM + kb;
#define SLAB_Q(word, hi, inv) __builtin_bit_cast(unsigned, __builtin_fmaf(__builtin_bit_cast(float, (hi) ? ((word) & 0xffff0000u) : ((word) << 16)), (inv), 12582912.0f))
#define SLAB_PK(a, b, c, d) __builtin_amdgcn_perm(__builtin_amdgcn_perm((d), (c), 0x0c0c0400u), __builtin_amdgcn_perm((b), (a), 0x0c0c0400u), 0x05040100u)
#pragma unroll
    for (int j = 0; j < 4; ++j) { const float inv = j == 0 ? i0 : (j == 1 ? i1 : (j == 2 ? i2 : i3));
#pragma unroll
        for (int i = 0; i < 16; ++i) {
            const unsigned a = SLAB_Q(st[2 * (0 + i) + (j >> 1)], j & 1, inv), b = SLAB_Q(st[2 * (16 + i) + (j >> 1)], j & 1, inv), c = SLAB_Q(st[2 * (32 + i) + (j >> 1)], j & 1, inv), e = SLAB_Q(st[2 * (48 + i) + (j >> 1)], j & 1, inv);
            *(GAS unsigned*)(dst + (size_t)j * DM + 128 * i) = SLAB_PK(a, b, c, e); } }
#undef SLAB_Q
#undef SLAB_PK
    __syncthreads();
}
__device__ __forceinline__ void witems_run(const WPtrs& P, int lo, int hi, int rank, int nw, LAS float* scr, int lane) {
    if (lo + rank >= hi) return;
    WItem cur = witem_decode(P, lo + rank); f32x4 cv[8]; witem_load(cv, cur, lane);
    for (int it = lo + rank; it < hi; it += nw) {
        const int itn = it + nw; WItem nxt = cur; f32x4 nv[8];
        if (itn < hi) { nxt = witem_decode(P, itn); witem_load(nv, nxt, lane); }
        witem_store(cv, cur, scr, lane);
        if (itn < hi) {
#pragma unroll
            for (int i = 0; i < 8; ++i) cv[i] = nv[i];
            cur = nxt; }
    }
}
__device__ __forceinline__ void gain_to_lds(const float* g, LAS unsigned char* dst, int tid) {
    for (int i = tid; i < DM / 4; i += NWAVES * 64) ((LAS f32x4*)dst)[i] = ((const GAS f32x4*)g)[i];
}
__device__ __forceinline__ const float* x_row(const float* xp, const float* xs, const float* meta, int m) {
    return m < TP ? xp + (size_t)m * DM : (m < MREAL ? xs + (size_t)(m - TP) * DM : meta + (size_t)(m - MREAL) * DM);
}

typedef const __attribute__((address_space(4))) char* kptr_t;
__device__ __forceinline__ kptr_t kbase() { kptr_t p = (kptr_t)__builtin_amdgcn_kernarg_segment_ptr(); asm volatile("" : "+s"(p)); return p; }
__device__ __forceinline__ const float* kin(kptr_t p, int i) { return *(const float* const __attribute__((address_space(4)))*)(p + 8 * i); }
__device__ __forceinline__ float* kout(kptr_t p) { return *(float* const __attribute__((address_space(4)))*)(p + 128); }
__device__ __forceinline__ unsigned char* kws(kptr_t p) { return *(unsigned char* const __attribute__((address_space(4)))*)(p + 136); }
#define K_IN(name, i) const float* const name = kin(kp_, i)
#define K_WS(type, name, off) type* const name = (type*)(kws(kp_) + (off))
#define K_WPTRS(DN_MODE) const WPtrs WP{kin(kp_, 3), kin(kp_, 4), kin(kp_, 15), kin(kp_, 7), kin(kp_, 8), (bf16*)(kws(kp_) + WS_WIN), (bf16*)(kws(kp_) + WS_WOUT), (bf16*)(kws(kp_) + WS_WDN), (float*)(kws(kp_) + WS_CMAXD), (DN_MODE)}
#define GRID_BAR() do { XcdBarrier b_; b_.bar = (unsigned*)(kws(kbase()) + WS_CTL) + CW_BAR; b_.x = xb_xcc_id(); b_.st = F.MISC + 8; b_.t0 = (F.wave == 0 && lane_id() == 0); xcd_barrier(b_); } while (0)
struct Args { const float* in[16]; float* out; unsigned char* ws; };
__global__ void __launch_bounds__(NWAVES * 64, 2) enc_fwd(Args args) {
    extern __shared__ __attribute__((aligned(16))) unsigned char lds[];
    Frame F;
    F.lds = (LAS unsigned char*)lds;
    F.MISC = (volatile LAS unsigned*)(F.lds + MISC_OFF);
    F.wave = __builtin_amdgcn_readfirstlane((int)threadIdx.x >> 6);
    F.G = gridDim.x; { const int bx = blockIdx.x; F.vcu = (F.G % 8 == 0) ? (bx % 8) * (F.G / 8) + bx / 8 : bx; }
    for (int u = (F.wave * 64 + lane_id()); u < (LDS_BYTES - LDSCTL_OFF) / 4; u += NWAVES * 64) ((LAS unsigned*)(F.lds + LDSCTL_OFF))[u] = 0u;
    __syncthreads();
    (void)xcd_barrier_post((unsigned*)(kws(kbase()) + WS_CTL) + CW_BAR, F.MISC + 8, F.wave == 0 && lane_id() == 0);
    const int gw = F.vcu * NWAVES + F.wave, NGW = F.G * NWAVES;

#pragma unroll
    for (int rep_ = 0; rep_ < REP_P0; ++rep_) {
        const kptr_t kp_ = kbase(); K_IN(x_prompt, 0); K_IN(x_sample, 1); K_IN(meta, 2); K_IN(g_pre_mix, 9); K_WS(bf16, Abuf, WS_A); K_WS(float, rsx, WS_RSX);
        int ln = lane_id(); asm volatile("" : "+v"(ln));
        LAS float* scr = (LAS float*)(F.lds + RING_OFF + F.wave * P0_SCR);
        { int td = (F.wave * 64 + lane_id()); asm volatile("" : "+v"(td)); gain_to_lds(g_pre_mix, F.lds + GAIN_OFF, td); } __syncthreads();
        { constexpr int SLAB_ITEMS = 53; const int nsl = SLAB0 + (P4_INT8 ? NSLAB_O : 0), rem = nsl % F.G, nlight = rem ? F.G - rem : 0; const int nextra = (SLAB_ITEMS * nlight < WI_A) ? SLAB_ITEMS * nlight : 0;
          if (rep_ == 0) { K_IN(w_gate, 13); K_IN(w_up, 14); K_IN(w_out, 4); K_IN(g_na, 7); K_IN(g_sw, 8);
            { int td = F.wave * 64 + ln; for (int i = td; i < DM / 4; i += NWAVES * 64) ((LAS f32x4*)(F.lds + OG_OFF))[i] = i < 512 ? ((const GAS f32x4*)g_na)[i] : ((const GAS f32x4*)g_sw)[i - 512]; } __syncthreads(); K_WS(unsigned char, Wgu8, WS_WGU); K_WS(float, cmaxw, WS_COLMAX); K_WS(unsigned char, Wout8, WS_WOUT); K_WS(float, cmaxo, WS_CMAXO);
            for (int s = F.vcu; s < nsl; s += F.G) { if (s < SLAB0) wgu_slab(w_gate, w_up, Wgu8, cmaxw, s, (LAS float*)(F.lds + SLAB_RED_OFF), F.wave, ln);
                                                   else wout_slab(w_out, (const LAS float*)(F.lds + OG_OFF), Wout8, cmaxo, s - SLAB0, (LAS float*)(F.lds + SLAB_RED_OFF), F.wave, ln); } }
          K_WPTRS(1);
          if (nextra > 0 && F.vcu >= rem) witems_run(WP, 0, nextra, (F.vcu - rem) * NWAVES + F.wave, nlight * NWAVES, scr, ln);
          witems_run(WP, nextra, WI_A, gw, NGW, scr, ln);
          witems_run(WP, WI_A, WI_N, gw, NGW, scr, ln); }
        {
            f32x4 v[16];
            auto load_row = [&](f32x4 (&d)[16], int m) { if (m < MREAL + NMETA) { const GAS f32x4* xr = (const GAS f32x4*)x_row(x_prompt, x_sample, meta, m) + ln;
#pragma unroll
                    for (int j = 0; j < 16; ++j) d[j] = __builtin_nontemporal_load(xr + 64 * j); } };
            if (gw < MPAD) load_row(v, gw);
            for (int m = gw; m < MPAD; m += NGW) {
                const int mn = m + NGW; f32x4 nv[16];
                if (mn < MPAD) load_row(nv, mn);
                GAS unsigned long long* o8 = (GAS unsigned long long*)(Abuf + (size_t)m * DM) + ln;
                if (m >= MREAL + NMETA) {
#pragma unroll
                    for (int j = 0; j < 16; ++j) o8[64 * j] = 0ull;
                } else {
                    float s = 0.f;
#pragma unroll
                    for (int j = 0; j < 16; ++j) s += (v[j].x * v[j].x + v[j].y * v[j].y) + (v[j].z * v[j].z + v[j].w * v[j].w);
                    const float nrm = sqrtf(wave_sum(s) * (1.0f / DM) + EPS), rs = 1.0f / nrm;
                    if (ln == 0 && m < MREAL) rsx[m] = nrm;
#pragma unroll
                    for (int j = 0; j < 16; ++j) { const f32x4 g = ((const LAS f32x4*)(F.lds + GAIN_OFF))[ln + 64 * j];
                        o8[64 * j] = (unsigned long long)pkbf(v[j].x * rs * g.x, v[j].y * rs * g.y) | ((unsigned long long)pkbf(v[j].z * rs * g.z, v[j].w * rs * g.w) << 32);
                        if ((j & 3) == 3) asm volatile("" ::: "memory"); }
                }
                if (mn < MPAD) {
#pragma unroll
                    for (int j = 0; j < 16; ++j) v[j] = nv[j]; }
            }
        }
    }
    GRID_BAR();

    {
        const kptr_t kp_ = kbase(); K_WS(bf16, Abuf, WS_A); K_WS(bf16, Win_t, WS_WIN); K_WS(bf16, Bbuf, WS_B);
        pg8::Gemm g{Abuf, Win_t, MPAD, DIN, DM}; pg8::StaticOrder S; S.init(MPAD, DIN, F.G, (int)blockIdx.x, WGM_P1);
        pg8::EpiBf16Blk E{Bbuf, MPAD};
        pg8::gemm_phase<pg8::EpiBf16Blk, pg8::StaticOrder, true, true>(F.lds + RING_OFF, g, S, E, F.wave);
        { constexpr int NWG = (MPAD / 256) * (DIN / 256); const int rem = NWG % F.G; const bool idle = rem != 0 && (int)blockIdx.x >= rem;
          if (idle || rem == 0) { int ln = lane_id(); asm volatile("" : "+v"(ln));
              K_IN(w_gate, 13); K_IN(w_up, 14); K_WS(unsigned char, Wgu8, WS_WGU); K_WS(float, cmaxw, WS_COLMAX);
              const int rank = idle ? (int)blockIdx.x - rem : (int)blockIdx.x, nr = idle ? F.G - rem : F.G;
              for (int s = SLAB0 + rank; s < NSLAB; s += nr) wgu_slab(w_gate, w_up, Wgu8, cmaxw, s, (LAS float*)(F.lds + SLAB_RED_OFF), F.wave, ln); } }
    }
    GRID_BAR();

#pragma unroll
    for (int rep_ = 0; rep_ < REP_P2; ++rep_) {
        const kptr_t kp_ = kbase(); K_WS(bf16, Bbuf, WS_B); K_WS(float, ssq, WS_ACC2); K_IN(rpb, 5); K_IN(sink, 6);
        const att::bf16* Pp = (const att::bf16*)Bbuf; att::bf16* Op = (att::bf16*)kout(kp_);
#pragma unroll
        for (int rna_ = 0; rna_ < REP_NA; ++rna_)
        for (int uidx = F.vcu; uidx < 1536; uidx += F.G) {
            att::UnitP u;
            if (uidx < 1024) { u.seqbase = 0; u.T = TP; u.head = uidx >> 6; u.blk = uidx & 63; }
            else { const int v = uidx - 1024; u.seqbase = TP + TS * (v >> 8); u.T = TS; u.head = (v & 255) >> 4; u.blk = v & 15; }
            att::bf16* Op2 = Op; float* ssq2 = ssq; const att::bf16* Pp2 = Pp; asm volatile("" : "+s"(Op2), "+s"(ssq2), "+s"(Pp2));
            att::attn_unit_na4(u, Pp2, Op2, ssq2, rpb, (LAS char*)F.lds + RING_OFF, F.wave, rna_ == 0);
        }
#pragma unroll
        for (int rsw_ = 0; rsw_ < REP_SW; ++rsw_)
        for (int uidx = F.vcu; uidx < 1536; uidx += F.G) {
            att::UnitP u;
            if (uidx < 1024) { u.seqbase = 0; u.T = TP; u.head = uidx >> 8; u.blk = uidx & 255; }
            else { const int v = uidx - 1024; u.seqbase = TP + TS * (v >> 8); u.T = TS; u.head = (v & 255) >> 6; u.blk = v & 63; }
            att::bf16* Op2 = Op; float* ssq2 = ssq; const att::bf16* Pp2 = Pp; asm volatile("" : "+s"(Op2), "+s"(ssq2), "+s"(Pp2));
            att::attn_unit_sw4(u, Pp2, Op2, ssq2, sink, (LAS char*)F.lds + RING_OFF, F.wave, rsw_ == 0);
        }
    }
    GRID_BAR();

#if P4_INT8
    { int ln3 = lane_id(); asm volatile("" : "+v"(ln3));
    const kptr_t kp_ = kbase(); K_WS(float, ssq, WS_ACC2); K_WS(float, onsc, WS_ONSC); K_WS(unsigned char, On8, WS_ON8); const bf16* const Obuf = (const bf16*)kout(kp_);
    for (int m = gw; m < MREAL; m += NGW) {
        const GAS unsigned long long* orow = (const GAS unsigned long long*)(Obuf + (size_t)m * DM) + ln3;
        f32x4 v[16];
        { unsigned long long ow[16];
#pragma unroll
          for (int j = 0; j < 16; ++j) ow[j] = __builtin_nontemporal_load(orow + 64 * j);
#pragma unroll
          for (int j = 0; j < 16; ++j) { const unsigned lo = (unsigned)ow[j], hi = (unsigned)(ow[j] >> 32); v[j] = (f32x4){att::bf_lo(lo), att::bf_hi(lo), att::bf_lo(hi), att::bf_hi(hi)}; } }
        const float qa = ssq[2 * (size_t)m], qb = ssq[2 * (size_t)m + 1];
#pragma unroll
        for (int s2 = 1; s2 < 8; s2 <<= 1)
#pragma unroll
            for (int j = 0; j < 16; ++j) if (!(j & s2)) { const f32x4 a = v[j], c = v[j | s2]; v[j] = a + c; v[j | s2] = a - c; }
        float ama = 0.f, amb = 0.f;
#pragma unroll
        for (int j = 0; j < 16; ++j) { const float mx = fmaxf(fmaxf(fabsf(v[j].x), fabsf(v[j].y)), fmaxf(fabsf(v[j].z), fabsf(v[j].w)));
            if (j < 8) ama = fmaxf(ama, mx); else amb = fmaxf(amb, mx); }
        const float rsa = 1.0f / sqrtf(qa * (1.0f / 2048.0f) + EPS), rsb = 1.0f / sqrtf(qb * (1.0f / 2048.0f) + EPS);
        float na = wave_max(ama) * rsa, nb = wave_max(amb) * rsb;
        na = fmaxf(fmaxf(na, nb * (1.0f / 32.0f)), 1e-30f); nb = fmaxf(nb, na * (1.0f / 32.0f));
        const float sa = na * (1.0f / 127.0f), sb = nb * (1.0f / 127.0f), ia = rsa / sa, ib = rsb / sb;
        GAS unsigned* o4 = (GAS unsigned*)(On8 + (size_t)m * DM) + ln3;
#pragma unroll
        for (int j = 0; j < 16; ++j) { const float iv = j < 8 ? ia : ib;
            const int a0 = (int)__builtin_rintf(v[j].x * iv), a1 = (int)__builtin_rintf(v[j].y * iv), a2 = (int)__builtin_rintf(v[j].z * iv), a3 = (int)__builtin_rintf(v[j].w * iv);
            o4[64 * j] = ((unsigned)a0 & 255u) | (((unsigned)a1 & 255u) << 8) | (((unsigned)a2 & 255u) << 16) | ((unsigned)a3 << 24); }
        if (ln3 == 0) { onsc[2 * (size_t)m] = sa; onsc[2 * (size_t)m + 1] = sb; }
    }
    }
    GRID_BAR();

    {
        const kptr_t kp_ = kbase(); K_WS(bf16, On8, WS_ON8); K_WS(bf16, Wout8, WS_WOUT); K_WS(float, onsc, WS_ONSC); K_WS(float, cmaxo, WS_CMAXO); K_WS(bf16, Bbuf, WS_B);
        pg8::Gemm g{On8, Wout8, MREAL, DM, DM / 2}; pg8::StaticOrder S; S.init(MREAL, DM, F.G, (int)blockIdx.x, WGM_P4);
        pg8::EpiBf16I8Norm2 E{Bbuf, DM, onsc, cmaxo};
        pg8::gemm_phase<pg8::EpiBf16I8Norm2, pg8::StaticOrder, true, true>(F.lds + RING_OFF, g, S, E, F.wave);
    }
#else
    {
        const kptr_t kp_ = kbase(); K_WS(bf16, Wout_t, WS_WOUT); K_WS(float, ssq, WS_ACC2); K_WS(bf16, Bbuf, WS_B);
        pg8::Gemm g{(const bf16*)kout(kp_), Wout_t, MREAL, DM, DM}; pg8::StaticOrder S; S.init(MREAL, DM, F.G, (int)blockIdx.x, WGM_P4);
        pg8::EpiBf16Norm2 E{Bbuf, DM, ssq, 1.0f / 2048.0f, EPS};
        pg8::gemm_phase<pg8::EpiBf16Norm2, pg8::StaticOrder, true, true>(F.lds + RING_OFF, g, S, E, F.wave);
    }
#endif
    GRID_BAR();

    { int ln5 = lane_id(); asm volatile("" : "+v"(ln5));
    const kptr_t kp_ = kbase(); K_IN(g_pre_mix, 9); K_IN(g_post_mix, 10); K_IN(g_pre_ffn, 11); K_WS(bf16, Abuf, WS_A); K_WS(bf16, Bbuf, WS_B); K_WS(unsigned char, H8, WS_WIN); K_WS(float, scaleA, WS_SCALEA); K_WS(float, rsx, WS_RSX); float* const out = kout(kp_);
    { int td = (F.wave * 64 + lane_id()); asm volatile("" : "+v"(td)); gain_to_lds(g_post_mix, F.lds + RING_OFF, td); gain_to_lds(g_pre_ffn, F.lds + RING_OFF + 16384, td);
      for (int i = td; i < DM / 4; i += NWAVES * 64) { const f32x4 g = ((const GAS f32x4*)g_pre_mix)[i]; ((LAS f32x4*)(F.lds + RING_OFF + 32768))[i] = (f32x4){1.0f / g.x, 1.0f / g.y, 1.0f / g.z, 1.0f / g.w}; } } __syncthreads();
    for (int m = gw; m < MREAL; m += NGW) {
        const GAS unsigned long long* mr = (const GAS unsigned long long*)(Bbuf + (size_t)m * DM) + ln5;
        const GAS unsigned long long* hr = (const GAS unsigned long long*)(Abuf + (size_t)m * DM) + ln5;
        f32x4 v[16]; unsigned long long mw[16], hw[16]; float s = 0.f;
#pragma unroll
        for (int j = 0; j < 16; ++j) { mw[j] = __builtin_nontemporal_load(mr + 64 * j); hw[j] = __builtin_nontemporal_load(hr + 64 * j); }
        const float nrm = rsx[m];
#pragma unroll
        for (int j = 0; j < 16; ++j) { const unsigned lo = (unsigned)mw[j], hi = (unsigned)(mw[j] >> 32); const float a = att::bf_lo(lo), b = att::bf_hi(lo), c = att::bf_lo(hi), d = att::bf_hi(hi);
            s += (a * a + b * b) + (c * c + d * d); }
        const float rs1 = 1.0f / sqrtf(wave_sum(s) * (1.0f / DM) + EPS); float s2 = 0.f;
        GAS unsigned long long* x8 = (GAS unsigned long long*)(out + (size_t)m * DM) + ln5;
#pragma unroll
        for (int j = 0; j < 16; ++j) { const f32x4 g = ((const LAS f32x4*)(F.lds + RING_OFF))[ln5 + 64 * j], rg = ((const LAS f32x4*)(F.lds + RING_OFF + 32768))[ln5 + 64 * j];
            const unsigned lo = (unsigned)mw[j], hi = (unsigned)(mw[j] >> 32), xl = (unsigned)hw[j], xh = (unsigned)(hw[j] >> 32);
            v[j].x = att::bf_lo(xl) * nrm * rg.x + att::bf_lo(lo) * rs1 * g.x; v[j].y = att::bf_hi(xl) * nrm * rg.y + att::bf_hi(lo) * rs1 * g.y;
            v[j].z = att::bf_lo(xh) * nrm * rg.z + att::bf_lo(hi) * rs1 * g.z; v[j].w = att::bf_hi(xh) * nrm * rg.w + att::bf_hi(hi) * rs1 * g.w;
            s2 += (v[j].x * v[j].x + v[j].y * v[j].y) + (v[j].z * v[j].z + v[j].w * v[j].w);
            x8[64 * j] = (unsigned long long)pkbf(v[j].x, v[j].y) | ((unsigned long long)pkbf(v[j].z, v[j].w) << 32);
            if ((j & 3) == 3) asm volatile("" ::: "memory"); }
        const float rs2 = 1.0f / sqrtf(wave_sum(s2) * (1.0f / DM) + EPS);
        float am = 0.f;
#pragma unroll
        for (int j = 0; j < 16; ++j) { const f32x4 g = ((const LAS f32x4*)(F.lds + RING_OFF + 16384))[ln5 + 64 * j];
            v[j].x *= rs2 * g.x; v[j].y *= rs2 * g.y; v[j].z *= rs2 * g.z; v[j].w *= rs2 * g.w;
            am = fmaxf(fmaxf(am, fmaxf(fabsf(v[j].x), fabsf(v[j].y))), fmaxf(fabsf(v[j].z), fabsf(v[j].w)));
            if ((j & 3) == 3) asm volatile("" ::: "memory"); }
        am = wave_max(am); const float inv = am > 0.f ? 127.0f / am : 0.f;
        GAS unsigned* o4 = (GAS unsigned*)(H8 + (size_t)m * DM) + ln5;
#pragma unroll
        for (int j = 0; j < 16; ++j) { const int a0 = (int)__builtin_rintf(v[j].x * inv), a1 = (int)__builtin_rintf(v[j].y * inv), a2 = (int)__builtin_rintf(v[j].z * inv), a3 = (int)__builtin_rintf(v[j].w * inv);
            o4[64 * j] = ((unsigned)a0 & 255u) | (((unsigned)a1 & 255u) << 8) | (((unsigned)a2 & 255u) << 16) | ((unsigned)a3 << 24); }
        if (ln5 == 0) scaleA[m] = am * (1.0f / 127.0f);
    }
    }
    GRID_BAR();

#pragma unroll
    for (int rep_ = 0; rep_ < REP_P6; ++rep_) {
        const kptr_t kp_ = kbase(); K_WS(bf16, H8, WS_WIN); K_WS(bf16, Wgu_t, WS_WGU); K_WS(bf16, Bbuf, WS_B);
        K_WS(float, scaleA, WS_SCALEA); K_WS(float, cmax, WS_COLMAX);
        pg8::Gemm g{H8, Wgu_t, MREAL, NGU, DM / 2};
        pg8::StaticOrder S; S.init(MREAL, NGU, F.G, (int)blockIdx.x);
        pg8::EpiSwiGLUI8 E{Bbuf, DFF, scaleA, cmax};
        pg8::gemm_phase<pg8::EpiSwiGLUI8, pg8::StaticOrder, true, true>(F.lds + RING_OFF, g, S, E, F.wave);
        if (rep_ == 0) { constexpr int NWG = (MREAL / 256) * (NGU / 256); const int rem = NWG % F.G; const bool idle = rem != 0 && (int)blockIdx.x >= rem;
          if (idle || rem == 0) { int ln = lane_id(); asm volatile("" : "+v"(ln));
              K_WPTRS(2);
              witems_run(WP, WI_A, WI_N, (idle ? (int)blockIdx.x - rem : (int)blockIdx.x) * NWAVES + F.wave, (idle ? F.G - rem : F.G) * NWAVES, (LAS float*)(F.lds + RING_OFF + F.wave * P0_SCR), ln); } }
    }
    GRID_BAR();

    { int ln6 = lane_id(); asm volatile("" : "+v"(ln6));
    const kptr_t kp_ = kbase(); K_WS(bf16, Bbuf, WS_B); K_WS(unsigned char, Act8, WS_ACT8); K_WS(float, scaleA, WS_SCALEA);
    const bool l1 = (ln6 & 1) != 0, l2 = (ln6 & 2) != 0, l4 = (ln6 & 4) != 0;
#define P6B_X1(X) do { const float o_ = (X); const float p_ = __builtin_bit_cast(float, __builtin_amdgcn_update_dpp(0, __builtin_bit_cast(int, o_), 0xB1, 0xF, 0xF, false)); (X) = l1 ? p_ - o_ : o_ + p_; } while (0)
#define P6B_X2(X) do { const float o_ = (X); const float p_ = __builtin_bit_cast(float, __builtin_amdgcn_update_dpp(0, __builtin_bit_cast(int, o_), 0x4E, 0xF, 0xF, false)); (X) = l2 ? p_ - o_ : o_ + p_; } while (0)
#define P6B_X4(X) do { const float o_ = (X); const float p_ = swz_xor<(4 << 10) | 0x1f>(o_); (X) = l4 ? p_ - o_ : o_ + p_; } while (0)
    for (int m = gw; m < MREAL; m += NGW) {
        const GAS unsigned long long* ar = (const GAS unsigned long long*)(Bbuf + (size_t)m * DFF) + ln6;
        GAS unsigned* o4 = (GAS unsigned*)(Act8 + (size_t)m * DFF) + ln6;
        unsigned st[86]; float am = 0.f;
#define P6B_BATCH(B0, CNT) do { unsigned long long aw[CNT]; \
            _Pragma("unroll") for (int i = 0; i < (CNT); ++i) aw[i] = __builtin_nontemporal_load(ar + 64 * ((B0) + i)); \
            _Pragma("unroll") for (int i = 0; i < (CNT); ++i) { const unsigned lo = (unsigned)aw[i], hi = (unsigned)(aw[i] >> 32); \
                const float x0 = att::bf_lo(lo), y0 = att::bf_hi(lo), z0 = att::bf_lo(hi), w0 = att::bf_hi(hi); \
                const float a_ = x0 + y0, b_ = x0 - y0, c_ = z0 + w0, d_ = z0 - w0; float x = a_ + c_, y = b_ + d_, z = a_ - c_, w = b_ - d_; \
                P6B_X1(x); P6B_X1(y); P6B_X1(z); P6B_X1(w); P6B_X2(x); P6B_X2(y); P6B_X2(z); P6B_X2(w); P6B_X4(x); P6B_X4(y); P6B_X4(z); P6B_X4(w); \
                am = fmaxf(fmaxf(am, fmaxf(fabsf(x), fabsf(y))), fmaxf(fabsf(z), fabsf(w))); \
                st[2 * ((B0) + i)] = pkbf(x, y); st[2 * ((B0) + i) + 1] = pkbf(z, w); } } while (0)
        P6B_BATCH(0, 11); P6B_BATCH(11, 11); P6B_BATCH(22, 11); P6B_BATCH(33, 10);
#undef P6B_BATCH
        am = wave_max(am) * 1.00390625f;
        const float inv = am > 0.f ? 127.0f / am : 0.f;
#pragma unroll
        for (int j = 0; j < 43; ++j) { const unsigned lo = st[2 * j], hi = st[2 * j + 1];
            const int a0 = (int)__builtin_rintf(att::bf_lo(lo) * inv), a1 = (int)__builtin_rintf(att::bf_hi(lo) * inv), a2 = (int)__builtin_rintf(att::bf_lo(hi) * inv), a3 = (int)__builtin_rintf(att::bf_hi(hi) * inv);
            o4[64 * j] = ((unsigned)a0 & 255u) | (((unsigned)a1 & 255u) << 8) | (((unsigned)a2 & 255u) << 16) | ((unsigned)a3 << 24); }
        if (ln6 == 0) scaleA[m] = am * (1.0f / 127.0f);
    }
#undef P6B_X1
#undef P6B_X2
#undef P6B_X4
    }
    GRID_BAR();

    {
        const kptr_t kp_ = kbase(); K_WS(bf16, Abuf, WS_A); K_WS(bf16, Wdn8, WS_WDN); K_WS(bf16, Act8, WS_ACT8); K_WS(float, scaleA, WS_SCALEA); K_WS(float, cmaxd, WS_CMAXD);
        pg8::Gemm g{Act8, Wdn8, MREAL, DM, DFF / 2}; pg8::StaticOrder S; S.init(MREAL, DM, F.G, (int)blockIdx.x, WGM_P7);
        pg8::EpiBf16I8 E{Abuf, DM, scaleA, cmaxd};
        pg8::gemm_phase<pg8::EpiBf16I8, pg8::StaticOrder, true, true>(F.lds + RING_OFF, g, S, E, F.wave);
    }
    GRID_BAR();

    { int ln8 = lane_id(); asm volatile("" : "+v"(ln8));
    const kptr_t kp_ = kbase(); K_IN(g_post_ffn, 12); K_WS(bf16, Abuf, WS_A); float* const out = kout(kp_);
    { int td = (F.wave * 64 + lane_id()); asm volatile("" : "+v"(td)); gain_to_lds(g_post_ffn, F.lds + RING_OFF, td); } __syncthreads();
    for (int m = gw; m < MREAL; m += NGW) {
        GAS f32x4* yr = (GAS f32x4*)(out + (size_t)m * DM) + ln8;
        const GAS unsigned long long* xr = (const GAS unsigned long long*)(out + (size_t)m * DM) + ln8;
        const GAS unsigned long long* fr = (const GAS unsigned long long*)(Abuf + (size_t)m * DM) + ln8;
        unsigned long long xw[16], fw[16]; float sf = 0.f;
#pragma unroll
        for (int j = 0; j < 16; ++j) { xw[j] = __builtin_nontemporal_load(xr + 64 * j); fw[j] = __builtin_nontemporal_load(fr + 64 * j); }
#pragma unroll
        for (int j = 0; j < 16; ++j) { const unsigned lo = (unsigned)fw[j], hi = (unsigned)(fw[j] >> 32); const float a = att::bf_lo(lo), b = att::bf_hi(lo), c = att::bf_lo(hi), d = att::bf_hi(hi);
            sf += (a * a + b * b) + (c * c + d * d); }
        const float rs3 = 1.0f / sqrtf(wave_sum(sf) * (1.0f / DM) + EPS);
#pragma unroll
        for (int j = 0; j < 16; ++j) { const f32x4 g3 = ((const LAS f32x4*)(F.lds + RING_OFF))[ln8 + 64 * j];
            const unsigned lo = (unsigned)fw[j], hi = (unsigned)(fw[j] >> 32), xl = (unsigned)xw[j], xh = (unsigned)(xw[j] >> 32);
            f32x4 y; y.x = att::bf_lo(xl) + att::bf_lo(lo) * rs3 * g3.x; y.y = att::bf_hi(xl) + att::bf_hi(lo) * rs3 * g3.y;
            y.z = att::bf_lo(xh) + att::bf_lo(hi) * rs3 * g3.z; y.w = att::bf_hi(xh) + att::bf_hi(hi) * rs3 * g3.w;
            __builtin_nontemporal_store(y, yr + 64 * j);
            if ((j & 3) == 3) asm volatile("" ::: "memory"); }
    }
    }
}

extern "C" void kernel_launch(void* const* d_in, const int* in_sizes, int n_in, void* d_out, int out_size, void* d_ws, size_t ws_size, hipStream_t stream) {
    static int grid = 0;
    if (grid == 0) {
        if (n_in != 16 || in_sizes[0] != TP * DM || in_sizes[1] != 2 * TS * DM || out_size != MREAL * DM || ws_size < WS_END) {
            fprintf(stderr, "kernel_launch: shape mismatch: n_in %d in0 %d in1 %d out %d ws %zu (need %zu); nothing launched\n", n_in, n_in > 0 ? in_sizes[0] : -1, n_in > 1 ? in_sizes[1] : -1, out_size, ws_size, (size_t)WS_END); grid = -1; return; }
        int dev = 0, cus = 0, per_cu = 0;
        if (hipGetDevice(&dev) != hipSuccess || hipDeviceGetAttribute(&cus, hipDeviceAttributeMultiprocessorCount, dev) != hipSuccess) { fprintf(stderr, "kernel_launch: device query failed\n"); grid = -1; return; }
        if (hipFuncSetAttribute((const void*)enc_fwd, hipFuncAttributeMaxDynamicSharedMemorySize, LDS_BYTES) != hipSuccess) { fprintf(stderr, "kernel_launch: hipFuncSetAttribute failed\n"); grid = -1; return; }
        if (hipOccupancyMaxActiveBlocksPerMultiprocessor(&per_cu, (const void*)enc_fwd, NWAVES * 64, LDS_BYTES) != hipSuccess || per_cu < 1)
            fprintf(stderr, "kernel_launch: note: occupancy query reports %d workgroups per CU\n", per_cu);
        (void)hipGetLastError();
        grid = cus;
    }
    if (grid < 0) return;
    if (hipMemsetAsync((char*)d_ws + WS_CTL, 0, CTL_ZERO_BYTES, stream) != hipSuccess) { fprintf(stderr, "kernel_launch: memset failed\n"); return; }
    Args a{};
    for (int i = 0; i < 16; ++i) a.in[i] = (const float*)d_in[i];
    a.out = (float*)d_out; a.ws = (unsigned char*)d_ws;
    hipLaunchKernelGGL(enc_fwd, dim3(grid), dim3(NWAVES * 64), LDS_BYTES, stream, a);
    const hipError_t le = hipPeekAtLastError();
    if (le != hipSuccess) fprintf(stderr, "kernel_launch: launch failed: %s\n", hipGetErrorName(le));
}
```

```cpp
#include <hip/hip_runtime.h>
#include <hip/hip_bf16.h>
#include <cstdio>
#include <cstdint>
namespace pg8 {
#define PG8_LAS __attribute__((address_space(3)))
typedef unsigned short bf16_t;
typedef short bf16x8 __attribute__((ext_vector_type(8)));
typedef float f32x4 __attribute__((ext_vector_type(4)));
typedef unsigned u32x4 __attribute__((ext_vector_type(4)));
constexpr int BM = 256, BK = 64, HALF = 128, HTB = HALF * BK * 2  , STAGE_BYTES = 8 * HTB, NXCD = 8, WGM = 8;

__host__ __device__ __forceinline__ int lds_byte(int r, int c) { const int st = (r >> 4) * 2 + (c >> 5), rr = r & 15, cc = c & 31, ob = rr * 64 + cc * 2; return st * 1024 + (ob ^ (((ob >> 9) & 1) << 5)); }
__host__ __device__ __forceinline__ void stage_rc(int b, int& R, int& C) { const int st = b / 1024, sb = b % 1024, swz = sb ^ (((sb >> 9) & 1) << 5); R = (st >> 1) * 16 + swz / 64; C = (st & 1) * 32 + (swz % 64) / 2; }
__host__ __device__ __forceinline__ int perm32(int rho) { const int n = rho >> 4, i = rho & 15; return 8 * (i >> 2) + 4 * n + (i & 3); }

struct Unit { int pm, pn; };
struct Gemm { const bf16_t* A; const bf16_t* Bt; int M, N, K; };

struct StaticOrder {
    int nM, nN, nwg, G, c, wgm;
    __host__ __device__ void init(int M, int N, int G_, int c_, int wgm_ = WGM) { nM = M / BM; nN = N / BM; nwg = nM * nN; G = G_; c = c_; wgm = wgm_; }
    __host__ __device__ bool next(int i, Unit& u) const {
        const long L = (long)i * G + c; if (L >= nwg) return false;
        int wgid = (int)L; { const int q = nwg / NXCD, r = nwg % NXCD, xcd = wgid % NXCD, off = wgid / NXCD; wgid = (xcd < r ? xcd * (q + 1) : r * (q + 1) + (xcd - r) * q) + off; }
        const int nig = wgm * nN, gid = wgid / nig, fm = gid * wgm, gsz = (nM - fm) < wgm ? (nM - fm) : wgm;
        u.pm = fm + ((wgid % nig) % gsz); u.pn = (wgid % nig) / gsz; return true;
    }
    __device__ __forceinline__ void a_ready(const Unit&) const {}
    __device__ __forceinline__ void done(const Unit&) const {}
};

__device__ __forceinline__ unsigned cvt_pk_bf16(float lo, float hi) { unsigned r; asm volatile("v_cvt_pk_bf16_f32 %0, %1, %2" : "=v"(r) : "v"(lo), "v"(hi)); return r; }
typedef float f32x2 __attribute__((ext_vector_type(2)));
struct EpiBf16 {
    static constexpr bool PERM = true, AFTER_DRAIN = false, HAS_MID = false, I8 = false;
    bf16_t* O; int ldc;
    __device__ __forceinline__ void operator()(const f32x4 (&acc)[2][2][4][2], const Unit& u, int wr, int wc, int fr, int fq) const {
        const int row0 = u.pm * BM + wr * 64 + fr, col0 = u.pn * BM + wc * 32 + 8 * fq;
#pragma unroll
        for (int ai = 0; ai < 2; ++ai)
#pragma unroll
            for (int m = 0; m < 4; ++m) { bf16_t* rowp = O + (size_t)(row0 + ai * HALF + m * 16) * ldc + col0;
#pragma unroll
                for (int bj = 0; bj < 2; ++bj) { const f32x4 v0 = acc[ai][bj][m][0], v1 = acc[ai][bj][m][1];
                    u32x4 w; w.x = cvt_pk_bf16(v0[0], v0[1]); w.y = cvt_pk_bf16(v0[2], v0[3]); w.z = cvt_pk_bf16(v1[0], v1[1]); w.w = cvt_pk_bf16(v1[2], v1[3]);
                    *(u32x4*)(rowp + bj * HALF) = w; } }
    }
};
struct EpiF32 {
    static constexpr bool PERM = false, AFTER_DRAIN = false, HAS_MID = false, I8 = false;
    float* C; int ldc;
    __device__ __forceinline__ void operator()(const f32x4 (&acc)[2][2][4][2], const Unit& u, int wr, int wc, int fr, int fq) const {
        const int row0 = u.pm * BM + wr * 64 + fr, col0 = u.pn * BM + wc * 32 + 4 * fq;
#pragma unroll
        for (int ai = 0; ai < 2; ++ai)
#pragma unroll
            for (int m = 0; m < 4; ++m) { float* rowp = C + (size_t)(row0 + ai * HALF + m * 16) * ldc + col0;
#pragma unroll
                for (int bj = 0; bj < 2; ++bj)
#pragma unroll
                    for (int n = 0; n < 2; ++n) *(f32x4*)(rowp + bj * HALF + n * 16) = acc[ai][bj][m][n]; }
    }
};
__device__ __forceinline__ float silu_mul(float g, float u) { return g * u * __builtin_amdgcn_rcpf(1.0f + __builtin_amdgcn_exp2f(g * -1.4426950408889634f)); }
struct EpiSwiGLU {
    static constexpr bool PERM = true, AFTER_DRAIN = false, HAS_MID = false, I8 = false;
    bf16_t* O; int ldc;
    __device__ __forceinline__ void operator()(const f32x4 (&acc)[2][2][4][2], const Unit& u, int wr, int wc, int fr, int fq) const {
        const int row0 = u.pm * BM + wr * 64 + fr, col0 = u.pn * HALF + wc * 32 + 8 * fq;
#pragma unroll
        for (int ai = 0; ai < 2; ++ai)
#pragma unroll
            for (int m = 0; m < 4; ++m) { bf16_t* rowp = O + (size_t)(row0 + ai * HALF + m * 16) * ldc + col0;
                const f32x4 g0 = acc[ai][0][m][0], g1 = acc[ai][0][m][1], u0 = acc[ai][1][m][0], u1 = acc[ai][1][m][1];
                u32x4 w; w.x = cvt_pk_bf16(silu_mul(g0[0], u0[0]), silu_mul(g0[1], u0[1])); w.y = cvt_pk_bf16(silu_mul(g0[2], u0[2]), silu_mul(g0[3], u0[3]));
                w.z = cvt_pk_bf16(silu_mul(g1[0], u1[0]), silu_mul(g1[1], u1[1])); w.w = cvt_pk_bf16(silu_mul(g1[2], u1[2]), silu_mul(g1[3], u1[3]));
                *(u32x4*)rowp = w; }
    }
};

struct EpiF32Norm2 {
    static constexpr bool PERM = false, AFTER_DRAIN = false, HAS_MID = true, I8 = false;
    float* C; int ldc; const float* acc2; float inv_cnt, eps;
    __device__ __forceinline__ void mid(f32x4 (&acc)[2][2][4][2], const Unit& u, int wr, int fr) const {
        const int row0 = u.pm * BM + wr * 64 + fr;
#pragma unroll
        for (int ai = 0; ai < 2; ++ai)
#pragma unroll
            for (int m = 0; m < 4; ++m) { const f32x2 s = *(const f32x2*)(acc2 + 2 * (size_t)(row0 + ai * HALF + m * 16));
                const float ratio = __builtin_amdgcn_sqrtf((s.y * inv_cnt + eps) * __builtin_amdgcn_rcpf(s.x * inv_cnt + eps));
#pragma unroll
                for (int bj = 0; bj < 2; ++bj)
#pragma unroll
                    for (int n = 0; n < 2; ++n) acc[ai][bj][m][n] *= ratio; }
    }
    __device__ __forceinline__ void operator()(const f32x4 (&acc)[2][2][4][2], const Unit& u, int wr, int wc, int fr, int fq) const {
        const int row0 = u.pm * BM + wr * 64 + fr, col0 = u.pn * BM + wc * 32 + 4 * fq;
#pragma unroll
        for (int ai = 0; ai < 2; ++ai)
#pragma unroll
            for (int m = 0; m < 4; ++m) { const int row = row0 + ai * HALF + m * 16; float* rowp = C + (size_t)row * ldc + col0;
                const float rsb = __builtin_amdgcn_rsqf(acc2[2 * (size_t)row + 1] * inv_cnt + eps);
#pragma unroll
                for (int bj = 0; bj < 2; ++bj)
#pragma unroll
                    for (int n = 0; n < 2; ++n) *(f32x4*)(rowp + bj * HALF + n * 16) = acc[ai][bj][m][n] * rsb; }
    }
};

struct EpiBf16Norm2 {
    static constexpr bool PERM = true, AFTER_DRAIN = false, HAS_MID = true, I8 = false;
    bf16_t* O; int ldc; const float* acc2; float inv_cnt, eps;
    __device__ __forceinline__ void mid(f32x4 (&acc)[2][2][4][2], const Unit& u, int wr, int fr) const {
        const int row0 = u.pm * BM + wr * 64 + fr;
#pragma unroll
        for (int ai = 0; ai < 2; ++ai)
#pragma unroll
            for (int m = 0; m < 4; ++m) { const f32x2 s = *(const f32x2*)(acc2 + 2 * (size_t)(row0 + ai * HALF + m * 16));
                const float ratio = __builtin_amdgcn_sqrtf((s.y * inv_cnt + eps) * __builtin_amdgcn_rcpf(s.x * inv_cnt + eps));
#pragma unroll
                for (int bj = 0; bj < 2; ++bj)
#pragma unroll
                    for (int n = 0; n < 2; ++n) acc[ai][bj][m][n] *= ratio; }
    }
    __device__ __forceinline__ void operator()(const f32x4 (&acc)[2][2][4][2], const Unit& u, int wr, int wc, int fr, int fq) const {
        const int row0 = u.pm * BM + wr * 64 + fr, col0 = u.pn * BM + wc * 32 + 8 * fq;
#pragma unroll
        for (int ai = 0; ai < 2; ++ai)
#pragma unroll
            for (int m = 0; m < 4; ++m) { const int row = row0 + ai * HALF + m * 16; bf16_t* rowp = O + (size_t)row * ldc + col0;
                const float rsb = __builtin_amdgcn_rsqf(acc2[2 * (size_t)row + 1] * inv_cnt + eps);
#pragma unroll
                for (int bj = 0; bj < 2; ++bj) { const f32x4 v0 = acc[ai][bj][m][0] * rsb, v1 = acc[ai][bj][m][1] * rsb;
                    u32x4 w; w.x = cvt_pk_bf16(v0[0], v0[1]); w.y = cvt_pk_bf16(v0[2], v0[3]); w.z = cvt_pk_bf16(v1[0], v1[1]); w.w = cvt_pk_bf16(v1[2], v1[3]);
                    *(u32x4*)(rowp + bj * HALF) = w; } }
    }
};

typedef int i32x4e __attribute__((ext_vector_type(4)));
struct EpiSwiGLUI8 {
    static constexpr bool PERM = true, AFTER_DRAIN = false, HAS_MID = false, I8 = true;
    bf16_t* O; int ldc; const float* sa; const float* sbmax;
    __device__ __forceinline__ void operator()(const i32x4e (&acc)[2][2][4][2], const Unit& u, int wr, int wc, int fr, int fq) const {
        const int row0 = u.pm * BM + wr * 64 + fr, col0 = u.pn * HALF + wc * 32 + 8 * fq, brow0 = u.pn * BM + wc * 32 + 8 * fq;
        const f32x4 sg0 = *(const f32x4*)(sbmax + brow0) * (1.0f / 127.0f), sg1 = *(const f32x4*)(sbmax + brow0 + 4) * (1.0f / 127.0f);
        const f32x4 su0 = *(const f32x4*)(sbmax + brow0 + HALF) * (1.0f / 127.0f), su1 = *(const f32x4*)(sbmax + brow0 + HALF + 4) * (1.0f / 127.0f);
#pragma unroll
        for (int ai = 0; ai < 2; ++ai)
#pragma unroll
            for (int m = 0; m < 4; ++m) { const int row = row0 + ai * HALF + m * 16; bf16_t* rowp = O + (size_t)row * ldc + col0; const float s = sa[row];
                const f32x4 g0 = __builtin_convertvector(acc[ai][0][m][0], f32x4) * (sg0 * s), g1 = __builtin_convertvector(acc[ai][0][m][1], f32x4) * (sg1 * s);
                const f32x4 u0 = __builtin_convertvector(acc[ai][1][m][0], f32x4) * (su0 * s), u1 = __builtin_convertvector(acc[ai][1][m][1], f32x4) * (su1 * s);
                u32x4 w; w.x = cvt_pk_bf16(silu_mul(g0[0], u0[0]), silu_mul(g0[1], u0[1])); w.y = cvt_pk_bf16(silu_mul(g0[2], u0[2]), silu_mul(g0[3], u0[3]));
                w.z = cvt_pk_bf16(silu_mul(g1[0], u1[0]), silu_mul(g1[1], u1[1])); w.w = cvt_pk_bf16(silu_mul(g1[2], u1[2]), silu_mul(g1[3], u1[3]));
                *(u32x4*)rowp = w; }
    }
};


struct EpiBf16I8Norm2 {
    static constexpr bool PERM = true, AFTER_DRAIN = false, HAS_MID = true, I8 = true;
    bf16_t* O; int ldc; const float* scl; const float* sbmax;
    __device__ __forceinline__ void mid(i32x4e (&acc)[2][2][4][2], const Unit& u, int wr, int fr) const {
        const int row0 = u.pm * BM + wr * 64 + fr;
#pragma unroll
        for (int ai = 0; ai < 2; ++ai)
#pragma unroll
            for (int m = 0; m < 4; ++m) { const f32x2 s = *(const f32x2*)(scl + 2 * (size_t)(row0 + ai * HALF + m * 16));
                const float ratio = s.x * __builtin_amdgcn_rcpf(s.y);
#pragma unroll
                for (int bj = 0; bj < 2; ++bj)
#pragma unroll
                    for (int n = 0; n < 2; ++n) { const f32x4 t = __builtin_convertvector(acc[ai][bj][m][n], f32x4) * ratio;
                        acc[ai][bj][m][n] = (i32x4e){(int)__builtin_rintf(t[0]), (int)__builtin_rintf(t[1]), (int)__builtin_rintf(t[2]), (int)__builtin_rintf(t[3])}; } }
    }
    __device__ __forceinline__ void operator()(const i32x4e (&acc)[2][2][4][2], const Unit& u, int wr, int wc, int fr, int fq) const {
        const int row0 = u.pm * BM + wr * 64 + fr, col0 = u.pn * BM + wc * 32 + 8 * fq;
        f32x4 sb[2][2];
#pragma unroll
        for (int bj = 0; bj < 2; ++bj)
#pragma unroll
            for (int n = 0; n < 2; ++n) sb[bj][n] = *(const f32x4*)(sbmax + col0 + bj * HALF + 4 * n) * (1.0f / 127.0f);
#pragma unroll
        for (int ai = 0; ai < 2; ++ai)
#pragma unroll
            for (int m = 0; m < 4; ++m) { const int row = row0 + ai * HALF + m * 16; bf16_t* rowp = O + (size_t)row * ldc + col0; const float s = scl[2 * (size_t)row + 1];
#pragma unroll
                for (int bj = 0; bj < 2; ++bj) { const f32x4 v0 = __builtin_convertvector(acc[ai][bj][m][0], f32x4) * (sb[bj][0] * s), v1 = __builtin_convertvector(acc[ai][bj][m][1], f32x4) * (sb[bj][1] * s);
                    u32x4 w; w.x = cvt_pk_bf16(v0[0], v0[1]); w.y = cvt_pk_bf16(v0[2], v0[3]); w.z = cvt_pk_bf16(v1[0], v1[1]); w.w = cvt_pk_bf16(v1[2], v1[3]);
                    *(u32x4*)(rowp + bj * HALF) = w; } }
    }
};

struct EpiBf16I8 {
    static constexpr bool PERM = true, AFTER_DRAIN = false, HAS_MID = false, I8 = true;
    bf16_t* O; int ldc; const float* sa; const float* sbmax;
    __device__ __forceinline__ void operator()(const i32x4e (&acc)[2][2][4][2], const Unit& u, int wr, int wc, int fr, int fq) const {
        const int row0 = u.pm * BM + wr * 64 + fr, col0 = u.pn * BM + wc * 32 + 8 * fq;
        f32x4 sb[2][2];
#pragma unroll
        for (int bj = 0; bj < 2; ++bj)
#pragma unroll
            for (int n = 0; n < 2; ++n) sb[bj][n] = *(const f32x4*)(sbmax + col0 + bj * HALF + 4 * n) * (1.0f / 127.0f);
#pragma unroll
        for (int ai = 0; ai < 2; ++ai)
#pragma unroll
            for (int m = 0; m < 4; ++m) { const int row = row0 + ai * HALF + m * 16; bf16_t* rowp = O + (size_t)row * ldc + col0; const float s = sa[row];
#pragma unroll
                for (int bj = 0; bj < 2; ++bj) { const f32x4 v0 = __builtin_convertvector(acc[ai][bj][m][0], f32x4) * (sb[bj][0] * s), v1 = __builtin_convertvector(acc[ai][bj][m][1], f32x4) * (sb[bj][1] * s);
                    u32x4 w; w.x = cvt_pk_bf16(v0[0], v0[1]); w.y = cvt_pk_bf16(v0[2], v0[3]); w.z = cvt_pk_bf16(v1[0], v1[1]); w.w = cvt_pk_bf16(v1[2], v1[3]);
                    *(u32x4*)(rowp + bj * HALF) = w; } }
    }
};

struct EpiBf16Blk {
    static constexpr bool PERM = true, AFTER_DRAIN = false, HAS_MID = false, I8 = false;
    bf16_t* O; int rows;
    __device__ __forceinline__ void operator()(const f32x4 (&acc)[2][2][4][2], const Unit& u, int wr, int wc, int fr, int fq) const {
        const int row0 = u.pm * BM + wr * 64 + fr, cin = wc * 32 + 8 * fq;
#pragma unroll
        for (int ai = 0; ai < 2; ++ai)
#pragma unroll
            for (int m = 0; m < 4; ++m) {
#pragma unroll
                for (int bj = 0; bj < 2; ++bj) { bf16_t* p = O + ((size_t)(u.pn * 2 + bj) * rows + (row0 + ai * HALF + m * 16)) * 128 + cin;
                    const f32x4 v0 = acc[ai][bj][m][0], v1 = acc[ai][bj][m][1];
                    u32x4 w; w.x = cvt_pk_bf16(v0[0], v0[1]); w.y = cvt_pk_bf16(v0[2], v0[3]); w.z = cvt_pk_bf16(v1[0], v1[1]); w.w = cvt_pk_bf16(v1[2], v1[3]);
                    *(u32x4*)p = w; } }
    }
};

typedef int i32x4 __attribute__((ext_vector_type(4)));
template <bool I8> struct AccSel { typedef f32x4 T; };
template <> struct AccSel<true> { typedef i32x4 T; };
template <bool I8> __device__ __forceinline__ typename AccSel<I8>::T mma16(bf16x8 b, bf16x8 a, typename AccSel<I8>::T c) {
    if constexpr (I8) return __builtin_amdgcn_mfma_i32_16x16x64_i8(__builtin_bit_cast(i32x4, b), __builtin_bit_cast(i32x4, a), c, 0, 0, 0);
    else return __builtin_amdgcn_mfma_f32_16x16x32_bf16(b, a, c, 0, 0, 0);
}
template <class Epi, class Sched, bool ALIGN_EPI = false, bool SP2 = false>
__device__ __forceinline__ void gemm_phase(PG8_LAS unsigned char* lds, const Gemm g, const Sched& S, const Epi& E, const int wave_id  ) {
    unsigned zero_ = 0u; asm volatile("" : "+s"(zero_));
    int tid = wave_id * 64 + (int)__builtin_amdgcn_mbcnt_hi(~0u, __builtin_amdgcn_mbcnt_lo(~0u, zero_)); asm volatile("" : "+v"(tid));
    const int wid = __builtin_amdgcn_readfirstlane(tid >> 6), lane = tid & 63, wr = wid >> 2, wc = wid & 3, fr = lane & 15, fq = lane >> 4;
    const int K = g.K, nt = K / BK;
    unsigned voffA[2], voffB[2];
#pragma unroll
    for (int i = 0; i < 2; ++i) { int R, C; stage_rc(tid * 16 + i * 8192, R, C); const int Rb = Epi::PERM ? ((R & ~31) + perm32(R & 31)) : R;
        voffA[i] = (unsigned)(R * K + C) * 2u; voffB[i] = (unsigned)(Rb * K + C) * 2u; }
    const size_t kstep = (size_t)(BK * 2);
    const size_t hstep = (size_t)HALF * K * 2;
    const size_t tstep = 2 * hstep;
    const unsigned ldsw = (unsigned)wid * 1024u;
    const int aoff = lds_byte(wr * 64 + fr, fq * 8), boff = lds_byte(wc * 32 + fr, fq * 8);
#define PG8_SA(b, h) (((b) * 2 + (h)) * HTB)
#define PG8_SB(b, h) ((4 + (b) * 2 + (h)) * HTB)
#define PG8_STAGE(bufoff, gbase, voff) do { _Pragma("unroll") for (int _i = 0; _i < 2; ++_i) \
        __builtin_amdgcn_global_load_lds((const unsigned*)((const char*)(gbase) + (voff)[_i]), (PG8_LAS unsigned*)(lds + (bufoff) + ldsw + _i * 8192), 16, 0, 0); } while (0)
#define PG8_LDA(dst, b, h) do { _Pragma("unroll") for (int m = 0; m < 4; ++m) _Pragma("unroll") for (int k = 0; k < 2; ++k) dst[m][k] = *(const PG8_LAS bf16x8*)(lds + PG8_SA(b, h) + aoff + m * 2048 + k * 1024); } while (0)
#define PG8_LDB(dst, b, h) do { _Pragma("unroll") for (int n = 0; n < 2; ++n) _Pragma("unroll") for (int k = 0; k < 2; ++k) dst[n][k] = *(const PG8_LAS bf16x8*)(lds + PG8_SB(b, h) + boff + n * 2048 + k * 1024); } while (0)
#define PG8_MMA(ai, bj, At, Bt) do { __builtin_amdgcn_s_setprio(1); _Pragma("unroll") for (int m = 0; m < 4; ++m) _Pragma("unroll") for (int n = 0; n < 2; ++n) _Pragma("unroll") for (int k = 0; k < 2; ++k) \
        acc[ai][bj][m][n] = mma16<Epi::I8>(Bt[n][k], At[m][k], acc[ai][bj][m][n]); __builtin_amdgcn_s_setprio(0); } while (0)
#define PG8_WAIT_V(n) asm volatile("s_waitcnt vmcnt(" #n ")" ::: "memory")
#define PG8_WAIT_L(n) asm volatile("s_waitcnt lgkmcnt(" #n ")" ::: "memory")
#define PG8_BAR __builtin_amdgcn_s_barrier()
#define PG8_SCHED __builtin_amdgcn_sched_barrier(0)
    Unit cur, nxt; int ui = 0;
    if (!S.next(0, cur)) return;
    typedef typename AccSel<Epi::I8>::T acc_t;
    acc_t acc[2][2][4][2];
#pragma unroll
    for (int a = 0; a < 2; ++a)
#pragma unroll
        for (int b = 0; b < 2; ++b)
#pragma unroll
            for (int m = 0; m < 4; ++m)
#pragma unroll
                for (int n = 0; n < 2; ++n) acc[a][b][m][n] = acc_t{};
    bf16x8 At[4][2], B0[2][2], B1[2][2];
    const char* cA = (const char*)g.A + (size_t)cur.pm * tstep; const char* cB = (const char*)g.Bt + (size_t)cur.pn * tstep;
    S.a_ready(cur);
    if constexpr (SP2) {
        PG8_STAGE(PG8_SB(0, 0), cB, voffB); PG8_STAGE(PG8_SB(0, 1), cB + hstep, voffB); PG8_STAGE(PG8_SA(0, 0), cA, voffA); PG8_STAGE(PG8_SA(0, 1), cA + hstep, voffA);
        if (wr == 1) PG8_BAR;
        PG8_WAIT_V(2); PG8_BAR;
        PG8_STAGE(PG8_SB(1, 0), cB + kstep, voffB); PG8_STAGE(PG8_SA(1, 0), cA + kstep, voffA); PG8_STAGE(PG8_SB(1, 1), cB + hstep + kstep, voffB);
        PG8_WAIT_V(6); PG8_BAR;
    } else {
        PG8_STAGE(PG8_SB(0, 0), cB, voffB); PG8_STAGE(PG8_SA(0, 0), cA, voffA); PG8_STAGE(PG8_SB(0, 1), cB + hstep, voffB); PG8_STAGE(PG8_SA(0, 1), cA + hstep, voffA);
        if (wr == 1) PG8_BAR;
        PG8_WAIT_V(4); PG8_BAR;
        PG8_STAGE(PG8_SB(1, 0), cB + kstep, voffB); PG8_STAGE(PG8_SA(1, 0), cA + kstep, voffA); PG8_STAGE(PG8_SB(1, 1), cB + hstep + kstep, voffB);
        PG8_WAIT_V(6); PG8_BAR;
    }
    for (;;) {
        const bool has_next = S.next(ui + 1, nxt);
        const char* nA = has_next ? (const char*)g.A + (size_t)nxt.pm * tstep : cA; const char* nB = has_next ? (const char*)g.Bt + (size_t)nxt.pn * tstep : cB;
        for (int t = 0; t < nt; t += 2) {
            const bool last = (t == nt - 2);
            const char* a1 = cA + (size_t)(t + 1) * kstep;
            const char* a2 = last ? nA : cA + (size_t)(t + 2) * kstep; const char* b2 = last ? nB : cB + (size_t)(t + 2) * kstep;
            const char* a3 = a2 + kstep; const char* b3 = b2 + kstep;
            if (last && has_next) S.a_ready(nxt);
            if constexpr (Epi::HAS_MID) { if (t == (nt >> 1)) { unsigned z2_ = 0u; asm volatile("" : "+s"(z2_)); const int l2_ = (int)__builtin_amdgcn_mbcnt_hi(~0u, __builtin_amdgcn_mbcnt_lo(~0u, z2_)); E.mid(acc, cur, wr, l2_ & 15); } }
            if constexpr (SP2) {
            PG8_LDB(B0, 0, 0); PG8_LDB(B1, 0, 1); PG8_SCHED; PG8_LDA(At, 0, 0); PG8_STAGE(PG8_SA(1, 1), a1 + hstep, voffA);
            PG8_WAIT_V(8); PG8_WAIT_L(0); PG8_BAR; PG8_MMA(0, 0, At, B0); PG8_MMA(0, 1, At, B1); PG8_BAR; PG8_SCHED;
            PG8_LDA(At, 0, 1); PG8_STAGE(PG8_SB(0, 0), b2, voffB); PG8_STAGE(PG8_SB(0, 1), b2 + hstep, voffB); PG8_STAGE(PG8_SA(0, 0), a2, voffA);
            PG8_WAIT_V(8); PG8_WAIT_L(0); PG8_BAR; PG8_MMA(1, 0, At, B0); PG8_MMA(1, 1, At, B1); PG8_BAR; PG8_SCHED;
            PG8_LDB(B0, 1, 0); PG8_LDB(B1, 1, 1); PG8_SCHED; PG8_LDA(At, 1, 0); PG8_STAGE(PG8_SA(0, 1), a2 + hstep, voffA);
            PG8_WAIT_V(8); PG8_WAIT_L(0); PG8_BAR; PG8_MMA(0, 0, At, B0); PG8_MMA(0, 1, At, B1); PG8_BAR; PG8_SCHED;
            PG8_LDA(At, 1, 1); PG8_STAGE(PG8_SB(1, 0), b3, voffB); PG8_STAGE(PG8_SB(1, 1), b3 + hstep, voffB); PG8_STAGE(PG8_SA(1, 0), a3, voffA);
            PG8_WAIT_V(8); PG8_WAIT_L(0); PG8_BAR; PG8_MMA(1, 0, At, B0); PG8_MMA(1, 1, At, B1); PG8_BAR; PG8_SCHED;
            } else {
            PG8_LDB(B0, 0, 0); PG8_SCHED; PG8_LDA(At, 0, 0); PG8_STAGE(PG8_SA(1, 1), a1 + hstep, voffA);
            PG8_WAIT_L(8); PG8_BAR; PG8_WAIT_L(0); PG8_MMA(0, 0, At, B0); PG8_BAR; PG8_SCHED;
            PG8_LDB(B1, 0, 1); PG8_STAGE(PG8_SB(0, 0), b2, voffB);
            PG8_BAR; PG8_WAIT_L(0); PG8_MMA(0, 1, At, B1); PG8_BAR;
            PG8_LDA(At, 0, 1); PG8_STAGE(PG8_SA(0, 0), a2, voffA);
            PG8_BAR; PG8_WAIT_L(0); PG8_MMA(1, 0, At, B0); PG8_BAR; PG8_SCHED;
            PG8_STAGE(PG8_SB(0, 1), b2 + hstep, voffB);
            PG8_WAIT_V(6); PG8_BAR; PG8_MMA(1, 1, At, B1); PG8_BAR;
            PG8_LDB(B0, 1, 0); PG8_SCHED; PG8_LDA(At, 1, 0); PG8_STAGE(PG8_SA(0, 1), a2 + hstep, voffA);
            PG8_WAIT_L(8); PG8_BAR; PG8_WAIT_L(0); PG8_MMA(0, 0, At, B0); PG8_BAR; PG8_SCHED;
            PG8_LDB(B1, 1, 1); PG8_STAGE(PG8_SB(1, 0), b3, voffB);
            PG8_BAR; PG8_WAIT_L(0); PG8_MMA(0, 1, At, B1); PG8_BAR;
            PG8_LDA(At, 1, 1); PG8_STAGE(PG8_SA(1, 0), a3, voffA);
            PG8_BAR; PG8_WAIT_L(0); PG8_MMA(1, 0, At, B0); PG8_BAR; PG8_SCHED;
            PG8_STAGE(PG8_SB(1, 1), b3 + hstep, voffB);
            PG8_WAIT_V(6); PG8_BAR; PG8_MMA(1, 1, At, B1); PG8_BAR;
            }
        }
        if constexpr (ALIGN_EPI) { if (wr == 0) PG8_BAR; }
        if constexpr (!Epi::AFTER_DRAIN) { unsigned z3_ = 0u; asm volatile("" : "+s"(z3_)); const int l3_ = (int)__builtin_amdgcn_mbcnt_hi(~0u, __builtin_amdgcn_mbcnt_lo(~0u, z3_));
            E(acc, cur, wr, wc, l3_ & 15, l3_ >> 4); S.done(cur); }
        if (!has_next) break;
#pragma unroll
        for (int a = 0; a < 2; ++a)
#pragma unroll
            for (int b = 0; b < 2; ++b)
#pragma unroll
                for (int m = 0; m < 4; ++m)
#pragma unroll
                    for (int n = 0; n < 2; ++n) acc[a][b][m][n] = acc_t{};
        cur = nxt; cA = nA; cB = nB; ++ui;
        if constexpr (ALIGN_EPI) { if (wr == 1) PG8_BAR; }
    }
    PG8_WAIT_V(0);
    if constexpr (!ALIGN_EPI) { if (wr == 0) PG8_BAR; }
    PG8_BAR;
    if constexpr (Epi::AFTER_DRAIN) { E.fused(acc, cur, wr, wc, fr, fq, lds, wid, lane); S.done(cur); }
#undef PG8_SA
#undef PG8_SB
#undef PG8_STAGE
#undef PG8_LDA
#undef PG8_LDB
#undef PG8_MMA
#undef PG8_WAIT_V
#undef PG8_WAIT_L
#undef PG8_BAR
#undef PG8_SCHED
}
}
namespace att {
#define ALDS __attribute__((address_space(3)))
using bf16 = __hip_bfloat16;
using bf16x8 = __attribute__((ext_vector_type(8))) short;
using s16x4  = __attribute__((ext_vector_type(4))) short;
using f32x16 = __attribute__((ext_vector_type(16))) float;
using u32x4  = __attribute__((ext_vector_type(4))) unsigned;
constexpr int LDP = 9216;
constexpr int PROWS = 24832;
constexpr int LDO = 4096;
constexpr int META_ROW = 24576;
constexpr int SHM_V = 16384, SHM_K = 16384;
constexpr int OFF_WS = 65536, OFF_TAB = 65536 + 2048, ATT_LDS = OFF_TAB + 15 * 128 * 4;
constexpr float LOG2E = 1.4426950408889634f;
constexpr float THRX = 8.0f;
constexpr float NEG = -1e30f;
#define KSWZ(row, colB) ((row) * 256 + ((colB) ^ (((row) & 15) << 4)))
#define SBAR() __builtin_amdgcn_sched_barrier(0)
__device__ __forceinline__ int crow(int r, int hi) { return (r & 3) + 8 * (r >> 2) + 4 * hi; }
__device__ __forceinline__ unsigned cvtpk(float lo, float hi) { unsigned r; asm volatile("v_cvt_pk_bf16_f32 %0, %1, %2" : "=v"(r) : "v"(lo), "v"(hi)); return r; }

struct UnitP { int seqbase, T, head, blk; };

__device__ __forceinline__ void partialSM(f32x16& p0, f32x16& p1, float& m_reg, float& alpha) {
  float pmax = p0[0];
#pragma unroll
  for (int r = 1; r < 16; ++r) pmax = fmaxf(pmax, p0[r]);
#pragma unroll
  for (int r = 0; r < 16; ++r) pmax = fmaxf(pmax, p1[r]);
  { auto rr = __builtin_amdgcn_permlane32_swap(__float_as_uint(pmax), __float_as_uint(pmax), false, false);
    pmax = fmaxf(__uint_as_float(rr[0]), __uint_as_float(rr[1])); }
  float mn;
  if (__builtin_expect(__all(pmax - m_reg <= THRX), 1)) { mn = m_reg; alpha = 1.f; }
  else { mn = fmaxf(m_reg, pmax); alpha = __builtin_amdgcn_exp2f(m_reg - mn); m_reg = mn; }
#pragma unroll
  for (int r = 0; r < 16; ++r) p0[r] = p0[r] - mn;
#pragma unroll
  for (int r = 0; r < 16; ++r) p1[r] = p1[r] - mn;
#pragma unroll
  for (int r = 0; r < 16; ++r) p0[r] = __builtin_amdgcn_exp2f(p0[r]);
}
__device__ __forceinline__ void finishSM(f32x16& p0, f32x16& p1, float alpha, float& l_reg, bf16x8& pa0, bf16x8& pa1, bf16x8& pa2, bf16x8& pa3) {
#pragma unroll
  for (int r = 0; r < 16; ++r) p1[r] = __builtin_amdgcn_exp2f(p1[r]);
  float ps = 0;
#pragma unroll
  for (int r = 0; r < 16; ++r) ps += p0[r];
#pragma unroll
  for (int r = 0; r < 16; ++r) ps += p1[r];
  { auto rr = __builtin_amdgcn_permlane32_swap(__float_as_uint(ps), __float_as_uint(ps), false, false);
    ps = __uint_as_float(rr[0]) + __uint_as_float(rr[1]); }
  l_reg = l_reg * alpha + ps;
#define PK4(P, BASE, OUT) do { unsigned a0 = cvtpk(P[BASE + 0], P[BASE + 1]), a1 = cvtpk(P[BASE + 2], P[BASE + 3]);   \
    unsigned b0 = cvtpk(P[BASE + 4], P[BASE + 5]), b1 = cvtpk(P[BASE + 6], P[BASE + 7]);                              \
    auto r0 = __builtin_amdgcn_permlane32_swap(a0, b0, false, false); auto r1 = __builtin_amdgcn_permlane32_swap(a1, b1, false, false); \
    u32x4 w = {r0[0], r1[0], r0[1], r1[1]}; OUT = *reinterpret_cast<bf16x8*>(&w); } while (0)
  PK4(p0, 0, pa0); PK4(p0, 8, pa1); PK4(p1, 0, pa2); PK4(p1, 8, pa3);
#undef PK4
}
__device__ __forceinline__ void qkt(f32x16& p0, f32x16& p1, const ALDS char* Ks, const bf16x8* qr, int r32, int hi) {
  p0 = f32x16{}; p1 = f32x16{};
#pragma unroll
  for (int d0 = 0; d0 < 8; ++d0) { int cb = (d0 * 16 + hi * 8) * 2;
    bf16x8 b0 = *(const ALDS bf16x8*)(Ks + KSWZ(r32, cb));
    bf16x8 b1 = *(const ALDS bf16x8*)(Ks + KSWZ(32 + r32, cb));
    p0 = __builtin_amdgcn_mfma_f32_32x32x16_bf16(b0, qr[d0], p0, 0, 0, 0);
    p1 = __builtin_amdgcn_mfma_f32_32x32x16_bf16(b1, qr[d0], p1, 0, 0, 0); }
}
__device__ __forceinline__ int v_st(int k, int c) { const int kk = (k & ~0xC) | ((k & 4) << 1) | ((k & 8) >> 1); return ((kk >> 3) * 4 + (c >> 5)) * 512 + ((kk & 7) * 32 + (c & 31)) * 2; }
__device__ __forceinline__ int v_rd_base(int lane) { return ((lane & 3) << 3) | (((lane >> 2) & 3) << 6) | (((lane >> 4) & 1) << 5) | (((lane >> 5) & 1) << 8); }
constexpr int v_rd_off(int d0, int ks, int half) { return d0 * 512 + ks * 4096 + half * 2048; }
template <int OFF> __device__ __forceinline__ s16x4 tr_read(int vb) {
  s16x4 r; asm volatile("ds_read_b64_tr_b16 %0, %1 offset:%2" : "=&v"(r) : "v"(vb), "i"(OFF) : "memory"); return r;
}
template <int D0> __device__ __forceinline__ void pv_one(f32x16& od, int vb, bf16x8 pa0, bf16x8 pa1, bf16x8 pa2, bf16x8 pa3) {
  const s16x4 l0 = tr_read<v_rd_off(D0, 0, 0)>(vb), h0 = tr_read<v_rd_off(D0, 0, 1)>(vb), l1 = tr_read<v_rd_off(D0, 1, 0)>(vb), h1 = tr_read<v_rd_off(D0, 1, 1)>(vb);
  const s16x4 l2 = tr_read<v_rd_off(D0, 2, 0)>(vb), h2 = tr_read<v_rd_off(D0, 2, 1)>(vb), l3 = tr_read<v_rd_off(D0, 3, 0)>(vb), h3 = tr_read<v_rd_off(D0, 3, 1)>(vb);
  asm volatile("s_waitcnt lgkmcnt(0)" ::: "memory"); SBAR();
#define PK(L, H) (bf16x8){L[0], L[1], L[2], L[3], H[0], H[1], H[2], H[3]}
  od = __builtin_amdgcn_mfma_f32_32x32x16_bf16(pa0, PK(l0, h0), od, 0, 0, 0);
  od = __builtin_amdgcn_mfma_f32_32x32x16_bf16(pa1, PK(l1, h1), od, 0, 0, 0);
  od = __builtin_amdgcn_mfma_f32_32x32x16_bf16(pa2, PK(l2, h2), od, 0, 0, 0);
  od = __builtin_amdgcn_mfma_f32_32x32x16_bf16(pa3, PK(l3, h3), od, 0, 0, 0);
#undef PK
}
__device__ __forceinline__ void pv_d0(f32x16* o, int vb, bf16x8 pa0, bf16x8 pa1, bf16x8 pa2, bf16x8 pa3) {
  pv_one<0>(o[0], vb, pa0, pa1, pa2, pa3); pv_one<1>(o[1], vb, pa0, pa1, pa2, pa3); pv_one<2>(o[2], vb, pa0, pa1, pa2, pa3); pv_one<3>(o[3], vb, pa0, pa1, pa2, pa3);
}
__device__ __forceinline__ float bf_lo(unsigned w) { return __uint_as_float(w << 16); }
__device__ __forceinline__ float bf_hi(unsigned w) { return __uint_as_float(w & 0xffff0000u); }

template <int KIND> __device__ __forceinline__ int tile_row(const UnitP& u, int j) {
  if (j == 0) return META_ROW;
  if (KIND == 0) { const int rows = u.T >> 6; int rs0 = 4 * u.blk - 4; rs0 = rs0 < 0 ? 0 : (rs0 > rows - 8 ? rows - 8 : rs0);
    int kr = rs0 + j - 1; kr = kr > rows - 1 ? rows - 1 : kr; return u.seqbase + 64 * kr; }
  else { int ks = 64 * u.blk + 64 * (j - 3); ks = ks < 0 ? 0 : (ks > u.T - 64 ? u.T - 64 : ks); return u.seqbase + ks; }
}


__device__ __forceinline__ void qkt1(f32x16& p, const ALDS char* Ks, const bf16x8* qr, int koff  , int r32, int hi) {
  p = f32x16{};
#pragma unroll
  for (int d0 = 0; d0 < 8; ++d0) { const int cb = (d0 * 16 + hi * 8) * 2;
    const bf16x8 b0 = *(const ALDS bf16x8*)(Ks + koff + (cb ^ ((r32 & 15) << 4)));
    p = __builtin_amdgcn_mfma_f32_32x32x16_bf16(b0, qr[d0], p, 0, 0, 0); }
}
__device__ __forceinline__ void partialSM1(f32x16& p, float& m_reg, float& alpha) {
  float pmax = p[0];
#pragma unroll
  for (int r = 1; r < 16; ++r) pmax = fmaxf(pmax, p[r]);
  { auto rr = __builtin_amdgcn_permlane32_swap(__float_as_uint(pmax), __float_as_uint(pmax), false, false);
    pmax = fmaxf(__uint_as_float(rr[0]), __uint_as_float(rr[1])); }
  float mn;
  if (__builtin_expect(__all(pmax - m_reg <= THRX), 1)) { mn = m_reg; alpha = 1.f; }
  else { mn = fmaxf(m_reg, pmax); alpha = __builtin_amdgcn_exp2f(m_reg - mn); m_reg = mn; }
#pragma unroll
  for (int r = 0; r < 16; ++r) p[r] = p[r] - mn;
#pragma unroll
  for (int r = 0; r < 8; ++r) p[r] = __builtin_amdgcn_exp2f(p[r]);
}
__device__ __forceinline__ void finishSM1(f32x16& p, float alpha, float& l_reg, bf16x8& pa0, bf16x8& pa1) {
#pragma unroll
  for (int r = 8; r < 16; ++r) p[r] = __builtin_amdgcn_exp2f(p[r]);
  float ps = 0;
#pragma unroll
  for (int r = 0; r < 16; ++r) ps += p[r];
  { auto rr = __builtin_amdgcn_permlane32_swap(__float_as_uint(ps), __float_as_uint(ps), false, false);
    ps = __uint_as_float(rr[0]) + __uint_as_float(rr[1]); }
  l_reg = l_reg * alpha + ps;
#define PK4(P, BASE, OUT) do { unsigned a0 = cvtpk(P[BASE + 0], P[BASE + 1]), a1 = cvtpk(P[BASE + 2], P[BASE + 3]);   \
    unsigned b0 = cvtpk(P[BASE + 4], P[BASE + 5]), b1 = cvtpk(P[BASE + 6], P[BASE + 7]);                              \
    auto r0 = __builtin_amdgcn_permlane32_swap(a0, b0, false, false); auto r1 = __builtin_amdgcn_permlane32_swap(a1, b1, false, false); \
    u32x4 w = {r0[0], r1[0], r0[1], r1[1]}; OUT = *reinterpret_cast<bf16x8*>(&w); } while (0)
  PK4(p, 0, pa0); PK4(p, 8, pa1);
#undef PK4
}
template <int D0> __device__ __forceinline__ void pv2_one(f32x16& od, int vbA, int vbB, bf16x8 pa0, bf16x8 pa1) {
  const s16x4 l0 = tr_read<D0 * 512>(vbA), h0 = tr_read<D0 * 512 + 2048>(vbA), l1 = tr_read<D0 * 512>(vbB), h1 = tr_read<D0 * 512 + 2048>(vbB);
  asm volatile("s_waitcnt lgkmcnt(0)" ::: "memory"); SBAR();
#define PK(L, H) (bf16x8){L[0], L[1], L[2], L[3], H[0], H[1], H[2], H[3]}
  od = __builtin_amdgcn_mfma_f32_32x32x16_bf16(pa0, PK(l0, h0), od, 0, 0, 0);
  od = __builtin_amdgcn_mfma_f32_32x32x16_bf16(pa1, PK(l1, h1), od, 0, 0, 0);
#undef PK
}
__device__ __forceinline__ void pv2(f32x16* o, int vbA, int vbB, bf16x8 pa0, bf16x8 pa1) {
  pv2_one<0>(o[0], vbA, vbB, pa0, pa1); pv2_one<1>(o[1], vbA, vbB, pa0, pa1); pv2_one<2>(o[2], vbA, vbB, pa0, pa1); pv2_one<3>(o[3], vbA, vbB, pa0, pa1);
}

constexpr int RB = 32768, NRB = 3, D_OFF_WS = NRB * RB, D_OFF_TAB = D_OFF_WS + 2048, D_ATT_LDS = D_OFF_TAB + 15 * 128 * 4;
struct DmaSrc { const bf16* k[2]; const bf16* v[2]; };
__device__ __forceinline__ DmaSrc dma_src(const bf16* P, int kcol, int vcol, int wid, int lane) {
  DmaSrc s;
#pragma unroll
  for (int i = 0; i < 2; ++i) {
    const int piece = i * 8 + wid;
    { const int row = piece * 4 + (lane >> 4), chunk = (lane & 15) ^ (row & 15); s.k[i] = P + ((size_t)(kcol >> 7) * PROWS + row) * 128 + chunk * 8; }
    { const int sub = piece * 2 + (lane >> 5), kk = (sub >> 2) * 8 + ((lane >> 2) & 7), c = (sub & 3) * 32 + (lane & 3) * 8;
      const int k = (kk & ~0xC) | ((kk & 4) << 1) | ((kk & 8) >> 1); s.v[i] = P + ((size_t)(vcol >> 7) * PROWS + k) * 128 + c; }
  }
  return s;
}
#define DMA_WAIT_BAR(last) do { if (last) asm volatile("s_waitcnt vmcnt(0) lgkmcnt(0)" ::: "memory"); else asm volatile("s_waitcnt vmcnt(4) lgkmcnt(0)" ::: "memory"); \
    __builtin_amdgcn_s_barrier(); asm volatile("" ::: "memory"); } while (0)
#define PK4(P, BASE, OUT) do { unsigned a0 = cvtpk(P[BASE + 0], P[BASE + 1]), a1 = cvtpk(P[BASE + 2], P[BASE + 3]);   \
    unsigned b0 = cvtpk(P[BASE + 4], P[BASE + 5]), b1 = cvtpk(P[BASE + 6], P[BASE + 7]);                              \
    auto r0 = __builtin_amdgcn_permlane32_swap(a0, b0, false, false); auto r1 = __builtin_amdgcn_permlane32_swap(a1, b1, false, false); \
    u32x4 w = {r0[0], r1[0], r0[1], r1[1]}; OUT = *reinterpret_cast<bf16x8*>(&w); } while (0)
#define ATT_EPILOGUE(OROW_EXPR, SSQ_IDX) do { \
  unsigned ze_ = 0u; asm volatile("" : "+s"(ze_)); const int lane_e = (int)__builtin_amdgcn_mbcnt_hi(~0u, __builtin_amdgcn_mbcnt_lo(~0u, ze_)), r32e = lane_e & 31, hie = lane_e >> 5; \
  if (hie == 0) li_l[r32e] = l_reg; asm volatile("s_waitcnt lgkmcnt(0)" ::: "memory"); \
  ALDS unsigned short* stg = (ALDS unsigned short*)(lds + wid * 8192); \
  _Pragma("unroll") for (int r = 0; r < 16; ++r) { const int orow = crow(r, hie); const float rl = __builtin_amdgcn_rcpf(li_l[orow]); \
    _Pragma("unroll") for (int d0 = 0; d0 < 4; ++d0) stg[orow * 128 + d0 * 32 + r32e] = (unsigned short)(cvtpk(o[d0][r] * rl, 0.f) & 0xffffu); } \
  asm volatile("s_waitcnt lgkmcnt(0)" ::: "memory"); \
  const int q = lane_e >> 1, half = lane_e & 1; float ss = 0.f; \
  const size_t orow_g = (size_t)(OROW_EXPR); \
  bf16* og = O + orow_g * LDO + ocol + half * 64; \
  _Pragma("unroll") for (int i = 0; i < 8; ++i) { const u32x4 v = *(const ALDS u32x4*)(stg + q * 128 + half * 64 + i * 8); \
    ss += bf_lo(v.x) * bf_lo(v.x) + bf_hi(v.x) * bf_hi(v.x) + bf_lo(v.y) * bf_lo(v.y) + bf_hi(v.y) * bf_hi(v.y) \
        + bf_lo(v.z) * bf_lo(v.z) + bf_hi(v.z) * bf_hi(v.z) + bf_lo(v.w) * bf_lo(v.w) + bf_hi(v.w) * bf_hi(v.w); \
    *(u32x4*)(og + i * 8) = v; } \
  ss += __builtin_bit_cast(float, __builtin_amdgcn_update_dpp(0, __builtin_bit_cast(int, ss), 0xB1, 0xF, 0xF, false)); \
  if (half == 0 && do_ssq) atomicAdd(ssq + orow_g * 2 + (SSQ_IDX), ss); } while (0)


constexpr int P_VOFF = 0, P_KOFF = 4 * 16384, P_OFF_WS = P_KOFF + 3 * 16384, P_OFF_TAB = P_OFF_WS + 2048, P_ATT_LDS = P_OFF_TAB + 15 * 128 * 4;
__device__ __forceinline__ void dma_tile_kv(const DmaSrc& s, size_t rowoff, ALDS char* vslot, ALDS char* kslot, int wid) {
#pragma unroll
  for (int i = 0; i < 2; ++i) {
    __builtin_amdgcn_global_load_lds((const unsigned*)(s.v[i] + rowoff), (ALDS unsigned*)(vslot + (i * 8 + wid) * 1024), 16, 0, 0);
    __builtin_amdgcn_global_load_lds((const unsigned*)(s.k[i] + rowoff), (ALDS unsigned*)(kslot + (i * 8 + wid) * 1024), 16, 0, 0);
  }
}
#define RESC4(a) do { if (__any((a) < 1.f)) { if (hi == 0) al_l[r32] = (a); asm volatile("s_waitcnt lgkmcnt(0)" ::: "memory"); \
    _Pragma("unroll") for (int r = 0; r < 16; ++r) { const float a_ = al_l[crow(r, hi)]; _Pragma("unroll") for (int d = 0; d < 4; ++d) o[d][r] *= a_; } } } while (0)
#define STEP_ENTER(TR, j) do { DMA_WAIT_BAR((j) + 1 >= NT); \
    if ((j) + 2 < NT) { const int k2_ = k3 == 0 ? 2 : k3 - 1; dma_tile_kv(src, (size_t)TR(u, (j) + 2) * 128, lds + P_VOFF + (((j) + 2) & 3) * 16384, lds + P_KOFF + k2_ * 16384, wid); } } while (0)
#define STEP_LEAVE() do { k3 = k3 == 2 ? 0 : k3 + 1; } while (0)

__device__ __forceinline__ void attn_unit_na4(const UnitP u, const bf16* __restrict__ P, bf16* __restrict__ O, float* __restrict__ ssq,
                                              const float* __restrict__ rpb, ALDS char* lds, const int wave_id, const bool do_ssq = true) {
  constexpr int NT = 12;
  unsigned zero_ = 0u; asm volatile("" : "+s"(zero_));
  int tid = wave_id * 64 + (int)__builtin_amdgcn_mbcnt_hi(~0u, __builtin_amdgcn_mbcnt_lo(~0u, zero_)); asm volatile("" : "+v"(tid));
  const int wid = __builtin_amdgcn_readfirstlane(tid >> 6), lane = tid & 63, r32 = lane & 31, hi = lane >> 5;
  ALDS float* wsf = (ALDS float*)(lds + P_OFF_WS) + wid * 64; ALDS float* li_l = wsf; ALDS float* al_l = wsf + 32;
  ALDS float* tab = (ALDS float*)(lds + P_OFF_TAB);
  const int rows = u.T >> 6, rp = wid >> 2, cg = wid & 3, R0 = 4 * u.blk + 2 * rp;
  const int kbA = cg == 0 ? 0 : cg - 1, kbB = cg == 0 ? 3 : cg;
  const int qi = r32 & 15, Rq = R0 + (r32 >> 4);
  const int qc = cg == 0 ? (qi < 8 ? qi : 48 + qi) : 16 * cg - 8 + qi;
  const int qrow = u.seqbase + 64 * Rq + qc;
  const int kcol = 2048 + 128 * u.head, vcol = 4096 + 128 * u.head, ocol = 128 * u.head;
  int rs0 = 4 * u.blk - 4; rs0 = rs0 < 0 ? 0 : (rs0 > rows - 8 ? rows - 8 : rs0);
  const int koffT = ((r32 < 16 ? 16 * kbA : 16 * kbB - 16) + r32) * 256;
  const DmaSrc src = dma_src(P, kcol, vcol, wid, lane);
  dma_tile_kv(src, (size_t)tile_row<0>(u, 0) * 128, lds + P_VOFF, lds + P_KOFF, wid); dma_tile_kv(src, (size_t)tile_row<0>(u, 1) * 128, lds + P_VOFF + 16384, lds + P_KOFF + 16384, wid);
  for (int idx = tid; idx < 15 * 128; idx += 512) { const int ir = idx >> 7, e = (idx & 127) - 48;
    tab[idx] = (e >= 0 && e <= 30) ? rpb[u.head * 465 + ir * 31 + e] * LOG2E : 0.f; }
  float m_reg = -1e30f, l_reg = 0; f32x16 o[4] = {}; bf16x8 qr[8];
  { const bf16* Qw = P + ((size_t)u.head * PROWS + qrow) * 128 + hi * 8;
#pragma unroll
    for (int d0 = 0; d0 < 8; ++d0) qr[d0] = *reinterpret_cast<const bf16x8*>(Qw + d0 * 16); }
#pragma unroll
  for (int d0 = 0; d0 < 8; ++d0) asm volatile("" :: "v"(qr[d0]));
  asm volatile("s_waitcnt vmcnt(0)" ::: "memory");
  const int vrd = (int)(unsigned)(__SIZE_TYPE__)lds + P_VOFF + v_rd_base(lane);
#define APPLY4(PP, j) do { int qc_ = qc, Rq_ = Rq; asm volatile("" : "+v"(qc_), "+v"(Rq_)); \
    const int kr_ = rs0 + (j) - 1; int rsR_ = Rq_ - 4; rsR_ = rsR_ < 0 ? 0 : (rsR_ > rows - 8 ? rows - 8 : rsR_); int cs_ = qc_ - 8; cs_ = cs_ < 0 ? 0 : (cs_ > 48 ? 48 : cs_); \
    const bool rv_ = (kr_ < rows) && (kr_ >= rsR_) && (kr_ < rsR_ + 8); \
    int ir_ = kr_ - Rq_ + 7; ir_ = ir_ < 0 ? 0 : (ir_ > 14 ? 14 : ir_); \
    const ALDS float* tA_ = tab + ir_ * 128 + (63 - qc_ + 16 * kbA + 4 * hi); const ALDS float* tB_ = tA_ + 16 * (kbB - kbA); \
    const int uA_ = rv_ ? 16 * kbA + 4 * hi - cs_ : 4096, uB_ = rv_ ? 16 * kbB + 4 * hi - cs_ : 4096; \
    _Pragma("unroll") for (int r = 0; r < 8; ++r) { const int of_ = (r & 3) + 8 * (r >> 2); PP[r] = ((unsigned)(of_ + uA_) < 16u) ? PP[r] + tA_[of_] : NEG; } \
    _Pragma("unroll") for (int r = 8; r < 16; ++r) { const int of_ = (r & 3) + 8 * ((r >> 2) - 2); PP[r] = ((unsigned)(of_ + uB_) < 16u) ? PP[r] + tB_[of_] : NEG; } } while (0)
  f32x16 pA, pB; float alA, alB; bf16x8 pa0, pa1;
  int k3 = 0;
  STEP_ENTER(tile_row<0>, 0);
  qkt1(pA, lds + P_KOFF, qr, r32 * 256, r32, hi);
#pragma unroll
  for (int r = 8; r < 16; ++r) pA[r] = NEG;
  partialSM1(pA, m_reg, alA);
  STEP_LEAVE();
#pragma unroll 1
  for (int j = 1; j + 1 < NT; j += 2) {
    STEP_ENTER(tile_row<0>, j);
    { const int vb = vrd + ((j - 1) & 3) * 16384;
      SBAR(); qkt1(pB, lds + P_KOFF + k3 * 16384, qr, koffT, r32, hi);
      finishSM1(pA, alA, l_reg, pa0, pa1); SBAR();
      if (j == 1) pv2(o, vb, vb + 4096, pa0, pa1); else pv2(o, vb + kbA * 4096, vb + kbB * 4096, pa0, pa1);
      APPLY4(pB, j); partialSM1(pB, m_reg, alB);
      RESC4(alB); }
    STEP_LEAVE();
    STEP_ENTER(tile_row<0>, j + 1);
    { const int vb = vrd + (j & 3) * 16384;
      SBAR(); qkt1(pA, lds + P_KOFF + k3 * 16384, qr, koffT, r32, hi);
      finishSM1(pB, alB, l_reg, pa0, pa1); SBAR();
      pv2(o, vb + kbA * 4096, vb + kbB * 4096, pa0, pa1);
      APPLY4(pA, j + 1); partialSM1(pA, m_reg, alA);
      RESC4(alA); }
    STEP_LEAVE();
  }
  STEP_ENTER(tile_row<0>, NT - 1);
  { const int vb = vrd + ((NT - 2) & 3) * 16384, vbl = vrd + ((NT - 1) & 3) * 16384;
    SBAR(); qkt1(pB, lds + P_KOFF + k3 * 16384, qr, koffT, r32, hi);
    finishSM1(pA, alA, l_reg, pa0, pa1); SBAR();
    pv2(o, vb + kbA * 4096, vb + kbB * 4096, pa0, pa1);
    APPLY4(pB, NT - 1); partialSM1(pB, m_reg, alB);
    RESC4(alB);
    finishSM1(pB, alB, l_reg, pa0, pa1); SBAR();
    pv2(o, vbl + kbA * 4096, vbl + kbB * 4096, pa0, pa1); }
#undef APPLY4
  asm volatile("s_waitcnt lgkmcnt(0)" ::: "memory"); __builtin_amdgcn_s_barrier(); asm volatile("" ::: "memory");
  ATT_EPILOGUE(u.seqbase + 64 * (R0 + (q >> 4)) + (cg == 0 ? ((q & 15) < 8 ? (q & 15) : 48 + (q & 15)) : 16 * cg - 8 + (q & 15)), 0);
  asm volatile("s_waitcnt lgkmcnt(0)" ::: "memory"); __builtin_amdgcn_s_barrier(); asm volatile("" ::: "memory");
}
__device__ __forceinline__ void attn_unit_sw4(const UnitP u, const bf16* __restrict__ P, bf16* __restrict__ O, float* __restrict__ ssq,
                                              const float* __restrict__ sinkp, ALDS char* lds, const int wave_id, const bool do_ssq = true) {
  constexpr int NT = 6;
  unsigned zero_ = 0u; asm volatile("" : "+s"(zero_));
  int tid = wave_id * 64 + (int)__builtin_amdgcn_mbcnt_hi(~0u, __builtin_amdgcn_mbcnt_lo(~0u, zero_)); asm volatile("" : "+v"(tid));
  const int wid = __builtin_amdgcn_readfirstlane(tid >> 6), lane = tid & 63, r32 = lane & 31, hi = lane >> 5;
  ALDS float* wsf = (ALDS float*)(lds + P_OFF_WS) + wid * 64; ALDS float* li_l = wsf; ALDS float* al_l = wsf + 32;
  ALDS float* tab = (ALDS float*)(lds + P_OFF_TAB);
  const int hq = 4 * u.head + (wid >> 1), tq = 64 * u.blk + 32 * (wid & 1) + r32;
  const int orow0 = u.seqbase + 64 * u.blk + 32 * (wid & 1), qrow = orow0 + r32;
  const int kcol = 8192 + 128 * u.head, vcol = 8704 + 128 * u.head, ocol = 2048 + 128 * hq;
  const float slope2 = __builtin_amdgcn_exp2f(-0.5f * (float)(hq + 1)) * LOG2E, sink2 = sinkp[hq] * LOG2E;
  const DmaSrc src = dma_src(P, kcol, vcol, wid, lane);
  dma_tile_kv(src, (size_t)tile_row<1>(u, 0) * 128, lds + P_VOFF, lds + P_KOFF, wid); dma_tile_kv(src, (size_t)tile_row<1>(u, 1) * 128, lds + P_VOFF + 16384, lds + P_KOFF + 16384, wid);
  for (int idx = tid; idx < 4 * 384; idx += 512) { const int hh = idx / 384, i = idx - hh * 384; int d = 191 - i; d = d < 0 ? -d : d;
    tab[idx] = (d <= 128) ? -(__builtin_amdgcn_exp2f(-0.5f * (float)(4 * u.head + hh + 1)) * LOG2E) * (float)d : NEG; }
  float m_reg = -1e30f, l_reg = 0; f32x16 o[4] = {}; bf16x8 qr[8];
  { const bf16* Qw = P + ((size_t)(48 + hq) * PROWS + qrow) * 128 + hi * 8;
#pragma unroll
    for (int d0 = 0; d0 < 8; ++d0) qr[d0] = *reinterpret_cast<const bf16x8*>(Qw + d0 * 16); }
#pragma unroll
  for (int d0 = 0; d0 < 8; ++d0) asm volatile("" :: "v"(qr[d0]));
  asm volatile("s_waitcnt vmcnt(0)" ::: "memory");
  const int vrd = (int)(unsigned)(__SIZE_TYPE__)lds + P_VOFF + v_rd_base(lane);
#define APPLYS(P0, P1, j) do { const int ks_ = 64 * u.blk + 64 * ((j) - 3); \
    if (ks_ >= 0 && ks_ < u.T) { int tq_ = tq; asm volatile("" : "+v"(tq_)); const ALDS float* tb_ = tab + (wid >> 1) * 384 + (191 - (tq_ - ks_ - 4 * hi)); \
      _Pragma("unroll") for (int r = 0; r < 16; ++r) { const int kc0_ = (r & 3) + 8 * (r >> 2); P0[r] = P0[r] + tb_[kc0_]; P1[r] = P1[r] + tb_[kc0_ + 32]; } } \
    else { _Pragma("unroll") for (int r = 0; r < 16; ++r) { P0[r] = NEG; P1[r] = NEG; } } } while (0)
  f32x16 pA0, pA1, pB0, pB1; float alA, alB; bf16x8 pa0, pa1, pa2, pa3;
  int k3 = 0;
  const bool lead = wid < 4;
#define SW_STEP_A(N0, N1, alN, O0, O1, alO, vb, jj) do { SBAR(); qkt(N0, N1, lds + P_KOFF + k3 * 16384, qr, r32, hi); \
      finishSM(O0, O1, alO, l_reg, pa0, pa1, pa2, pa3); SBAR(); \
      pv_d0(o, vb, pa0, pa1, pa2, pa3); \
      APPLYS(N0, N1, jj); partialSM(N0, N1, m_reg, alN); \
      RESC4(alN); } while (0)
#define SW_STEP_B(N0, N1, alN, O0, O1, alO, vb, jj) do { SBAR(); finishSM(O0, O1, alO, l_reg, pa0, pa1, pa2, pa3); SBAR(); \
      qkt(N0, N1, lds + P_KOFF + k3 * 16384, qr, r32, hi); SBAR(); \
      APPLYS(N0, N1, jj); partialSM(N0, N1, m_reg, alN); SBAR(); \
      pv_d0(o, vb, pa0, pa1, pa2, pa3); \
      RESC4(alN); } while (0)
  STEP_ENTER(tile_row<1>, 0);
  qkt(pA0, pA1, lds + P_KOFF, qr, r32, hi);
#pragma unroll
  for (int r = 0; r < 8; ++r) { const int md_ = 16 + tq - crow(r, hi); pA0[r] = pA0[r] - slope2 * (float)(md_ > 128 ? 128 : md_); }
#pragma unroll
  for (int r = 8; r < 16; ++r) pA0[r] = NEG;
#pragma unroll
  for (int r = 0; r < 16; ++r) pA1[r] = NEG;
  partialSM(pA0, pA1, m_reg, alA);
  STEP_LEAVE();
  if (lead) {
#pragma unroll 1
    for (int j = 1; j + 1 < NT; j += 2) {
      STEP_ENTER(tile_row<1>, j);
      { const int vb = vrd + ((j - 1) & 3) * 16384; SW_STEP_A(pB0, pB1, alB, pA0, pA1, alA, vb, j); }
      STEP_LEAVE();
      STEP_ENTER(tile_row<1>, j + 1);
      { const int vb = vrd + (j & 3) * 16384; SW_STEP_A(pA0, pA1, alA, pB0, pB1, alB, vb, j + 1); }
      STEP_LEAVE();
    }
    STEP_ENTER(tile_row<1>, NT - 1);
    { const int vb = vrd + ((NT - 2) & 3) * 16384, vbl = vrd + ((NT - 1) & 3) * 16384;
      SW_STEP_A(pB0, pB1, alB, pA0, pA1, alA, vb, NT - 1);
      finishSM(pB0, pB1, alB, l_reg, pa0, pa1, pa2, pa3); SBAR();
      pv_d0(o, vbl, pa0, pa1, pa2, pa3); }
  } else {
#pragma unroll 1
    for (int j = 1; j + 1 < NT; j += 2) {
      STEP_ENTER(tile_row<1>, j);
      { const int vb = vrd + ((j - 1) & 3) * 16384; SW_STEP_B(pB0, pB1, alB, pA0, pA1, alA, vb, j); }
      STEP_LEAVE();
      STEP_ENTER(tile_row<1>, j + 1);
      { const int vb = vrd + (j & 3) * 16384; SW_STEP_B(pA0, pA1, alA, pB0, pB1, alB, vb, j + 1); }
      STEP_LEAVE();
    }
    STEP_ENTER(tile_row<1>, NT - 1);
    { const int vb = vrd + ((NT - 2) & 3) * 16384, vbl = vrd + ((NT - 1) & 3) * 16384;
      SW_STEP_B(pB0, pB1, alB, pA0, pA1, alA, vb, NT - 1);
      finishSM(pB0, pB1, alB, l_reg, pa0, pa1, pa2, pa3); SBAR();
      pv_d0(o, vbl, pa0, pa1, pa2, pa3); }
  }
#undef APPLYS
#undef SW_STEP_A
#undef SW_STEP_B
  l_reg += __builtin_amdgcn_exp2f(sink2 - m_reg);
  asm volatile("s_waitcnt lgkmcnt(0)" ::: "memory"); __builtin_amdgcn_s_barrier(); asm volatile("" ::: "memory");
  ATT_EPILOGUE(orow0 + q, 1);
  asm volatile("s_waitcnt lgkmcnt(0)" ::: "memory"); __builtin_amdgcn_s_barrier(); asm volatile("" ::: "memory");
}
#undef RESC4
#undef STEP_ENTER
#undef STEP_LEAVE
#undef PK4
#undef DMA_WAIT_BAR
#undef ATT_EPILOGUE
#undef KSWZ
#undef SBAR
}

#define GAS __attribute__((address_space(1)))
#define LAS __attribute__((address_space(3)))
typedef unsigned short bf16;
typedef unsigned v4u __attribute__((ext_vector_type(4)));
typedef float f32x4 __attribute__((ext_vector_type(4)));
typedef short bf16x8 __attribute__((ext_vector_type(8)));
typedef GAS unsigned gu32;
typedef GAS unsigned long long gu64;
#define RLX_AGENT __ATOMIC_RELAXED, __HIP_MEMORY_SCOPE_AGENT
#define LDS_WAIT() asm volatile("s_waitcnt lgkmcnt(0)" ::: "memory")
#define VM_WAIT() asm volatile("s_waitcnt vmcnt(0)" ::: "memory")
__device__ __forceinline__ unsigned long long rt() { return __builtin_amdgcn_s_memrealtime(); }
__device__ __forceinline__ unsigned f2bf(float f) { unsigned u = __builtin_bit_cast(unsigned, f); return (u + 0x7fffu + ((u >> 16) & 1u)) >> 16; }
__device__ __forceinline__ unsigned pk2(float lo, float hi) { return f2bf(lo) | (f2bf(hi) << 16); }

#define XB_TMO      128
#define XB_XCNT(j)  (256  + 64 * (j))
#define XB_XSUB(j)  (1280 + 64 * (j))
#define XB_XGEN(j)  (2304 + 64 * (j))
#define XB_TOP      3328
#define XB_TOPGEN   3392
#define XCD_BAR_WORDS 3456
#define XB_SPIN_CAP (1u << 18)

__device__ __forceinline__ unsigned xb_ld(unsigned* p)              { return __hip_atomic_load(p, __ATOMIC_RELAXED, __HIP_MEMORY_SCOPE_AGENT); }
__device__ __forceinline__ unsigned xb_add(unsigned* p, unsigned v) { return __hip_atomic_fetch_add(p, v, __ATOMIC_RELAXED, __HIP_MEMORY_SCOPE_AGENT); }
__device__ __forceinline__ unsigned xb_xcc_id() { return (unsigned)__builtin_amdgcn_s_getreg((3 << 11) | 20) & 0xFu; }
#define XB_SPIN(cond, bar) do { unsigned _sp = 0; while (cond) { __builtin_amdgcn_s_sleep(1); \
    if ((++_sp & 255u) == 0u) { if (xb_ld(&(bar)[XB_TMO])) break; if (_sp > XB_SPIN_CAP) { atomicAdd(&(bar)[XB_TMO], 1u); break; } } } } while (0)

struct XcdBarrier {
    unsigned* bar; unsigned x; bool t0;
    volatile LAS unsigned* st;
};

__device__ __forceinline__ XcdBarrier xcd_barrier_post(unsigned* bar, volatile LAS unsigned* st, bool t0) {
    XcdBarrier b; b.bar = bar; b.x = xb_xcc_id(); b.st = st; b.t0 = t0;
    if (t0) (void)xb_add(&bar[XB_XCNT(b.x)], 1u);
    return b;
}
__device__ __forceinline__ void xcd_barrier_complete(unsigned* bar, unsigned x, unsigned& nloc, unsigned& nx) {
    const unsigned G = gridDim.x * gridDim.y * gridDim.z;
    unsigned sum, cnt, mine, sp = 0u;
    for (;;) {
        sum = 0u; cnt = 0u; mine = 0u;
#pragma unroll
        for (unsigned j = 0; j < 16; ++j) { const unsigned c = xb_ld(&bar[XB_XCNT(j)]); sum += c; cnt += (c > 0u) ? 1u : 0u; mine = (j == x) ? c : mine; }
        if (sum == G) break;
        __builtin_amdgcn_s_sleep(1);
        if ((++sp & 255u) == 0u) { if (xb_ld(&bar[XB_TMO])) break; if (sp > XB_SPIN_CAP) { atomicAdd(&bar[XB_TMO], 1u); break; } }
    }
    nloc = mine > 0u ? mine : 1u; nx = cnt > 0u ? cnt : 1u;
}

__device__ __forceinline__ void xcd_barrier(const XcdBarrier& b) {
    asm volatile("s_waitcnt vmcnt(0)" ::: "memory");
    __syncthreads();
    if (b.t0) {
        unsigned* bar = b.bar;
        __builtin_amdgcn_s_waitcnt(0);
        unsigned nloc = b.st[0], nx = b.st[1];
        if (nloc == 0u) { xcd_barrier_complete(bar, b.x, nloc, nx); b.st[0] = nloc; b.st[1] = nx; }
        const unsigned old = xb_add(&bar[XB_XSUB(b.x)], 1u);
        const unsigned gen = old / nloc;
        if (old + 1u == (gen + 1u) * nloc) {
            __builtin_amdgcn_fence(__ATOMIC_RELEASE, "agent");
            asm volatile("s_waitcnt vmcnt(0)" ::: "memory");
            const unsigned og = xb_add(&bar[XB_TOP], 1u);
            const unsigned tg = og / nx;
            if (og + 1u == (tg + 1u) * nx) xb_add(&bar[XB_TOPGEN], 1u);
            else XB_SPIN(xb_ld(&bar[XB_TOPGEN]) == tg, bar);
            __builtin_amdgcn_fence(__ATOMIC_ACQUIRE, "agent");
            xb_add(&bar[XB_XGEN(b.x)], 1u);
            asm volatile("s_waitcnt vmcnt(0)" ::: "memory");
        } else {
            XB_SPIN(xb_ld(&bar[XB_XGEN(b.x)]) == gen, bar);
            __builtin_amdgcn_fence(__ATOMIC_ACQUIRE, "agent");
            asm volatile("s_waitcnt vmcnt(0)" ::: "memory");
        }
    }
    __syncthreads();
}
#ifndef P4_INT8
#define P4_INT8 1
#endif
#ifndef WGM_P7
#define WGM_P7 2
#endif
#ifndef WGM_P1
#define WGM_P1 4
#endif
#ifndef WGM_P4
#define WGM_P4 4
#endif
#ifndef REP_P2
#define REP_P2 1
#endif
#ifndef REP_P6
#define REP_P6 1
#endif
#ifndef REP_P0
#define REP_P0 1
#endif
#ifndef REP_NA
#define REP_NA 1
#endif
#ifndef REP_SW
#define REP_SW 1
#endif
constexpr int NWAVES = 8;
constexpr int DM = 4096, TP = 16384, TS = 4096, MREAL = 24576, NMETA = 16, MPAD = 24832;
constexpr int DIN = 9216, DFF = 11008, NGU = 2 * DFF;
constexpr float EPS = 1e-6f;
constexpr float QSCALE = 0.08838834764831845f * 1.4426950408889634f;

constexpr size_t MiB = 1u << 20;
constexpr size_t WS_CTL = 0, CTL_ZERO_BYTES = 1 * MiB;
constexpr size_t WS_ACC2 = 256 * 1024;
constexpr size_t WS_WIN = 4 * MiB;
constexpr size_t WS_WOUT = WS_WIN + (size_t)DIN * DM * 2;
constexpr size_t WS_WGU = WS_WOUT + (size_t)DM * DM * 2;
constexpr size_t WS_WDN = WS_WGU + (size_t)NGU * DM * 2;
constexpr size_t WS_A = WS_WDN + (size_t)DM * DFF * 2;
constexpr size_t WS_B = WS_A + (size_t)MPAD * DM * 2;
constexpr size_t WS_END = WS_B + (size_t)MREAL * DFF * 2;
static_assert((size_t)MPAD * DIN * 2 <= (size_t)MREAL * DFF * 2, "proj fits the act region");
constexpr size_t WS_RSX = 768 * 1024;
constexpr size_t WS_ACTMAX = 896 * 1024;
constexpr size_t WS_CMAXD = 480 * 1024;
constexpr size_t WS_ACT8 = WS_WIN;
constexpr size_t WS_CMAXO = 736 * 1024;
constexpr size_t WS_ONSC = 1 * MiB;
constexpr size_t WS_ON8 = WS_B + 256 * MiB;
constexpr size_t WS_SCALEA = 512 * 1024;
constexpr size_t WS_COLMAX = 640 * 1024;
constexpr int CW_BAR = 4096;
static_assert(WS_ACC2 + (size_t)MREAL * 2 * 4 <= WS_SCALEA && WS_SCALEA + (size_t)MREAL * 4 <= WS_COLMAX && WS_COLMAX + (size_t)NGU * 4 <= WS_CMAXO && WS_CMAXO + (size_t)DM * 4 <= WS_RSX && WS_ACC2 + (size_t)MREAL * 8 <= WS_CMAXD && WS_CMAXD + (size_t)DM * 4 <= WS_SCALEA && WS_ACT8 + (size_t)MREAL * DFF <= WS_WDN && WS_RSX + (size_t)MREAL * 4 <= WS_ACTMAX && WS_ACTMAX + (size_t)MREAL * 4 <= CTL_ZERO_BYTES && WS_ONSC + (size_t)MREAL * 8 <= WS_WIN && (size_t)MREAL * DM * 2 <= 256 * MiB && 256 * MiB + (size_t)MREAL * DM <= (size_t)MREAL * DFF * 2 && WS_RSX + (size_t)MREAL * 4 <= CTL_ZERO_BYTES && (size_t)MREAL * DM <= (size_t)(DIN + DM) * DM * 2 && (CW_BAR + XCD_BAR_WORDS) * 4 <= (int)WS_ACC2, "control region map");

constexpr int RING_OFF = 0, RING_BYTES = 131072;
constexpr int LDSCTL_OFF = RING_BYTES, MISC_OFF = LDSCTL_OFF + 320;
constexpr int OG_OFF = 94208;
constexpr int SLAB_RED_OFF = 90112;
#ifndef SLAB0
#define SLAB0 412
#endif
constexpr int P0_SCR = 8448, GAIN_OFF = 69632;
constexpr int LDS_BYTES = 147456;
static_assert(MISC_OFF + 128 <= LDS_BYTES && NWAVES * P0_SCR <= GAIN_OFF && GAIN_OFF + 16384 <= RING_BYTES && att::P_ATT_LDS <= RING_BYTES && att::PROWS == MPAD, "LDS map");

__device__ __forceinline__ unsigned pkbf(float lo, float hi) { return pg8::cvt_pk_bf16(lo, hi); }
__device__ __forceinline__ int lane_id() { unsigned z = 0u; asm volatile("" : "+s"(z)); return (int)__builtin_amdgcn_mbcnt_hi(~0u, __builtin_amdgcn_mbcnt_lo(~0u, z)); }
struct Frame {
    LAS unsigned char* lds;
    volatile LAS unsigned* MISC;
    int wave;
    int vcu, G;
};
template <int PAT> __device__ __forceinline__ float swz_xor(float v) { return __builtin_bit_cast(float, __builtin_amdgcn_ds_swizzle(__builtin_bit_cast(int, v), PAT)); }
__device__ __forceinline__ float wave_sum(float v) {
    v += swz_xor<(1 << 10) | 0x1f>(v); v += swz_xor<(2 << 10) | 0x1f>(v); v += swz_xor<(4 << 10) | 0x1f>(v); v += swz_xor<(8 << 10) | 0x1f>(v); v += swz_xor<(16 << 10) | 0x1f>(v);
    const auto rr = __builtin_amdgcn_permlane32_swap(__float_as_uint(v), __float_as_uint(v), false, false);
    return __uint_as_float(rr[0]) + __uint_as_float(rr[1]);
}
__device__ __forceinline__ float wave_max(float v) {
    v = fmaxf(v, swz_xor<(1 << 10) | 0x1f>(v)); v = fmaxf(v, swz_xor<(2 << 10) | 0x1f>(v)); v = fmaxf(v, swz_xor<(4 << 10) | 0x1f>(v)); v = fmaxf(v, swz_xor<(8 << 10) | 0x1f>(v)); v = fmaxf(v, swz_xor<(16 << 10) | 0x1f>(v));
    const auto rr = __builtin_amdgcn_permlane32_swap(__float_as_uint(v), __float_as_uint(v), false, false);
    return fmaxf(__uint_as_float(rr[0]), __uint_as_float(rr[1]));
}
struct WItem { const float* W; bf16* WT; const float* kscale; float* cmax; int K, N, k0, n0, dst_row0, mode; float scale; int had; };
__device__ __forceinline__ void witem_load(f32x4 (&v)[8], const WItem& it, int lane) {
    const float* p = it.W + (size_t)(it.k0 + (lane >> 3)) * it.N + it.n0 + 4 * (lane & 7);
#pragma unroll
    for (int i = 0; i < 8; ++i) v[i] = __builtin_nontemporal_load((const GAS f32x4*)(p + (size_t)(8 * i) * it.N));
}
__device__ __forceinline__ void witem_store(const f32x4 (&v)[8], const WItem& it, LAS float* scr, int lane) {
#pragma unroll
    for (int i = 0; i < 8; ++i) { LAS float* d = scr + (8 * i + (lane >> 3)) * 33 + 4 * (lane & 7); d[0] = v[i].x; d[1] = v[i].y; d[2] = v[i].z; d[3] = v[i].w; }
    LDS_WAIT(); asm volatile("" ::: "memory");
    const int c = lane & 7;
    f32x4 ka = (f32x4){it.scale, it.scale, it.scale, it.scale}, kb = ka;
    if (it.kscale) { ka = *(const GAS f32x4*)(it.kscale + it.k0 + 8 * c) * it.scale; kb = *(const GAS f32x4*)(it.kscale + it.k0 + 8 * c + 4) * it.scale; }
#pragma unroll
    for (int j = 0; j < 4; ++j) { const int n = (lane >> 3) + 8 * j; const LAS float* s = scr + (8 * c) * 33 + n;
        float x[8] = {s[0 * 33] * ka.x, s[1 * 33] * ka.y, s[2 * 33] * ka.z, s[3 * 33] * ka.w, s[4 * 33] * kb.x, s[5 * 33] * kb.y, s[6 * 33] * kb.z, s[7 * 33] * kb.w};
        if (it.had) {
#pragma unroll
            for (int b = 1; b < 8; b <<= 1)
#pragma unroll
                for (int i = 0; i < 8; ++i) if (!(i & b)) { const float a = x[i], e = x[i | b]; x[i] = a + e; x[i | b] = a - e; }
#pragma unroll
            for (int i = 0; i < 8; ++i) { const float p = __builtin_bit_cast(float, __builtin_amdgcn_update_dpp(0, __builtin_bit_cast(int, x[i]), 0xB1, 0xF, 0xF, false)); x[i] = (lane & 1) ? p - x[i] : x[i] + p; }
#pragma unroll
            for (int i = 0; i < 8; ++i) { const float p = __builtin_bit_cast(float, __builtin_amdgcn_update_dpp(0, __builtin_bit_cast(int, x[i]), 0x4E, 0xF, 0xF, false)); x[i] = (lane & 2) ? p - x[i] : x[i] + p; } }
        if (it.mode == 1) {
            float m = fmaxf(fmaxf(fmaxf(fabsf(x[0]), fabsf(x[1])), fmaxf(fabsf(x[2]), fabsf(x[3]))), fmaxf(fmaxf(fabsf(x[4]), fabsf(x[5])), fmaxf(fabsf(x[6]), fabsf(x[7]))));
            m = fmaxf(m, __builtin_bit_cast(float, __builtin_amdgcn_update_dpp(0, __builtin_bit_cast(int, m), 0xB1, 0xF, 0xF, false)));
            m = fmaxf(m, __builtin_bit_cast(float, __builtin_amdgcn_update_dpp(0, __builtin_bit_cast(int, m), 0x4E, 0xF, 0xF, false)));
            m = fmaxf(m, swz_xor<(4 << 10) | 0x1f>(m));
            if (c == 0) atomicMax((unsigned*)it.cmax + it.dst_row0 + n, __builtin_bit_cast(unsigned, m));
        } else if (it.mode == 2) {
            const float cm = it.cmax[it.dst_row0 + n], inv = cm > 0.f ? 127.0f / cm : 0.f;
#define WQ_(v) __builtin_bit_cast(unsigned, __builtin_fmaf((v), inv, 12582912.0f))
            const unsigned lo = __builtin_amdgcn_perm(__builtin_amdgcn_perm(WQ_(x[3]), WQ_(x[2]), 0x0c0c0400u), __builtin_amdgcn_perm(WQ_(x[1]), WQ_(x[0]), 0x0c0c0400u), 0x05040100u);
            const unsigned hi = __builtin_amdgcn_perm(__builtin_amdgcn_perm(WQ_(x[7]), WQ_(x[6]), 0x0c0c0400u), __builtin_amdgcn_perm(WQ_(x[5]), WQ_(x[4]), 0x0c0c0400u), 0x05040100u);
#undef WQ_
            *(GAS unsigned long long*)((GAS unsigned char*)it.WT + (size_t)(it.dst_row0 + n) * it.K + it.k0 + 8 * c) = (unsigned long long)lo | ((unsigned long long)hi << 32);
        } else {
        v4u o; o.x = pkbf(x[0], x[1]); o.y = pkbf(x[2], x[3]); o.z = pkbf(x[4], x[5]); o.w = pkbf(x[6], x[7]);
        *(GAS v4u*)(it.WT + (size_t)(it.dst_row0 + n) * it.K + it.k0 + 8 * c) = o; } }
    LDS_WAIT(); asm volatile("" ::: "memory");
}
constexpr int NB_IN = DIN / 32, NB_DM = DM / 32, NB_FF = DFF / 32;
constexpr int I_IN = (DM / 64) * NB_IN, I_OUT = P4_INT8 ? 0   : (DM / 64) * NB_DM, I_D = (DFF / 64) * NB_DM;
constexpr int WI_N = I_IN + I_OUT + I_D, WI_A = I_IN + I_OUT;
struct WPtrs { const float *w_in, *w_out, *w_down, *g_na, *g_sw; bf16 *Win_t, *Wout_t, *Wdn_t; float* cmaxd; int dn_mode; };
__device__ __forceinline__ WItem witem_decode(const WPtrs& P, int it) {
    WItem w; int r = it; w.kscale = nullptr; w.cmax = nullptr; w.mode = 0; w.scale = 1.0f; w.had = 0;
    if (r < I_IN) { const int kb = r / NB_IN, nb = r % NB_IN, n0 = 32 * nb; const bool isq = (n0 < 2048) || (n0 >= 6144 && n0 < 8192);
        w.W = P.w_in; w.WT = P.Win_t; w.K = DM; w.N = DIN; w.k0 = 64 * kb; w.n0 = n0; w.dst_row0 = n0; w.scale = isq ? QSCALE : 1.0f; return w; } r -= I_IN;
    if (r < I_OUT) { const int kb = r / NB_DM, nb = r % NB_DM; w.W = P.w_out; w.WT = P.Wout_t; w.K = DM; w.N = DM; w.k0 = 64 * kb; w.n0 = 32 * nb; w.dst_row0 = 32 * nb;
        w.kscale = (64 * kb < 2048) ? P.g_na : P.g_sw - 2048; return w; } r -= I_OUT;
    { const int kb = r / NB_DM, nb = r % NB_DM; w.W = P.w_down; w.WT = P.Wdn_t; w.K = DFF; w.N = DM; w.k0 = 64 * kb; w.n0 = 32 * nb; w.dst_row0 = 32 * nb; w.had = 1; w.scale = 1.0f / 32.0f; w.mode = P.dn_mode; w.cmax = P.cmaxd; return w; }
}
constexpr int NSLAB = 2 * NB_FF;
template <bool KSC> __device__ __forceinline__ void w8_slab(const float* W, int ldn, const float* ksc, unsigned char* WT8, float* cmax, int n0, int dst_row0, LAS float* red  , int wave, int lane) {
    const int r8 = lane >> 3, c8 = lane & 7;
    const float* p = W + (size_t)(512 * wave + 64 * r8) * ldn + n0 + 4 * c8;
    unsigned st[128]; f32x4 mx = (f32x4){0.f, 0.f, 0.f, 0.f};
#pragma unroll
    for (int b = 0; b < 4; ++b) { f32x4 v[16];
#pragma unroll
        for (int i = 0; i < 16; ++i) v[i] = __builtin_nontemporal_load((const GAS f32x4*)(p + (size_t)(16 * b + i) * ldn));
        if constexpr (KSC) { const GAS f32x4* gp = (const GAS f32x4*)(ksc + 512 * wave + 64 * r8 + 16 * b);
#pragma unroll
            for (int i4 = 0; i4 < 4; ++i4) { const f32x4 g = gp[i4]; v[4 * i4] *= g.x; v[4 * i4 + 1] *= g.y; v[4 * i4 + 2] *= g.z; v[4 * i4 + 3] *= g.w; } }
#pragma unroll
        for (int i = 0; i < 16; ++i) { mx.x = fmaxf(mx.x, fabsf(v[i].x)); mx.y = fmaxf(mx.y, fabsf(v[i].y)); mx.z = fmaxf(mx.z, fabsf(v[i].z)); mx.w = fmaxf(mx.w, fabsf(v[i].w));
            st[2 * (16 * b + i)] = pkbf(v[i].x, v[i].y); st[2 * (16 * b + i) + 1] = pkbf(v[i].z, v[i].w); } }
#define SLAB_RED(PAT) do { mx.x = fmaxf(mx.x, swz_xor<PAT>(mx.x)); mx.y = fmaxf(mx.y, swz_xor<PAT>(mx.y)); mx.z = fmaxf(mx.z, swz_xor<PAT>(mx.z)); mx.w = fmaxf(mx.w, swz_xor<PAT>(mx.w)); } while (0)
    SLAB_RED((8 << 10) | 0x1f); SLAB_RED((16 << 10) | 0x1f);
#undef SLAB_RED
    { const auto r0 = __builtin_amdgcn_permlane32_swap(__float_as_uint(mx.x), __float_as_uint(mx.x), false, false); mx.x = fmaxf(__uint_as_float(r0[0]), __uint_as_float(r0[1]));
      const auto r1 = __builtin_amdgcn_permlane32_swap(__float_as_uint(mx.y), __float_as_uint(mx.y), false, false); mx.y = fmaxf(__uint_as_float(r1[0]), __uint_as_float(r1[1]));
      const auto r2 = __builtin_amdgcn_permlane32_swap(__float_as_uint(mx.z), __float_as_uint(mx.z), false, false); mx.z = fmaxf(__uint_as_float(r2[0]), __uint_as_float(r2[1]));
      const auto r3 = __builtin_amdgcn_permlane32_swap(__float_as_uint(mx.w), __float_as_uint(mx.w), false, false); mx.w = fmaxf(__uint_as_float(r3[0]), __uint_as_float(r3[1])); }
    if (r8 == 0) *(LAS f32x4*)(red + 32 * wave + 4 * c8) = mx;
    __syncthreads();
    f32x4 cm = *(const LAS f32x4*)(red + 4 * c8);
#pragma unroll
    for (int w = 1; w < 8; ++w) { const f32x4 o = *(const LAS f32x4*)(red + 32 * w + 4 * c8); cm.x = fmaxf(cm.x, o.x); cm.y = fmaxf(cm.y, o.y); cm.z = fmaxf(cm.z, o.z); cm.w = fmaxf(cm.w, o.w); }
    cm *= 1.00390625f;
    if (wave == 0 && r8 == 0) *(GAS f32x4*)(cmax + dst_row0 + 4 * c8) = cm;
    const float i0 = cm.x > 0.f ? 127.0f / cm.x : 0.f, i1 = cm.y > 0.f ? 127.0f / cm.y : 0.f, i2 = cm.z > 0.f ? 127.0f / cm.z : 0.f, i3 = cm.w > 0.f ? 127.0f / cm.w : 0.f;
    GAS unsigned char* dst = (GAS unsigned char*)WT8 + (size_t)(dst_row0 + 4 * c8) * DM + 512 * wave + 64 * r8;
#define SLAB_Q(word, hi, inv) __builtin_bit_cast(unsigned, __builtin_fmaf(__builtin_bit_cast(float, (hi) ? ((word) & 0xffff0000u) : ((word) << 16)), (inv), 12582912.0f))
#define SLAB_PK(a, b, c, d) __builtin_amdgcn_perm(__builtin_amdgcn_perm((d), (c), 0x0c0c0400u), __builtin_amdgcn_perm((b), (a), 0x0c0c0400u), 0x05040100u)
#pragma unroll
    for (int j = 0; j < 4; ++j) { const float inv = j == 0 ? i0 : (j == 1 ? i1 : (j == 2 ? i2 : i3));
#pragma unroll
        for (int q = 0; q < 4; ++q) { v4u o;
#pragma unroll
            for (int d = 0; d < 4; ++d) { const int i = 16 * q + 4 * d;
                const unsigned a = SLAB_Q(st[2 * (i + 0) + (j >> 1)], j & 1, inv), b = SLAB_Q(st[2 * (i + 1) + (j >> 1)], j & 1, inv), c = SLAB_Q(st[2 * (i + 2) + (j >> 1)], j & 1, inv), e = SLAB_Q(st[2 * (i + 3) + (j >> 1)], j & 1, inv);
                const unsigned w = SLAB_PK(a, b, c, e);
                if (d == 0) o.x = w; else if (d == 1) o.y = w; else if (d == 2) o.z = w; else o.w = w; }
            *(GAS v4u*)(dst + (size_t)j * DM + 16 * q) = o; } }
#undef SLAB_Q
#undef SLAB_PK
    __syncthreads();
}
__device__ __forceinline__ void wgu_slab(const float* w_gate, const float* w_up, unsigned char* WT8, float* cmax, int s, LAS float* red, int wave, int lane) {
    const int mat = s >= NB_FF ? 1 : 0, n0 = 32 * (s - mat * NB_FF), dst_row0 = (n0 >> 7) * 256 + mat * 128 + (n0 & 127);
    w8_slab<false>(mat ? w_up : w_gate, DFF, nullptr, WT8, cmax, n0, dst_row0, red, wave, lane);
}
constexpr int NSLAB_O = DM / 32;
__device__ __forceinline__ void wout_slab(const float* w_out, const LAS float* og  , unsigned char* WT8, float* cmax, int s, LAS float* red, int wave, int lane) {
    const int r8 = lane >> 3, c8 = lane & 7, n0 = 32 * s, kb = 2048 * (wave >> 2) + 32 * (wave & 3) + 4 * r8;
    const unsigned voff = ((unsigned)kb * DM + n0 + 4 * c8) * 4u;
    const LAS float* gl = og + kb;
    unsigned st[128]; f32x4 mx = (f32x4){0.f, 0.f, 0.f, 0.f};
#pragma unroll
    for (int b = 0; b < 4; ++b) { f32x4 v[16];
#pragma unroll
        for (int i = 0; i < 16; ++i) v[i] = __builtin_nontemporal_load((const GAS f32x4*)((const GAS char*)w_out + (size_t)(128 * i + b) * DM * 4 + voff));
#pragma unroll
        for (int i = 0; i < 16; ++i) { const float g = gl[128 * i + b] * (1.0f / 8.0f); v[i] *= g; }
        asm volatile("" ::: "memory");
#pragma unroll
        for (int s2 = 2; s2 < 16; s2 <<= 1)
#pragma unroll
            for (int i = 0; i < 16; ++i) if (!(i & s2)) { const f32x4 a = v[i], c = v[i | s2]; v[i] = a + c; v[i | s2] = a - c; }
#pragma unroll
        for (int i = 0; i < 16; ++i) { mx.x = fmaxf(mx.x, fabsf(v[i].x)); mx.y = fmaxf(mx.y, fabsf(v[i].y)); mx.z = fmaxf(mx.z, fabsf(v[i].z)); mx.w = fmaxf(mx.w, fabsf(v[i].w));
            st[2 * (16 * b + i)] = pkbf(v[i].x, v[i].y); st[2 * (16 * b + i) + 1] = pkbf(v[i].z, v[i].w); } }
#define SLAB_RED(PAT) do { mx.x = fmaxf(mx.x, swz_xor<PAT>(mx.x)); mx.y = fmaxf(mx.y, swz_xor<PAT>(mx.y)); mx.z = fmaxf(mx.z, swz_xor<PAT>(mx.z)); mx.w = fmaxf(mx.w, swz_xor<PAT>(mx.w)); } while (0)
    SLAB_RED((8 << 10) | 0x1f); SLAB_RED((16 << 10) | 0x1f);
#undef SLAB_RED
    { const auto r0 = __builtin_amdgcn_permlane32_swap(__float_as_uint(mx.x), __float_as_uint(mx.x), false, false); mx.x = fmaxf(__uint_as_float(r0[0]), __uint_as_float(r0[1]));
      const auto r1 = __builtin_amdgcn_permlane32_swap(__float_as_uint(mx.y), __float_as_uint(mx.y), false, false); mx.y = fmaxf(__uint_as_float(r1[0]), __uint_as_float(r1[1]));
      const auto r2 = __builtin_amdgcn_permlane32_swap(__float_as_uint(mx.z), __float_as_uint(mx.z), false, false); mx.z = fmaxf(__uint_as_float(r2[0]), __uint_as_float(r2[1]));
      const auto r3 = __builtin_amdgcn_permlane32_swap(__float_as_uint(mx.w), __float_as_uint(mx.w), false, false); mx.w = fmaxf(__uint_as_float(r3[0]), __uint_as_float(r3[1])); }
    if (r8 == 0) *(LAS f32x4*)(red + 32 * wave + 4 * c8) = mx;
    __syncthreads();
    f32x4 cm = *(const LAS f32x4*)(red + 4 * c8);
#pragma unroll
    for (int w = 1; w < 8; ++w) { const f32x4 o = *(const LAS f32x4*)(red + 32 * w + 4 * c8); cm.x = fmaxf(cm.x, o.x); cm.y = fmaxf(cm.y, o.y); cm.z = fmaxf(cm.z, o.z); cm.w = fmaxf(cm.w, o.w); }
    cm *= 1.00390625f;
    if (wave == 0 && r8 == 0) *(GAS f32x4*)(cmax + n0 + 4 * c8) = cm;
    const float i0 = cm.x > 0.f ? 127.0f / cm.x : 0.f, i1 = cm.y > 0.f ? 127.0f / cm.y : 0.f, i2 = cm.z > 0.f ? 127.0f / cm.z : 0.f, i3 = cm.w > 0.f ? 127.0f / cm.w : 0.f;
    GAS unsigned char* dst = (GAS unsigned char*)WT8 + (size_t)(n0 + 4 * c8) * DM + kb;
#define SLAB_Q(word, hi, inv) __builtin_bit_cast(unsigned, __builtin_fmaf(__builtin_bit_cast(float, (hi) ? ((word) & 0xffff0000u) : ((word) << 16)), (inv), 12582912.0f))
#define SLAB_PK(a, b, c, d) __builtin_amdgcn_perm(__builtin_amdgcn_perm((d), (c), 0x0c0c0400u), __builtin_amdgcn_perm((b), (a), 0x0c0c0400u), 0x05040100u)
#pragma unroll
    for (int j = 0; j < 4; ++j) { const float inv = j == 0 ? i0 : (j == 1 ? i1 : (j == 2 ? i2 : i3));
#pragma unroll
        for (int i = 0; i < 16; ++i) {
            const unsigned a = SLAB_Q(st[2 * (0 + i) + (j >> 1)], j & 1, inv), b = SLAB_Q(st[2 * (16 + i) + (j >> 1)], j & 1, inv), c = SLAB_Q(st[2 * (32 + i) + (j >> 1)], j & 1, inv), e = SLAB_Q(st[2 * (48 + i) + (j >> 1)], j & 1, inv);
            *(GAS unsigned*)(dst + (size_t)j * DM + 128 * i) = SLAB_PK(a, b, c, e); } }
#undef SLAB_Q
#undef SLAB_PK
    __syncthreads();
}
__device__ __forceinline__ void witems_run(const WPtrs& P, int lo, int hi, int rank, int nw, LAS float* scr, int lane) {
    if (lo + rank >= hi) return;
    WItem cur = witem_decode(P, lo + rank); f32x4 cv[8]; witem_load(cv, cur, lane);
    for (int it = lo + rank; it < hi; it += nw) {
        const int itn = it + nw; WItem nxt = cur; f32x4 nv[8];
        if (itn < hi) { nxt = witem_decode(P, itn); witem_load(nv, nxt, lane); }
        witem_store(cv, cur, scr, lane);
        if (itn < hi) {
#pragma unroll
            for (int i = 0; i < 8; ++i) cv[i] = nv[i];
            cur = nxt; }
    }
}
__device__ __forceinline__ void gain_to_lds(const float* g, LAS unsigned char* dst, int tid) {
    for (int i = tid; i < DM / 4; i += NWAVES * 64) ((LAS f32x4*)dst)[i] = ((const GAS f32x4*)g)[i];
}
__device__ __forceinline__ const float* x_row(const float* xp, const float* xs, const float* meta, int m) {
    return m < TP ? xp + (size_t)m * DM : (m < MREAL ? xs + (size_t)(m - TP) * DM : meta + (size_t)(m - MREAL) * DM);
}

typedef const __attribute__((address_space(4))) char* kptr_t;
__device__ __forceinline__ kptr_t kbase() { kptr_t p = (kptr_t)__builtin_amdgcn_kernarg_segment_ptr(); asm volatile("" : "+s"(p)); return p; }
__device__ __forceinline__ const float* kin(kptr_t p, int i) { return *(const float* const __attribute__((address_space(4)))*)(p + 8 * i); }
__device__ __forceinline__ float* kout(kptr_t p) { return *(float* const __attribute__((address_space(4)))*)(p + 128); }
__device__ __forceinline__ unsigned char* kws(kptr_t p) { return *(unsigned char* const __attribute__((address_space(4)))*)(p + 136); }
#define K_IN(name, i) const float* const name = kin(kp_, i)
#define K_WS(type, name, off) type* const name = (type*)(kws(kp_) + (off))
#define K_WPTRS(DN_MODE) const WPtrs WP{kin(kp_, 3), kin(kp_, 4), kin(kp_, 15), kin(kp_, 7), kin(kp_, 8), (bf16*)(kws(kp_) + WS_WIN), (bf16*)(kws(kp_) + WS_WOUT), (bf16*)(kws(kp_) + WS_WDN), (float*)(kws(kp_) + WS_CMAXD), (DN_MODE)}
#define GRID_BAR() do { XcdBarrier b_; b_.bar = (unsigned*)(kws(kbase()) + WS_CTL) + CW_BAR; b_.x = xb_xcc_id(); b_.st = F.MISC + 8; b_.t0 = (F.wave == 0 && lane_id() == 0); xcd_barrier(b_); } while (0)
struct Args { const float* in[16]; float* out; unsigned char* ws; };
__global__ void __launch_bounds__(NWAVES * 64, 2) enc_fwd(Args args) {
    extern __shared__ __attribute__((aligned(16))) unsigned char lds[];
    Frame F;
    F.lds = (LAS unsigned char*)lds;
    F.MISC = (volatile LAS unsigned*)(F.lds + MISC_OFF);
    F.wave = __builtin_amdgcn_readfirstlane((int)threadIdx.x >> 6);
    F.G = gridDim.x; { const int bx = blockIdx.x; F.vcu = (F.G % 8 == 0) ? (bx % 8) * (F.G / 8) + bx / 8 : bx; }
    for (int u = (F.wave * 64 + lane_id()); u < (LDS_BYTES - LDSCTL_OFF) / 4; u += NWAVES * 64) ((LAS unsigned*)(F.lds + LDSCTL_OFF))[u] = 0u;
    __syncthreads();
    (void)xcd_barrier_post((unsigned*)(kws(kbase()) + WS_CTL) + CW_BAR, F.MISC + 8, F.wave == 0 && lane_id() == 0);
    const int gw = F.vcu * NWAVES + F.wave, NGW = F.G * NWAVES;

#pragma unroll
    for (int rep_ = 0; rep_ < REP_P0; ++rep_) {
        const kptr_t kp_ = kbase(); K_IN(x_prompt, 0); K_IN(x_sample, 1); K_IN(meta, 2); K_IN(g_pre_mix, 9); K_WS(bf16, Abuf, WS_A); K_WS(float, rsx, WS_RSX);
        int ln = lane_id(); asm volatile("" : "+v"(ln));
        LAS float* scr = (LAS float*)(F.lds + RING_OFF + F.wave * P0_SCR);
        { int td = (F.wave * 64 + lane_id()); asm volatile("" : "+v"(td)); gain_to_lds(g_pre_mix, F.lds + GAIN_OFF, td); } __syncthreads();
        { constexpr int SLAB_ITEMS = 53; const int nsl = SLAB0 + (P4_INT8 ? NSLAB_O : 0), rem = nsl % F.G, nlight = rem ? F.G - rem : 0; const int nextra = (SLAB_ITEMS * nlight < WI_A) ? SLAB_ITEMS * nlight : 0;
          if (rep_ == 0) { K_IN(w_gate, 13); K_IN(w_up, 14); K_IN(w_out, 4); K_IN(g_na, 7); K_IN(g_sw, 8);
            { int td = F.wave * 64 + ln; for (int i = td; i < DM / 4; i += NWAVES * 64) ((LAS f32x4*)(F.lds + OG_OFF))[i] = i < 512 ? ((const GAS f32x4*)g_na)[i] : ((const GAS f32x4*)g_sw)[i - 512]; } __syncthreads(); K_WS(unsigned char, Wgu8, WS_WGU); K_WS(float, cmaxw, WS_COLMAX); K_WS(unsigned char, Wout8, WS_WOUT); K_WS(float, cmaxo, WS_CMAXO);
            for (int s = F.vcu; s < nsl; s += F.G) { if (s < SLAB0) wgu_slab(w_gate, w_up, Wgu8, cmaxw, s, (LAS float*)(F.lds + SLAB_RED_OFF), F.wave, ln);
                                                   else wout_slab(w_out, (const LAS float*)(F.lds + OG_OFF), Wout8, cmaxo, s - SLAB0, (LAS float*)(F.lds + SLAB_RED_OFF), F.wave, ln); } }
          K_WPTRS(1);
          if (nextra > 0 && F.vcu >= rem) witems_run(WP, 0, nextra, (F.vcu - rem) * NWAVES + F.wave, nlight * NWAVES, scr, ln);
          witems_run(WP, nextra, WI_A, gw, NGW, scr, ln);
          witems_run(WP, WI_A, WI_N, gw, NGW, scr, ln); }
        {
            f32x4 v[16];
            auto load_row = [&](f32x4 (&d)[16], int m) { if (m < MREAL + NMETA) { const GAS f32x4* xr = (const GAS f32x4*)x_row(x_prompt, x_sample, meta, m) + ln;
#pragma unroll
                    for (int j = 0; j < 16; ++j) d[j] = __builtin_nontemporal_load(xr + 64 * j); } };
            if (gw < MPAD) load_row(v, gw);
            for (int m = gw; m < MPAD; m += NGW) {
                const int mn = m + NGW; f32x4 nv[16];
                if (mn < MPAD) load_row(nv, mn);
                GAS unsigned long long* o8 = (GAS unsigned long long*)(Abuf + (size_t)m * DM) + ln;
                if (m >= MREAL + NMETA) {
#pragma unroll
                    for (int j = 0; j < 16; ++j) o8[64 * j] = 0ull;
                } else {
                    float s = 0.f;
#pragma unroll
                    for (int j = 0; j < 16; ++j) s += (v[j].x * v[j].x + v[j].y * v[j].y) + (v[j].z * v[j].z + v[j].w * v[j].w);
                    const float nrm = sqrtf(wave_sum(s) * (1.0f / DM) + EPS), rs = 1.0f / nrm;
                    if (ln == 0 && m < MREAL) rsx[m] = nrm;
#pragma unroll
                    for (int j = 0; j < 16; ++j) { const f32x4 g = ((const LAS f32x4*)(F.lds + GAIN_OFF))[ln + 64 * j];
                        o8[64 * j] = (unsigned long long)pkbf(v[j].x * rs * g.x, v[j].y * rs * g.y) | ((unsigned long long)pkbf(v[j].z * rs * g.z, v[j].w * rs * g.w) << 32);
                        if ((j & 3) == 3) asm volatile("" ::: "memory"); }
                }
                if (mn < MPAD) {
#pragma unroll
                    for (int j = 0; j < 16; ++j) v[j] = nv[j]; }
            }
        }
    }
    GRID_BAR();

    {
        const kptr_t kp_ = kbase(); K_WS(bf16, Abuf, WS_A); K_WS(bf16, Win_t, WS_WIN); K_WS(bf16, Bbuf, WS_B);
        pg8::Gemm g{Abuf, Win_t, MPAD, DIN, DM}; pg8::StaticOrder S; S.init(MPAD, DIN, F.G, (int)blockIdx.x, WGM_P1);
        pg8::EpiBf16Blk E{Bbuf, MPAD};
        pg8::gemm_phase<pg8::EpiBf16Blk, pg8::StaticOrder, true, true>(F.lds + RING_OFF, g, S, E, F.wave);
        { constexpr int NWG = (MPAD / 256) * (DIN / 256); const int rem = NWG % F.G; const bool idle = rem != 0 && (int)blockIdx.x >= rem;
          if (idle || rem == 0) { int ln = lane_id(); asm volatile("" : "+v"(ln));
              K_IN(w_gate, 13); K_IN(w_up, 14); K_WS(unsigned char, Wgu8, WS_WGU); K_WS(float, cmaxw, WS_COLMAX);
              const int rank = idle ? (int)blockIdx.x - rem : (int)blockIdx.x, nr = idle ? F.G - rem : F.G;
              for (int s = SLAB0 + rank; s < NSLAB; s += nr) wgu_slab(w_gate, w_up, Wgu8, cmaxw, s, (LAS float*)(F.lds + SLAB_RED_OFF), F.wave, ln); } }
    }
    GRID_BAR();

#pragma unroll
    for (int rep_ = 0; rep_ < REP_P2; ++rep_) {
        const kptr_t kp_ = kbase(); K_WS(bf16, Bbuf, WS_B); K_WS(float, ssq, WS_ACC2); K_IN(rpb, 5); K_IN(sink, 6);
        const att::bf16* Pp = (const att::bf16*)Bbuf; att::bf16* Op = (att::bf16*)kout(kp_);
#pragma unroll
        for (int rna_ = 0; rna_ < REP_NA; ++rna_)
        for (int uidx = F.vcu; uidx < 1536; uidx += F.G) {
            att::UnitP u;
            if (uidx < 1024) { u.seqbase = 0; u.T = TP; u.head = uidx >> 6; u.blk = uidx & 63; }
            else { const int v = uidx - 1024; u.seqbase = TP + TS * (v >> 8); u.T = TS; u.head = (v & 255) >> 4; u.blk = v & 15; }
            att::bf16* Op2 = Op; float* ssq2 = ssq; const att::bf16* Pp2 = Pp; asm volatile("" : "+s"(Op2), "+s"(ssq2), "+s"(Pp2));
            att::attn_unit_na4(u, Pp2, Op2, ssq2, rpb, (LAS char*)F.lds + RING_OFF, F.wave, rna_ == 0);
        }
#pragma unroll
        for (int rsw_ = 0; rsw_ < REP_SW; ++rsw_)
        for (int uidx = F.vcu; uidx < 1536; uidx += F.G) {
            att::UnitP u;
            if (uidx < 1024) { u.seqbase = 0; u.T = TP; u.head = uidx >> 8; u.blk = uidx & 255; }
            else { const int v = uidx - 1024; u.seqbase = TP + TS * (v >> 8); u.T = TS; u.head = (v & 255) >> 6; u.blk = v & 63; }
            att::bf16* Op2 = Op; float* ssq2 = ssq; const att::bf16* Pp2 = Pp; asm volatile("" : "+s"(Op2), "+s"(ssq2), "+s"(Pp2));
            att::attn_unit_sw4(u, Pp2, Op2, ssq2, sink, (LAS char*)F.lds + RING_OFF, F.wave, rsw_ == 0);
        }
    }
    GRID_BAR();

#if P4_INT8
    { int ln3 = lane_id(); asm volatile("" : "+v"(ln3));
    const kptr_t kp_ = kbase(); K_WS(float, ssq, WS_ACC2); K_WS(float, onsc, WS_ONSC); K_WS(unsigned char, On8, WS_ON8); const bf16* const Obuf = (const bf16*)kout(kp_);
    for (int m = gw; m < MREAL; m += NGW) {
        const GAS unsigned long long* orow = (const GAS unsigned long long*)(Obuf + (size_t)m * DM) + ln3;
        f32x4 v[16];
        { unsigned long long ow[16];
#pragma unroll
          for (int j = 0; j < 16; ++j) ow[j] = __builtin_nontemporal_load(orow + 64 * j);
#pragma unroll
          for (int j = 0; j < 16; ++j) { const unsigned lo = (unsigned)ow[j], hi = (unsigned)(ow[j] >> 32); v[j] = (f32x4){att::bf_lo(lo), att::bf_hi(lo), att::bf_lo(hi), att::bf_hi(hi)}; } }
        const float qa = ssq[2 * (size_t)m], qb = ssq[2 * (size_t)m + 1];
#pragma unroll
        for (int s2 = 1; s2 < 8; s2 <<= 1)
#pragma unroll
            for (int j = 0; j < 16; ++j) if (!(j & s2)) { const f32x4 a = v[j], c = v[j | s2]; v[j] = a + c; v[j | s2] = a - c; }
        float ama = 0.f, amb = 0.f;
#pragma unroll
        for (int j = 0; j < 16; ++j) { const float mx = fmaxf(fmaxf(fabsf(v[j].x), fabsf(v[j].y)), fmaxf(fabsf(v[j].z), fabsf(v[j].w)));
            if (j < 8) ama = fmaxf(ama, mx); else amb = fmaxf(amb, mx); }
        const float rsa = 1.0f / sqrtf(qa * (1.0f / 2048.0f) + EPS), rsb = 1.0f / sqrtf(qb * (1.0f / 2048.0f) + EPS);
        float na = wave_max(ama) * rsa, nb = wave_max(amb) * rsb;
        na = fmaxf(fmaxf(na, nb * (1.0f / 32.0f)), 1e-30f); nb = fmaxf(nb, na * (1.0f / 32.0f));
        const float sa = na * (1.0f / 127.0f), sb = nb * (1.0f / 127.0f), ia = rsa / sa, ib = rsb / sb;
        GAS unsigned* o4 = (GAS unsigned*)(On8 + (size_t)m * DM) + ln3;
#pragma unroll
        for (int j = 0; j < 16; ++j) { const float iv = j < 8 ? ia : ib;
            const int a0 = (int)__builtin_rintf(v[j].x * iv), a1 = (int)__builtin_rintf(v[j].y * iv), a2 = (int)__builtin_rintf(v[j].z * iv), a3 = (int)__builtin_rintf(v[j].w * iv);
            o4[64 * j] = ((unsigned)a0 & 255u) | (((unsigned)a1 & 255u) << 8) | (((unsigned)a2 & 255u) << 16) | ((unsigned)a3 << 24); }
        if (ln3 == 0) { onsc[2 * (size_t)m] = sa; onsc[2 * (size_t)m + 1] = sb; }
    }
    }
    GRID_BAR();

    {
        const kptr_t kp_ = kbase(); K_WS(bf16, On8, WS_ON8); K_WS(bf16, Wout8, WS_WOUT); K_WS(float, onsc, WS_ONSC); K_WS(float, cmaxo, WS_CMAXO); K_WS(bf16, Bbuf, WS_B);
        pg8::Gemm g{On8, Wout8, MREAL, DM, DM / 2}; pg8::StaticOrder S; S.init(MREAL, DM, F.G, (int)blockIdx.x, WGM_P4);
        pg8::EpiBf16I8Norm2 E{Bbuf, DM, onsc, cmaxo};
        pg8::gemm_phase<pg8::EpiBf16I8Norm2, pg8::StaticOrder, true, true>(F.lds + RING_OFF, g, S, E, F.wave);
    }
#else
    {
        const kptr_t kp_ = kbase(); K_WS(bf16, Wout_t, WS_WOUT); K_WS(float, ssq, WS_ACC2); K_WS(bf16, Bbuf, WS_B);
        pg8::Gemm g{(const bf16*)kout(kp_), Wout_t, MREAL, DM, DM}; pg8::StaticOrder S; S.init(MREAL, DM, F.G, (int)blockIdx.x, WGM_P4);
        pg8::EpiBf16Norm2 E{Bbuf, DM, ssq, 1.0f / 2048.0f, EPS};
        pg8::gemm_phase<pg8::EpiBf16Norm2, pg8::StaticOrder, true, true>(F.lds + RING_OFF, g, S, E, F.wave);
    }
#endif
    GRID_BAR();

    { int ln5 = lane_id(); asm volatile("" : "+v"(ln5));
    const kptr_t kp_ = kbase(); K_IN(g_pre_mix, 9); K_IN(g_post_mix, 10); K_IN(g_pre_ffn, 11); K_WS(bf16, Abuf, WS_A); K_WS(bf16, Bbuf, WS_B); K_WS(unsigned char, H8, WS_WIN); K_WS(float, scaleA, WS_SCALEA); K_WS(float, rsx, WS_RSX); float* const out = kout(kp_);
    { int td = (F.wave * 64 + lane_id()); asm volatile("" : "+v"(td)); gain_to_lds(g_post_mix, F.lds + RING_OFF, td); gain_to_lds(g_pre_ffn, F.lds + RING_OFF + 16384, td);
      for (int i = td; i < DM / 4; i += NWAVES * 64) { const f32x4 g = ((const GAS f32x4*)g_pre_mix)[i]; ((LAS f32x4*)(F.lds + RING_OFF + 32768))[i] = (f32x4){1.0f / g.x, 1.0f / g.y, 1.0f / g.z, 1.0f / g.w}; } } __syncthreads();
    for (int m = gw; m < MREAL; m += NGW) {
        const GAS unsigned long long* mr = (const GAS unsigned long long*)(Bbuf + (size_t)m * DM) + ln5;
        const GAS unsigned long long* hr = (const GAS unsigned long long*)(Abuf + (size_t)m * DM) + ln5;
        f32x4 v[16]; unsigned long long mw[16], hw[16]; float s = 0.f;
#pragma unroll
        for (int j = 0; j < 16; ++j) { mw[j] = __builtin_nontemporal_load(mr + 64 * j); hw[j] = __builtin_nontemporal_load(hr + 64 * j); }
        const float nrm = rsx[m];
#pragma unroll
        for (int j = 0; j < 16; ++j) { const unsigned lo = (unsigned)mw[j], hi = (unsigned)(mw[j] >> 32); const float a = att::bf_lo(lo), b = att::bf_hi(lo), c = att::bf_lo(hi), d = att::bf_hi(hi);
            s += (a * a + b * b) + (c * c + d * d); }
        const float rs1 = 1.0f / sqrtf(wave_sum(s) * (1.0f / DM) + EPS); float s2 = 0.f;
        GAS unsigned long long* x8 = (GAS unsigned long long*)(out + (size_t)m * DM) + ln5;
#pragma unroll
        for (int j = 0; j < 16; ++j) { const f32x4 g = ((const LAS f32x4*)(F.lds + RING_OFF))[ln5 + 64 * j], rg = ((const LAS f32x4*)(F.lds + RING_OFF + 32768))[ln5 + 64 * j];
            const unsigned lo = (unsigned)mw[j], hi = (unsigned)(mw[j] >> 32), xl = (unsigned)hw[j], xh = (unsigned)(hw[j] >> 32);
            v[j].x = att::bf_lo(xl) * nrm * rg.x + att::bf_lo(lo) * rs1 * g.x; v[j].y = att::bf_hi(xl) * nrm * rg.y + att::bf_hi(lo) * rs1 * g.y;
            v[j].z = att::bf_lo(xh) * nrm * rg.z + att::bf_lo(hi) * rs1 * g.z; v[j].w = att::bf_hi(xh) * nrm * rg.w + att::bf_hi(hi) * rs1 * g.w;
            s2 += (v[j].x * v[j].x + v[j].y * v[j].y) + (v[j].z * v[j].z + v[j].w * v[j].w);
            x8[64 * j] = (unsigned long long)pkbf(v[j].x, v[j].y) | ((unsigned long long)pkbf(v[j].z, v[j].w) << 32);
            if ((j & 3) == 3) asm volatile("" ::: "memory"); }
        const float rs2 = 1.0f / sqrtf(wave_sum(s2) * (1.0f / DM) + EPS);
        float am = 0.f;
#pragma unroll
        for (int j = 0; j < 16; ++j) { const f32x4 g = ((const LAS f32x4*)(F.lds + RING_OFF + 16384))[ln5 + 64 * j];
            v[j].x *= rs2 * g.x; v[j].y *= rs2 * g.y; v[j].z *= rs2 * g.z; v[j].w *= rs2 * g.w;
            am = fmaxf(fmaxf(am, fmaxf(fabsf(v[j].x), fabsf(v[j].y))), fmaxf(fabsf(v[j].z), fabsf(v[j].w)));
            if ((j & 3) == 3) asm volatile("" ::: "memory"); }
        am = wave_max(am); const float inv = am > 0.f ? 127.0f / am : 0.f;
        GAS unsigned* o4 = (GAS unsigned*)(H8 + (size_t)m * DM) + ln5;
#pragma unroll
        for (int j = 0; j < 16; ++j) { const int a0 = (int)__builtin_rintf(v[j].x * inv), a1 = (int)__builtin_rintf(v[j].y * inv), a2 = (int)__builtin_rintf(v[j].z * inv), a3 = (int)__builtin_rintf(v[j].w * inv);
            o4[64 * j] = ((unsigned)a0 & 255u) | (((unsigned)a1 & 255u) << 8) | (((unsigned)a2 & 255u) << 16) | ((unsigned)a3 << 24); }
        if (ln5 == 0) scaleA[m] = am * (1.0f / 127.0f);
    }
    }
    GRID_BAR();

#pragma unroll
    for (int rep_ = 0; rep_ < REP_P6; ++rep_) {
        const kptr_t kp_ = kbase(); K_WS(bf16, H8, WS_WIN); K_WS(bf16, Wgu_t, WS_WGU); K_WS(bf16, Bbuf, WS_B);
        K_WS(float, scaleA, WS_SCALEA); K_WS(float, cmax, WS_COLMAX);
        pg8::Gemm g{H8, Wgu_t, MREAL, NGU, DM / 2};
        pg8::StaticOrder S; S.init(MREAL, NGU, F.G, (int)blockIdx.x);
        pg8::EpiSwiGLUI8 E{Bbuf, DFF, scaleA, cmax};
        pg8::gemm_phase<pg8::EpiSwiGLUI8, pg8::StaticOrder, true, true>(F.lds + RING_OFF, g, S, E, F.wave);
        if (rep_ == 0) { constexpr int NWG = (MREAL / 256) * (NGU / 256); const int rem = NWG % F.G; const bool idle = rem != 0 && (int)blockIdx.x >= rem;
          if (idle || rem == 0) { int ln = lane_id(); asm volatile("" : "+v"(ln));
              K_WPTRS(2);
              witems_run(WP, WI_A, WI_N, (idle ? (int)blockIdx.x - rem : (int)blockIdx.x) * NWAVES + F.wave, (idle ? F.G - rem : F.G) * NWAVES, (LAS float*)(F.lds + RING_OFF + F.wave * P0_SCR), ln); } }
    }
    GRID_BAR();

    { int ln6 = lane_id(); asm volatile("" : "+v"(ln6));
    const kptr_t kp_ = kbase(); K_WS(bf16, Bbuf, WS_B); K_WS(unsigned char, Act8, WS_ACT8); K_WS(float, scaleA, WS_SCALEA);
    const unsigned sm1 = (ln6 & 1) ? 0x80000000u : 0u, sm2 = (ln6 & 2) ? 0x80000000u : 0u, sm4 = (ln6 & 4) ? 0x80000000u : 0u;
#define P6B_X1(X) do { const float o_ = (X); const float p_ = __builtin_bit_cast(float, __builtin_amdgcn_update_dpp(0, __builtin_bit_cast(int, o_), 0xB1, 0xF, 0xF, false)); (X) = p_ + __builtin_bit_cast(float, __builtin_bit_cast(unsigned, o_) ^ sm1); } while (0)
#define P6B_X2(X) do { const float o_ = (X); const float p_ = __builtin_bit_cast(float, __builtin_amdgcn_update_dpp(0, __builtin_bit_cast(int, o_), 0x4E, 0xF, 0xF, false)); (X) = p_ + __builtin_bit_cast(float, __builtin_bit_cast(unsigned, o_) ^ sm2); } while (0)
#define P6B_X4(X) do { const float o_ = (X); const int lo_ = __builtin_amdgcn_update_dpp(0, __builtin_bit_cast(int, o_), 0x104, 0xF, 0x5, false); \
        const float p_ = __builtin_bit_cast(float, __builtin_amdgcn_update_dpp(lo_, __builtin_bit_cast(int, o_), 0x114, 0xF, 0xA, false)); (X) = p_ + __builtin_bit_cast(float, __builtin_bit_cast(unsigned, o_) ^ sm4); } while (0)
    for (int m = gw; m < MREAL; m += NGW) {
        const GAS unsigned long long* ar = (const GAS unsigned long long*)(Bbuf + (size_t)m * DFF) + ln6;
        GAS unsigned* o4 = (GAS unsigned*)(Act8 + (size_t)m * DFF) + ln6;
        unsigned st[86]; float am = 0.f;
        { unsigned long long aw[43];
#pragma unroll
          for (int i = 0; i < 43; ++i) aw[i] = __builtin_nontemporal_load(ar + 64 * i);
#pragma unroll
          for (int i = 0; i < 43; ++i) { const unsigned lo = (unsigned)aw[i], hi = (unsigned)(aw[i] >> 32);
            const float x0 = att::bf_lo(lo), y0 = att::bf_hi(lo), z0 = att::bf_lo(hi), w0 = att::bf_hi(hi);
            const float a_ = x0 + y0, b_ = x0 - y0, c_ = z0 + w0, d_ = z0 - w0; float x = a_ + c_, y = b_ + d_, z = a_ - c_, w = b_ - d_;
            P6B_X1(x); P6B_X1(y); P6B_X1(z); P6B_X1(w); P6B_X2(x); P6B_X2(y); P6B_X2(z); P6B_X2(w); P6B_X4(x); P6B_X4(y); P6B_X4(z); P6B_X4(w);
            am = fmaxf(fmaxf(am, fmaxf(fabsf(x), fabsf(y))), fmaxf(fabsf(z), fabsf(w)));
            st[2 * i] = pkbf(x, y); st[2 * i + 1] = pkbf(z, w); } }
        am = wave_max(am) * 1.00390625f;
        const float inv = am > 0.f ? 127.0f / am : 0.f;
#pragma unroll
        for (int j = 0; j < 43; ++j) { const unsigned lo = st[2 * j], hi = st[2 * j + 1];
#define P6B_Q(v) __builtin_bit_cast(unsigned, __builtin_fmaf((v), inv, 12582912.0f))
            o4[64 * j] = __builtin_amdgcn_perm(__builtin_amdgcn_perm(P6B_Q(att::bf_hi(hi)), P6B_Q(att::bf_lo(hi)), 0x0c0c0400u), __builtin_amdgcn_perm(P6B_Q(att::bf_hi(lo)), P6B_Q(att::bf_lo(lo)), 0x0c0c0400u), 0x05040100u);
#undef P6B_Q
        }
        if (ln6 == 0) scaleA[m] = am * (1.0f / 127.0f);
    }
#undef P6B_X1
#undef P6B_X2
#undef P6B_X4
    }
    GRID_BAR();

    {
        const kptr_t kp_ = kbase(); K_WS(bf16, Abuf, WS_A); K_WS(bf16, Wdn8, WS_WDN); K_WS(bf16, Act8, WS_ACT8); K_WS(float, scaleA, WS_SCALEA); K_WS(float, cmaxd, WS_CMAXD);
        pg8::Gemm g{Act8, Wdn8, MREAL, DM, DFF / 2}; pg8::StaticOrder S; S.init(MREAL, DM, F.G, (int)blockIdx.x, WGM_P7);
        pg8::EpiBf16I8 E{Abuf, DM, scaleA, cmaxd};
        pg8::gemm_phase<pg8::EpiBf16I8, pg8::StaticOrder, true, true>(F.lds + RING_OFF, g, S, E, F.wave);
    }
    GRID_BAR();

    { int ln8 = lane_id(); asm volatile("" : "+v"(ln8));
    const kptr_t kp_ = kbase(); K_IN(g_post_ffn, 12); K_WS(bf16, Abuf, WS_A); float* const out = kout(kp_);
    { int td = (F.wave * 64 + lane_id()); asm volatile("" : "+v"(td)); gain_to_lds(g_post_ffn, F.lds + RING_OFF, td); } __syncthreads();
    for (int m = gw; m < MREAL; m += NGW) {
        GAS f32x4* yr = (GAS f32x4*)(out + (size_t)m * DM) + ln8;
        const GAS unsigned long long* xr = (const GAS unsigned long long*)(out + (size_t)m * DM) + ln8;
        const GAS unsigned long long* fr = (const GAS unsigned long long*)(Abuf + (size_t)m * DM) + ln8;
        unsigned long long xw[16], fw[16]; float sf = 0.f;
#pragma unroll
        for (int j = 0; j < 16; ++j) { xw[j] = __builtin_nontemporal_load(xr + 64 * j); fw[j] = __builtin_nontemporal_load(fr + 64 * j); }
#pragma unroll
        for (int j = 0; j < 16; ++j) { const unsigned lo = (unsigned)fw[j], hi = (unsigned)(fw[j] >> 32); const float a = att::bf_lo(lo), b = att::bf_hi(lo), c = att::bf_lo(hi), d = att::bf_hi(hi);
            sf += (a * a + b * b) + (c * c + d * d); }
        const float rs3 = 1.0f / sqrtf(wave_sum(sf) * (1.0f / DM) + EPS);
#pragma unroll
        for (int j = 0; j < 16; ++j) { const f32x4 g3 = ((const LAS f32x4*)(F.lds + RING_OFF))[ln8 + 64 * j];
            const unsigned lo = (unsigned)fw[j], hi = (unsigned)(fw[j] >> 32), xl = (unsigned)xw[j], xh = (unsigned)(xw[j] >> 32);
            f32x4 y; y.x = att::bf_lo(xl) + att::bf_lo(lo) * rs3 * g3.x; y.y = att::bf_hi(xl) + att::bf_hi(lo) * rs3 * g3.y;
            y.z = att::bf_lo(xh) + att::bf_lo(hi) * rs3 * g3.z; y.w = att::bf_hi(xh) + att::bf_hi(hi) * rs3 * g3.w;
            __builtin_nontemporal_store(y, yr + 64 * j);
            if ((j & 3) == 3) asm volatile("" ::: "memory"); }
    }
    }
}

extern "C" void kernel_launch(void* const* d_in, const int* in_sizes, int n_in, void* d_out, int out_size, void* d_ws, size_t ws_size, hipStream_t stream) {
    static int grid = 0;
    if (grid == 0) {
        if (n_in != 16 || in_sizes[0] != TP * DM || in_sizes[1] != 2 * TS * DM || out_size != MREAL * DM || ws_size < WS_END) {
            fprintf(stderr, "kernel_launch: shape mismatch: n_in %d in0 %d in1 %d out %d ws %zu (need %zu); nothing launched\n", n_in, n_in > 0 ? in_sizes[0] : -1, n_in > 1 ? in_sizes[1] : -1, out_size, ws_size, (size_t)WS_END); grid = -1; return; }
        int dev = 0, cus = 0, per_cu = 0;
        if (hipGetDevice(&dev) != hipSuccess || hipDeviceGetAttribute(&cus, hipDeviceAttributeMultiprocessorCount, dev) != hipSuccess) { fprintf(stderr, "kernel_launch: device query failed\n"); grid = -1; return; }
        if (hipFuncSetAttribute((const void*)enc_fwd, hipFuncAttributeMaxDynamicSharedMemorySize, LDS_BYTES) != hipSuccess) { fprintf(stderr, "kernel_launch: hipFuncSetAttribute failed\n"); grid = -1; return; }
        if (hipOccupancyMaxActiveBlocksPerMultiprocessor(&per_cu, (const void*)enc_fwd, NWAVES * 64, LDS_BYTES) != hipSuccess || per_cu < 1)
            fprintf(stderr, "kernel_launch: note: occupancy query reports %d workgroups per CU\n", per_cu);
        (void)hipGetLastError();
        grid = cus;
    }
    if (grid < 0) return;
    if (hipMemsetAsync((char*)d_ws + WS_CTL, 0, CTL_ZERO_BYTES, stream) != hipSuccess) { fprintf(stderr, "kernel_launch: memset failed\n"); return; }
    Args a{};
    for (int i = 0; i < 16; ++i) a.in[i] = (const float*)d_in[i];
    a.out = (float*)d_out; a.ws = (unsigned char*)d_ws;
    hipLaunchKernelGGL(enc_fwd, dim3(grid), dim3(NWAVES * 64), LDS_BYTES, stream, a);
    const hipError_t le = hipPeekAtLastError();
    if (le != hipSuccess) fprintf(stderr, "kernel_launch: launch failed: %s\n", hipGetErrorName(le));
}
```

```cpp
#include <hip/hip_runtime.h>
#include <hip/hip_bf16.h>
#include <cstdio>
#include <cstdint>
namespace pg8 {
#define PG8_LAS __attribute__((address_space(3)))
typedef unsigned short bf16_t;
typedef short bf16x8 __attribute__((ext_vector_type(8)));
typedef float f32x4 __attribute__((ext_vector_type(4)));
typedef unsigned u32x4 __attribute__((ext_vector_type(4)));
constexpr int BM = 256, BK = 64, HALF = 128, HTB = HALF * BK * 2  , STAGE_BYTES = 8 * HTB, NXCD = 8, WGM = 8;

__host__ __device__ __forceinline__ int lds_byte(int r, int c) { const int st = (r >> 4) * 2 + (c >> 5), rr = r & 15, cc = c & 31, ob = rr * 64 + cc * 2; return st * 1024 + (ob ^ (((ob >> 9) & 1) << 5)); }
__host__ __device__ __forceinline__ void stage_rc(int b, int& R, int& C) { const int st = b / 1024, sb = b % 1024, swz = sb ^ (((sb >> 9) & 1) << 5); R = (st >> 1) * 16 + swz / 64; C = (st & 1) * 32 + (swz % 64) / 2; }
__host__ __device__ __forceinline__ int perm32(int rho) { const int n = rho >> 4, i = rho & 15; return 8 * (i >> 2) + 4 * n + (i & 3); }

struct Unit { int pm, pn; };
struct Gemm { const bf16_t* A; const bf16_t* Bt; int M, N, K; };

struct StaticOrder {
    int nM, nN, nwg, G, c, wgm;
    __host__ __device__ void init(int M, int N, int G_, int c_, int wgm_ = WGM) { nM = M / BM; nN = N / BM; nwg = nM * nN; G = G_; c = c_; wgm = wgm_; }
    __host__ __device__ bool next(int i, Unit& u) const {
        const long L = (long)i * G + c; if (L >= nwg) return false;
        int wgid = (int)L; { const int q = nwg / NXCD, r = nwg % NXCD, xcd = wgid % NXCD, off = wgid / NXCD; wgid = (xcd < r ? xcd * (q + 1) : r * (q + 1) + (xcd - r) * q) + off; }
        const int nig = wgm * nN, gid = wgid / nig, fm = gid * wgm, gsz = (nM - fm) < wgm ? (nM - fm) : wgm;
        u.pm = fm + ((wgid % nig) % gsz); u.pn = (wgid % nig) / gsz; return true;
    }
    __device__ __forceinline__ void a_ready(const Unit&) const {}
    __device__ __forceinline__ void done(const Unit&) const {}
};

__device__ __forceinline__ unsigned cvt_pk_bf16(float lo, float hi) { unsigned r; asm volatile("v_cvt_pk_bf16_f32 %0, %1, %2" : "=v"(r) : "v"(lo), "v"(hi)); return r; }
typedef float f32x2 __attribute__((ext_vector_type(2)));
struct EpiBf16 {
    static constexpr bool PERM = true, AFTER_DRAIN = false, HAS_MID = false, I8 = false;
    bf16_t* O; int ldc;
    __device__ __forceinline__ void operator()(const f32x4 (&acc)[2][2][4][2], const Unit& u, int wr, int wc, int fr, int fq) const {
        const int row0 = u.pm * BM + wr * 64 + fr, col0 = u.pn * BM + wc * 32 + 8 * fq;
#pragma unroll
        for (int ai = 0; ai < 2; ++ai)
#pragma unroll
            for (int m = 0; m < 4; ++m) { bf16_t* rowp = O + (size_t)(row0 + ai * HALF + m * 16) * ldc + col0;
#pragma unroll
                for (int bj = 0; bj < 2; ++bj) { const f32x4 v0 = acc[ai][bj][m][0], v1 = acc[ai][bj][m][1];
                    u32x4 w; w.x = cvt_pk_bf16(v0[0], v0[1]); w.y = cvt_pk_bf16(v0[2], v0[3]); w.z = cvt_pk_bf16(v1[0], v1[1]); w.w = cvt_pk_bf16(v1[2], v1[3]);
                    *(u32x4*)(rowp + bj * HALF) = w; } }
    }
};
struct EpiF32 {
    static constexpr bool PERM = false, AFTER_DRAIN = false, HAS_MID = false, I8 = false;
    float* C; int ldc;
    __device__ __forceinline__ void operator()(const f32x4 (&acc)[2][2][4][2], const Unit& u, int wr, int wc, int fr, int fq) const {
        const int row0 = u.pm * BM + wr * 64 + fr, col0 = u.pn * BM + wc * 32 + 4 * fq;
#pragma unroll
        for (int ai = 0; ai < 2; ++ai)
#pragma unroll
            for (int m = 0; m < 4; ++m) { float* rowp = C + (size_t)(row0 + ai * HALF + m * 16) * ldc + col0;
#pragma unroll
                for (int bj = 0; bj < 2; ++bj)
#pragma unroll
                    for (int n = 0; n < 2; ++n) *(f32x4*)(rowp + bj * HALF + n * 16) = acc[ai][bj][m][n]; }
    }
};
__device__ __forceinline__ float silu_mul(float g, float u) { return g * u * __builtin_amdgcn_rcpf(1.0f + __builtin_amdgcn_exp2f(g * -1.4426950408889634f)); }
struct EpiSwiGLU {
    static constexpr bool PERM = true, AFTER_DRAIN = false, HAS_MID = false, I8 = false;
    bf16_t* O; int ldc;
    __device__ __forceinline__ void operator()(const f32x4 (&acc)[2][2][4][2], const Unit& u, int wr, int wc, int fr, int fq) const {
        const int row0 = u.pm * BM + wr * 64 + fr, col0 = u.pn * HALF + wc * 32 + 8 * fq;
#pragma unroll
        for (int ai = 0; ai < 2; ++ai)
#pragma unroll
            for (int m = 0; m < 4; ++m) { bf16_t* rowp = O + (size_t)(row0 + ai * HALF + m * 16) * ldc + col0;
                const f32x4 g0 = acc[ai][0][m][0], g1 = acc[ai][0][m][1], u0 = acc[ai][1][m][0], u1 = acc[ai][1][m][1];
                u32x4 w; w.x = cvt_pk_bf16(silu_mul(g0[0], u0[0]), silu_mul(g0[1], u0[1])); w.y = cvt_pk_bf16(silu_mul(g0[2], u0[2]), silu_mul(g0[3], u0[3]));
                w.z = cvt_pk_bf16(silu_mul(g1[0], u1[0]), silu_mul(g1[1], u1[1])); w.w = cvt_pk_bf16(silu_mul(g1[2], u1[2]), silu_mul(g1[3], u1[3]));
                *(u32x4*)rowp = w; }
    }
};

struct EpiF32Norm2 {
    static constexpr bool PERM = false, AFTER_DRAIN = false, HAS_MID = true, I8 = false;
    float* C; int ldc; const float* acc2; float inv_cnt, eps;
    __device__ __forceinline__ void mid(f32x4 (&acc)[2][2][4][2], const Unit& u, int wr, int fr) const {
        const int row0 = u.pm * BM + wr * 64 + fr;
#pragma unroll
        for (int ai = 0; ai < 2; ++ai)
#pragma unroll
            for (int m = 0; m < 4; ++m) { const f32x2 s = *(const f32x2*)(acc2 + 2 * (size_t)(row0 + ai * HALF + m * 16));
                const float ratio = __builtin_amdgcn_sqrtf((s.y * inv_cnt + eps) * __builtin_amdgcn_rcpf(s.x * inv_cnt + eps));
#pragma unroll
                for (int bj = 0; bj < 2; ++bj)
#pragma unroll
                    for (int n = 0; n < 2; ++n) acc[ai][bj][m][n] *= ratio; }
    }
    __device__ __forceinline__ void operator()(const f32x4 (&acc)[2][2][4][2], const Unit& u, int wr, int wc, int fr, int fq) const {
        const int row0 = u.pm * BM + wr * 64 + fr, col0 = u.pn * BM + wc * 32 + 4 * fq;
#pragma unroll
        for (int ai = 0; ai < 2; ++ai)
#pragma unroll
            for (int m = 0; m < 4; ++m) { const int row = row0 + ai * HALF + m * 16; float* rowp = C + (size_t)row * ldc + col0;
                const float rsb = __builtin_amdgcn_rsqf(acc2[2 * (size_t)row + 1] * inv_cnt + eps);
#pragma unroll
                for (int bj = 0; bj < 2; ++bj)
#pragma unroll
                    for (int n = 0; n < 2; ++n) *(f32x4*)(rowp + bj * HALF + n * 16) = acc[ai][bj][m][n] * rsb; }
    }
};

struct EpiBf16Norm2 {
    static constexpr bool PERM = true, AFTER_DRAIN = false, HAS_MID = true, I8 = false;
    bf16_t* O; int ldc; const float* acc2; float inv_cnt, eps;
    __device__ __forceinline__ void mid(f32x4 (&acc)[2][2][4][2], const Unit& u, int wr, int fr) const {
        const int row0 = u.pm * BM + wr * 64 + fr;
#pragma unroll
        for (int ai = 0; ai < 2; ++ai)
#pragma unroll
            for (int m = 0; m < 4; ++m) { const f32x2 s = *(const f32x2*)(acc2 + 2 * (size_t)(row0 + ai * HALF + m * 16));
                const float ratio = __builtin_amdgcn_sqrtf((s.y * inv_cnt + eps) * __builtin_amdgcn_rcpf(s.x * inv_cnt + eps));
#pragma unroll
                for (int bj = 0; bj < 2; ++bj)
#pragma unroll
                    for (int n = 0; n < 2; ++n) acc[ai][bj][m][n] *= ratio; }
    }
    __device__ __forceinline__ void operator()(const f32x4 (&acc)[2][2][4][2], const Unit& u, int wr, int wc, int fr, int fq) const {
        const int row0 = u.pm * BM + wr * 64 + fr, col0 = u.pn * BM + wc * 32 + 8 * fq;
#pragma unroll
        for (int ai = 0; ai < 2; ++ai)
#pragma unroll
            for (int m = 0; m < 4; ++m) { const int row = row0 + ai * HALF + m * 16; bf16_t* rowp = O + (size_t)row * ldc + col0;
                const float rsb = __builtin_amdgcn_rsqf(acc2[2 * (size_t)row + 1] * inv_cnt + eps);
#pragma unroll
                for (int bj = 0; bj < 2; ++bj) { const f32x4 v0 = acc[ai][bj][m][0] * rsb, v1 = acc[ai][bj][m][1] * rsb;
                    u32x4 w; w.x = cvt_pk_bf16(v0[0], v0[1]); w.y = cvt_pk_bf16(v0[2], v0[3]); w.z = cvt_pk_bf16(v1[0], v1[1]); w.w = cvt_pk_bf16(v1[2], v1[3]);
                    *(u32x4*)(rowp + bj * HALF) = w; } }
    }
};

typedef int i32x4e __attribute__((ext_vector_type(4)));
__device__ __forceinline__ f32x4 silu_mul4(f32x4 g, f32x4 u) {
    const f32x4 t = g * -1.4426950408889634f;
    const f32x4 d = (f32x4){__builtin_amdgcn_exp2f(t.x), __builtin_amdgcn_exp2f(t.y), __builtin_amdgcn_exp2f(t.z), __builtin_amdgcn_exp2f(t.w)} + 1.0f;
    const f32x4 r = (f32x4){__builtin_amdgcn_rcpf(d.x), __builtin_amdgcn_rcpf(d.y), __builtin_amdgcn_rcpf(d.z), __builtin_amdgcn_rcpf(d.w)};
    return (g * u) * r;
}
struct EpiSwiGLUI8 {
    static constexpr bool PERM = true, AFTER_DRAIN = false, HAS_MID = false, I8 = true;
    bf16_t* O; int ldc; const float* sa; const float* sbmax;
    __device__ __forceinline__ void operator()(const i32x4e (&acc)[2][2][4][2], const Unit& u, int wr, int wc, int fr, int fq) const {
        const int row0 = u.pm * BM + wr * 64 + fr, col0 = u.pn * HALF + wc * 32 + 8 * fq, brow0 = u.pn * BM + wc * 32 + 8 * fq;
        const f32x4 sg0 = *(const f32x4*)(sbmax + brow0) * (1.0f / 127.0f), sg1 = *(const f32x4*)(sbmax + brow0 + 4) * (1.0f / 127.0f);
        const f32x4 su0 = *(const f32x4*)(sbmax + brow0 + HALF) * (1.0f / 127.0f), su1 = *(const f32x4*)(sbmax + brow0 + HALF + 4) * (1.0f / 127.0f);
#pragma unroll
        for (int ai = 0; ai < 2; ++ai)
#pragma unroll
            for (int m = 0; m < 4; ++m) { const int row = row0 + ai * HALF + m * 16; bf16_t* rowp = O + (size_t)row * ldc + col0; const float s = sa[row];
                const f32x4 g0 = __builtin_convertvector(acc[ai][0][m][0], f32x4) * (sg0 * s), g1 = __builtin_convertvector(acc[ai][0][m][1], f32x4) * (sg1 * s);
                const f32x4 u0 = __builtin_convertvector(acc[ai][1][m][0], f32x4) * (su0 * s), u1 = __builtin_convertvector(acc[ai][1][m][1], f32x4) * (su1 * s);
                const f32x4 a0 = silu_mul4(g0, u0), a1 = silu_mul4(g1, u1);
                u32x4 w; w.x = cvt_pk_bf16(a0.x, a0.y); w.y = cvt_pk_bf16(a0.z, a0.w); w.z = cvt_pk_bf16(a1.x, a1.y); w.w = cvt_pk_bf16(a1.z, a1.w);
                *(u32x4*)rowp = w; }
    }
};


struct EpiBf16I8Norm2 {
    static constexpr bool PERM = true, AFTER_DRAIN = false, HAS_MID = true, I8 = true;
    bf16_t* O; int ldc; const float* scl; const float* sbmax;
    __device__ __forceinline__ void mid(i32x4e (&acc)[2][2][4][2], const Unit& u, int wr, int fr) const {
        const int row0 = u.pm * BM + wr * 64 + fr;
#pragma unroll
        for (int ai = 0; ai < 2; ++ai)
#pragma unroll
            for (int m = 0; m < 4; ++m) { const f32x2 s = *(const f32x2*)(scl + 2 * (size_t)(row0 + ai * HALF + m * 16));
                const float ratio = s.x * __builtin_amdgcn_rcpf(s.y);
#pragma unroll
                for (int bj = 0; bj < 2; ++bj)
#pragma unroll
                    for (int n = 0; n < 2; ++n) { const f32x4 t = __builtin_convertvector(acc[ai][bj][m][n], f32x4) * ratio;
                        acc[ai][bj][m][n] = (i32x4e){(int)__builtin_rintf(t[0]), (int)__builtin_rintf(t[1]), (int)__builtin_rintf(t[2]), (int)__builtin_rintf(t[3])}; } }
    }
    __device__ __forceinline__ void operator()(const i32x4e (&acc)[2][2][4][2], const Unit& u, int wr, int wc, int fr, int fq) const {
        const int row0 = u.pm * BM + wr * 64 + fr, col0 = u.pn * BM + wc * 32 + 8 * fq;
        f32x4 sb[2][2];
#pragma unroll
        for (int bj = 0; bj < 2; ++bj)
#pragma unroll
            for (int n = 0; n < 2; ++n) sb[bj][n] = *(const f32x4*)(sbmax + col0 + bj * HALF + 4 * n) * (1.0f / 127.0f);
#pragma unroll
        for (int ai = 0; ai < 2; ++ai)
#pragma unroll
            for (int m = 0; m < 4; ++m) { const int row = row0 + ai * HALF + m * 16; bf16_t* rowp = O + (size_t)row * ldc + col0; const float s = scl[2 * (size_t)row + 1];
#pragma unroll
                for (int bj = 0; bj < 2; ++bj) { const f32x4 v0 = __builtin_convertvector(acc[ai][bj][m][0], f32x4) * (sb[bj][0] * s), v1 = __builtin_convertvector(acc[ai][bj][m][1], f32x4) * (sb[bj][1] * s);
                    u32x4 w; w.x = cvt_pk_bf16(v0[0], v0[1]); w.y = cvt_pk_bf16(v0[2], v0[3]); w.z = cvt_pk_bf16(v1[0], v1[1]); w.w = cvt_pk_bf16(v1[2], v1[3]);
                    *(u32x4*)(rowp + bj * HALF) = w; } }
    }
};

struct EpiBf16I8 {
    static constexpr bool PERM = true, AFTER_DRAIN = false, HAS_MID = false, I8 = true;
    bf16_t* O; int ldc; const float* sa; const float* sbmax;
    __device__ __forceinline__ void operator()(const i32x4e (&acc)[2][2][4][2], const Unit& u, int wr, int wc, int fr, int fq) const {
        const int row0 = u.pm * BM + wr * 64 + fr, col0 = u.pn * BM + wc * 32 + 8 * fq;
        f32x4 sb[2][2];
#pragma unroll
        for (int bj = 0; bj < 2; ++bj)
#pragma unroll
            for (int n = 0; n < 2; ++n) sb[bj][n] = *(const f32x4*)(sbmax + col0 + bj * HALF + 4 * n) * (1.0f / 127.0f);
#pragma unroll
        for (int ai = 0; ai < 2; ++ai)
#pragma unroll
            for (int m = 0; m < 4; ++m) { const int row = row0 + ai * HALF + m * 16; bf16_t* rowp = O + (size_t)row * ldc + col0; const float s = sa[row];
#pragma unroll
                for (int bj = 0; bj < 2; ++bj) { const f32x4 v0 = __builtin_convertvector(acc[ai][bj][m][0], f32x4) * (sb[bj][0] * s), v1 = __builtin_convertvector(acc[ai][bj][m][1], f32x4) * (sb[bj][1] * s);
                    u32x4 w; w.x = cvt_pk_bf16(v0[0], v0[1]); w.y = cvt_pk_bf16(v0[2], v0[3]); w.z = cvt_pk_bf16(v1[0], v1[1]); w.w = cvt_pk_bf16(v1[2], v1[3]);
                    *(u32x4*)(rowp + bj * HALF) = w; } }
    }
};

struct EpiBf16Blk {
    static constexpr bool PERM = true, AFTER_DRAIN = false, HAS_MID = false, I8 = false;
    bf16_t* O; int rows;
    __device__ __forceinline__ void operator()(const f32x4 (&acc)[2][2][4][2], const Unit& u, int wr, int wc, int fr, int fq) const {
        const int row0 = u.pm * BM + wr * 64 + fr, cin = wc * 32 + 8 * fq;
#pragma unroll
        for (int ai = 0; ai < 2; ++ai)
#pragma unroll
            for (int m = 0; m < 4; ++m) {
#pragma unroll
                for (int bj = 0; bj < 2; ++bj) { bf16_t* p = O + ((size_t)(u.pn * 2 + bj) * rows + (row0 + ai * HALF + m * 16)) * 128 + cin;
                    const f32x4 v0 = acc[ai][bj][m][0], v1 = acc[ai][bj][m][1];
                    u32x4 w; w.x = cvt_pk_bf16(v0[0], v0[1]); w.y = cvt_pk_bf16(v0[2], v0[3]); w.z = cvt_pk_bf16(v1[0], v1[1]); w.w = cvt_pk_bf16(v1[2], v1[3]);
                    *(u32x4*)p = w; } }
    }
};

typedef int i32x4 __attribute__((ext_vector_type(4)));
template <bool I8> struct AccSel { typedef f32x4 T; };
template <> struct AccSel<true> { typedef i32x4 T; };
template <bool I8> __device__ __forceinline__ typename AccSel<I8>::T mma16(bf16x8 b, bf16x8 a, typename AccSel<I8>::T c) {
    if constexpr (I8) return __builtin_amdgcn_mfma_i32_16x16x64_i8(__builtin_bit_cast(i32x4, b), __builtin_bit_cast(i32x4, a), c, 0, 0, 0);
    else return __builtin_amdgcn_mfma_f32_16x16x32_bf16(b, a, c, 0, 0, 0);
}
template <class Epi, class Sched, bool ALIGN_EPI = false, bool SP2 = false>
__device__ __forceinline__ void gemm_phase(PG8_LAS unsigned char* lds, const Gemm g, const Sched& S, const Epi& E, const int wave_id  ) {
    unsigned zero_ = 0u; asm volatile("" : "+s"(zero_));
    int tid = wave_id * 64 + (int)__builtin_amdgcn_mbcnt_hi(~0u, __builtin_amdgcn_mbcnt_lo(~0u, zero_)); asm volatile("" : "+v"(tid));
    const int wid = __builtin_amdgcn_readfirstlane(tid >> 6), lane = tid & 63, wr = wid >> 2, wc = wid & 3, fr = lane & 15, fq = lane >> 4;
    const int K = g.K, nt = K / BK;
    unsigned voffA[2], voffB[2];
#pragma unroll
    for (int i = 0; i < 2; ++i) { int R, C; stage_rc(tid * 16 + i * 8192, R, C); const int Rb = Epi::PERM ? ((R & ~31) + perm32(R & 31)) : R;
        voffA[i] = (unsigned)(R * K + C) * 2u; voffB[i] = (unsigned)(Rb * K + C) * 2u; }
    const size_t kstep = (size_t)(BK * 2);
    const size_t hstep = (size_t)HALF * K * 2;
    const size_t tstep = 2 * hstep;
    const unsigned ldsw = (unsigned)wid * 1024u;
    const int aoff = lds_byte(wr * 64 + fr, fq * 8), boff = lds_byte(wc * 32 + fr, fq * 8);
#define PG8_SA(b, h) (((b) * 2 + (h)) * HTB)
#define PG8_SB(b, h) ((4 + (b) * 2 + (h)) * HTB)
#define PG8_STAGE(bufoff, gbase, voff) do { _Pragma("unroll") for (int _i = 0; _i < 2; ++_i) \
        __builtin_amdgcn_global_load_lds((const unsigned*)((const char*)(gbase) + (voff)[_i]), (PG8_LAS unsigned*)(lds + (bufoff) + ldsw + _i * 8192), 16, 0, 0); } while (0)
#define PG8_LDA(dst, b, h) do { _Pragma("unroll") for (int m = 0; m < 4; ++m) _Pragma("unroll") for (int k = 0; k < 2; ++k) dst[m][k] = *(const PG8_LAS bf16x8*)(lds + PG8_SA(b, h) + aoff + m * 2048 + k * 1024); } while (0)
#define PG8_LDB(dst, b, h) do { _Pragma("unroll") for (int n = 0; n < 2; ++n) _Pragma("unroll") for (int k = 0; k < 2; ++k) dst[n][k] = *(const PG8_LAS bf16x8*)(lds + PG8_SB(b, h) + boff + n * 2048 + k * 1024); } while (0)
#define PG8_MMA(ai, bj, At, Bt) do { __builtin_amdgcn_s_setprio(1); _Pragma("unroll") for (int m = 0; m < 4; ++m) _Pragma("unroll") for (int n = 0; n < 2; ++n) _Pragma("unroll") for (int k = 0; k < 2; ++k) \
        acc[ai][bj][m][n] = mma16<Epi::I8>(Bt[n][k], At[m][k], acc[ai][bj][m][n]); __builtin_amdgcn_s_setprio(0); } while (0)
#define PG8_WAIT_V(n) asm volatile("s_waitcnt vmcnt(" #n ")" ::: "memory")
#define PG8_WAIT_L(n) asm volatile("s_waitcnt lgkmcnt(" #n ")" ::: "memory")
#define PG8_BAR __builtin_amdgcn_s_barrier()
#define PG8_SCHED __builtin_amdgcn_sched_barrier(0)
    Unit cur, nxt; int ui = 0;
    if (!S.next(0, cur)) return;
    typedef typename AccSel<Epi::I8>::T acc_t;
    acc_t acc[2][2][4][2];
#pragma unroll
    for (int a = 0; a < 2; ++a)
#pragma unroll
        for (int b = 0; b < 2; ++b)
#pragma unroll
            for (int m = 0; m < 4; ++m)
#pragma unroll
                for (int n = 0; n < 2; ++n) acc[a][b][m][n] = acc_t{};
    bf16x8 At[4][2], B0[2][2], B1[2][2];
    const char* cA = (const char*)g.A + (size_t)cur.pm * tstep; const char* cB = (const char*)g.Bt + (size_t)cur.pn * tstep;
    S.a_ready(cur);
    if constexpr (SP2) {
        PG8_STAGE(PG8_SB(0, 0), cB, voffB); PG8_STAGE(PG8_SB(0, 1), cB + hstep, voffB); PG8_STAGE(PG8_SA(0, 0), cA, voffA); PG8_STAGE(PG8_SA(0, 1), cA + hstep, voffA);
        if (wr == 1) PG8_BAR;
        PG8_WAIT_V(2); PG8_BAR;
        PG8_STAGE(PG8_SB(1, 0), cB + kstep, voffB); PG8_STAGE(PG8_SA(1, 0), cA + kstep, voffA); PG8_STAGE(PG8_SB(1, 1), cB + hstep + kstep, voffB);
        PG8_WAIT_V(6); PG8_BAR;
    } else {
        PG8_STAGE(PG8_SB(0, 0), cB, voffB); PG8_STAGE(PG8_SA(0, 0), cA, voffA); PG8_STAGE(PG8_SB(0, 1), cB + hstep, voffB); PG8_STAGE(PG8_SA(0, 1), cA + hstep, voffA);
        if (wr == 1) PG8_BAR;
        PG8_WAIT_V(4); PG8_BAR;
        PG8_STAGE(PG8_SB(1, 0), cB + kstep, voffB); PG8_STAGE(PG8_SA(1, 0), cA + kstep, voffA); PG8_STAGE(PG8_SB(1, 1), cB + hstep + kstep, voffB);
        PG8_WAIT_V(6); PG8_BAR;
    }
    for (;;) {
        const bool has_next = S.next(ui + 1, nxt);
        const char* nA = has_next ? (const char*)g.A + (size_t)nxt.pm * tstep : cA; const char* nB = has_next ? (const char*)g.Bt + (size_t)nxt.pn * tstep : cB;
        for (int t = 0; t < nt; t += 2) {
            const bool last = (t == nt - 2);
            const char* a1 = cA + (size_t)(t + 1) * kstep;
            const char* a2 = last ? nA : cA + (size_t)(t + 2) * kstep; const char* b2 = last ? nB : cB + (size_t)(t + 2) * kstep;
            const char* a3 = a2 + kstep; const char* b3 = b2 + kstep;
            if (last && has_next) S.a_ready(nxt);
            if constexpr (Epi::HAS_MID) { if (t == (nt >> 1)) { unsigned z2_ = 0u; asm volatile("" : "+s"(z2_)); const int l2_ = (int)__builtin_amdgcn_mbcnt_hi(~0u, __builtin_amdgcn_mbcnt_lo(~0u, z2_)); E.mid(acc, cur, wr, l2_ & 15); } }
            if constexpr (SP2) {
            PG8_LDB(B0, 0, 0); PG8_LDB(B1, 0, 1); PG8_SCHED; PG8_LDA(At, 0, 0); PG8_STAGE(PG8_SA(1, 1), a1 + hstep, voffA);
            PG8_WAIT_V(8); PG8_WAIT_L(0); PG8_BAR; PG8_MMA(0, 0, At, B0); PG8_MMA(0, 1, At, B1); PG8_BAR; PG8_SCHED;
            PG8_LDA(At, 0, 1); PG8_STAGE(PG8_SB(0, 0), b2, voffB); PG8_STAGE(PG8_SB(0, 1), b2 + hstep, voffB); PG8_STAGE(PG8_SA(0, 0), a2, voffA);
            PG8_WAIT_V(8); PG8_WAIT_L(0); PG8_BAR; PG8_MMA(1, 0, At, B0); PG8_MMA(1, 1, At, B1); PG8_BAR; PG8_SCHED;
            PG8_LDB(B0, 1, 0); PG8_LDB(B1, 1, 1); PG8_SCHED; PG8_LDA(At, 1, 0); PG8_STAGE(PG8_SA(0, 1), a2 + hstep, voffA);
            PG8_WAIT_V(8); PG8_WAIT_L(0); PG8_BAR; PG8_MMA(0, 0, At, B0); PG8_MMA(0, 1, At, B1); PG8_BAR; PG8_SCHED;
            PG8_LDA(At, 1, 1); PG8_STAGE(PG8_SB(1, 0), b3, voffB); PG8_STAGE(PG8_SB(1, 1), b3 + hstep, voffB); PG8_STAGE(PG8_SA(1, 0), a3, voffA);
            PG8_WAIT_V(8); PG8_WAIT_L(0); PG8_BAR; PG8_MMA(1, 0, At, B0); PG8_MMA(1, 1, At, B1); PG8_BAR; PG8_SCHED;
            } else {
            PG8_LDB(B0, 0, 0); PG8_SCHED; PG8_LDA(At, 0, 0); PG8_STAGE(PG8_SA(1, 1), a1 + hstep, voffA);
            PG8_WAIT_L(8); PG8_BAR; PG8_WAIT_L(0); PG8_MMA(0, 0, At, B0); PG8_BAR; PG8_SCHED;
            PG8_LDB(B1, 0, 1); PG8_STAGE(PG8_SB(0, 0), b2, voffB);
            PG8_BAR; PG8_WAIT_L(0); PG8_MMA(0, 1, At, B1); PG8_BAR;
            PG8_LDA(At, 0, 1); PG8_STAGE(PG8_SA(0, 0), a2, voffA);
            PG8_BAR; PG8_WAIT_L(0); PG8_MMA(1, 0, At, B0); PG8_BAR; PG8_SCHED;
            PG8_STAGE(PG8_SB(0, 1), b2 + hstep, voffB);
            PG8_WAIT_V(6); PG8_BAR; PG8_MMA(1, 1, At, B1); PG8_BAR;
            PG8_LDB(B0, 1, 0); PG8_SCHED; PG8_LDA(At, 1, 0); PG8_STAGE(PG8_SA(0, 1), a2 + hstep, voffA);
            PG8_WAIT_L(8); PG8_BAR; PG8_WAIT_L(0); PG8_MMA(0, 0, At, B0); PG8_BAR; PG8_SCHED;
            PG8_LDB(B1, 1, 1); PG8_STAGE(PG8_SB(1, 0), b3, voffB);
            PG8_BAR; PG8_WAIT_L(0); PG8_MMA(0, 1, At, B1); PG8_BAR;
            PG8_LDA(At, 1, 1); PG8_STAGE(PG8_SA(1, 0), a3, voffA);
            PG8_BAR; PG8_WAIT_L(0); PG8_MMA(1, 0, At, B0); PG8_BAR; PG8_SCHED;
            PG8_STAGE(PG8_SB(1, 1), b3 + hstep, voffB);
            PG8_WAIT_V(6); PG8_BAR; PG8_MMA(1, 1, At, B1); PG8_BAR;
            }
        }
        if constexpr (ALIGN_EPI) { if (wr == 0) PG8_BAR; }
        if constexpr (!Epi::AFTER_DRAIN) { unsigned z3_ = 0u; asm volatile("" : "+s"(z3_)); const int l3_ = (int)__builtin_amdgcn_mbcnt_hi(~0u, __builtin_amdgcn_mbcnt_lo(~0u, z3_));
            E(acc, cur, wr, wc, l3_ & 15, l3_ >> 4); S.done(cur); }
        if (!has_next) break;
#pragma unroll
        for (int a = 0; a < 2; ++a)
#pragma unroll
            for (int b = 0; b < 2; ++b)
#pragma unroll
                for (int m = 0; m < 4; ++m)
#pragma unroll
                    for (int n = 0; n < 2; ++n) acc[a][b][m][n] = acc_t{};
        cur = nxt; cA = nA; cB = nB; ++ui;
        if constexpr (ALIGN_EPI) { if (wr == 1) PG8_BAR; }
    }
    PG8_WAIT_V(0);
    if constexpr (!ALIGN_EPI) { if (wr == 0) PG8_BAR; }
    PG8_BAR;
    if constexpr (Epi::AFTER_DRAIN) { E.fused(acc, cur, wr, wc, fr, fq, lds, wid, lane); S.done(cur); }
#undef PG8_SA
#undef PG8_SB
#undef PG8_STAGE
#undef PG8_LDA
#undef PG8_LDB
#undef PG8_MMA
#undef PG8_WAIT_V
#undef PG8_WAIT_L
#undef PG8_BAR
#undef PG8_SCHED
}
}
namespace att {
#define ALDS __attribute__((address_space(3)))
using bf16 = __hip_bfloat16;
using bf16x8 = __attribute__((ext_vector_type(8))) short;
using s16x4  = __attribute__((ext_vector_type(4))) short;
using f32x16 = __attribute__((ext_vector_type(16))) float;
using u32x4  = __attribute__((ext_vector_type(4))) unsigned;
constexpr int LDP = 9216;
constexpr int PROWS = 24832;
constexpr int LDO = 4096;
constexpr int META_ROW = 24576;
constexpr int SHM_V = 16384, SHM_K = 16384;
constexpr int OFF_WS = 65536, OFF_TAB = 65536 + 2048, ATT_LDS = OFF_TAB + 15 * 128 * 4;
constexpr float LOG2E = 1.4426950408889634f;
constexpr float THRX = 8.0f;
constexpr float NEG = -1e30f;
#define KSWZ(row, colB) ((row) * 256 + ((colB) ^ (((row) & 15) << 4)))
#define SBAR() __builtin_amdgcn_sched_barrier(0)
__device__ __forceinline__ int crow(int r, int hi) { return (r & 3) + 8 * (r >> 2) + 4 * hi; }
__device__ __forceinline__ unsigned cvtpk(float lo, float hi) { unsigned r; asm volatile("v_cvt_pk_bf16_f32 %0, %1, %2" : "=v"(r) : "v"(lo), "v"(hi)); return r; }

struct UnitP { int seqbase, T, head, blk; };

__device__ __forceinline__ void partialSM(f32x16& p0, f32x16& p1, float& m_reg, float& alpha) {
  float pmax = p0[0];
#pragma unroll
  for (int r = 1; r < 16; ++r) pmax = fmaxf(pmax, p0[r]);
#pragma unroll
  for (int r = 0; r < 16; ++r) pmax = fmaxf(pmax, p1[r]);
  { auto rr = __builtin_amdgcn_permlane32_swap(__float_as_uint(pmax), __float_as_uint(pmax), false, false);
    pmax = fmaxf(__uint_as_float(rr[0]), __uint_as_float(rr[1])); }
  float mn;
  if (__builtin_expect(__all(pmax - m_reg <= THRX), 1)) { mn = m_reg; alpha = 1.f; }
  else { mn = fmaxf(m_reg, pmax); alpha = __builtin_amdgcn_exp2f(m_reg - mn); m_reg = mn; }
#pragma unroll
  for (int r = 0; r < 16; ++r) p0[r] = p0[r] - mn;
#pragma unroll
  for (int r = 0; r < 16; ++r) p1[r] = p1[r] - mn;
#pragma unroll
  for (int r = 0; r < 16; ++r) p0[r] = __builtin_amdgcn_exp2f(p0[r]);
}
__device__ __forceinline__ void finishSM(f32x16& p0, f32x16& p1, float alpha, float& l_reg, bf16x8& pa0, bf16x8& pa1, bf16x8& pa2, bf16x8& pa3) {
#pragma unroll
  for (int r = 0; r < 16; ++r) p1[r] = __builtin_amdgcn_exp2f(p1[r]);
  float ps = 0;
#pragma unroll
  for (int r = 0; r < 16; ++r) ps += p0[r];
#pragma unroll
  for (int r = 0; r < 16; ++r) ps += p1[r];
  { auto rr = __builtin_amdgcn_permlane32_swap(__float_as_uint(ps), __float_as_uint(ps), false, false);
    ps = __uint_as_float(rr[0]) + __uint_as_float(rr[1]); }
  l_reg = l_reg * alpha + ps;
#define PK4(P, BASE, OUT) do { unsigned a0 = cvtpk(P[BASE + 0], P[BASE + 1]), a1 = cvtpk(P[BASE + 2], P[BASE + 3]);   \
    unsigned b0 = cvtpk(P[BASE + 4], P[BASE + 5]), b1 = cvtpk(P[BASE + 6], P[BASE + 7]);                              \
    auto r0 = __builtin_amdgcn_permlane32_swap(a0, b0, false, false); auto r1 = __builtin_amdgcn_permlane32_swap(a1, b1, false, false); \
    u32x4 w = {r0[0], r1[0], r0[1], r1[1]}; OUT = *reinterpret_cast<bf16x8*>(&w); } while (0)
  PK4(p0, 0, pa0); PK4(p0, 8, pa1); PK4(p1, 0, pa2); PK4(p1, 8, pa3);
#undef PK4
}
__device__ __forceinline__ void qkt(f32x16& p0, f32x16& p1, const ALDS char* Ks, const bf16x8* qr, int r32, int hi) {
  p0 = f32x16{}; p1 = f32x16{};
#pragma unroll
  for (int d0 = 0; d0 < 8; ++d0) { int cb = (d0 * 16 + hi * 8) * 2;
    bf16x8 b0 = *(const ALDS bf16x8*)(Ks + KSWZ(r32, cb));
    bf16x8 b1 = *(const ALDS bf16x8*)(Ks + KSWZ(32 + r32, cb));
    p0 = __builtin_amdgcn_mfma_f32_32x32x16_bf16(b0, qr[d0], p0, 0, 0, 0);
    p1 = __builtin_amdgcn_mfma_f32_32x32x16_bf16(b1, qr[d0], p1, 0, 0, 0); }
}
__device__ __forceinline__ int v_st(int k, int c) { const int kk = (k & ~0xC) | ((k & 4) << 1) | ((k & 8) >> 1); return ((kk >> 3) * 4 + (c >> 5)) * 512 + ((kk & 7) * 32 + (c & 31)) * 2; }
__device__ __forceinline__ int v_rd_base(int lane) { return ((lane & 3) << 3) | (((lane >> 2) & 3) << 6) | (((lane >> 4) & 1) << 5) | (((lane >> 5) & 1) << 8); }
constexpr int v_rd_off(int d0, int ks, int half) { return d0 * 512 + ks * 4096 + half * 2048; }
template <int OFF> __device__ __forceinline__ s16x4 tr_read(int vb) {
  s16x4 r; asm volatile("ds_read_b64_tr_b16 %0, %1 offset:%2" : "=&v"(r) : "v"(vb), "i"(OFF) : "memory"); return r;
}
template <int D0> __device__ __forceinline__ void pv_one(f32x16& od, int vb, bf16x8 pa0, bf16x8 pa1, bf16x8 pa2, bf16x8 pa3) {
  const s16x4 l0 = tr_read<v_rd_off(D0, 0, 0)>(vb), h0 = tr_read<v_rd_off(D0, 0, 1)>(vb), l1 = tr_read<v_rd_off(D0, 1, 0)>(vb), h1 = tr_read<v_rd_off(D0, 1, 1)>(vb);
  const s16x4 l2 = tr_read<v_rd_off(D0, 2, 0)>(vb), h2 = tr_read<v_rd_off(D0, 2, 1)>(vb), l3 = tr_read<v_rd_off(D0, 3, 0)>(vb), h3 = tr_read<v_rd_off(D0, 3, 1)>(vb);
  asm volatile("s_waitcnt lgkmcnt(0)" ::: "memory"); SBAR();
#define PK(L, H) (bf16x8){L[0], L[1], L[2], L[3], H[0], H[1], H[2], H[3]}
  od = __builtin_amdgcn_mfma_f32_32x32x16_bf16(pa0, PK(l0, h0), od, 0, 0, 0);
  od = __builtin_amdgcn_mfma_f32_32x32x16_bf16(pa1, PK(l1, h1), od, 0, 0, 0);
  od = __builtin_amdgcn_mfma_f32_32x32x16_bf16(pa2, PK(l2, h2), od, 0, 0, 0);
  od = __builtin_amdgcn_mfma_f32_32x32x16_bf16(pa3, PK(l3, h3), od, 0, 0, 0);
#undef PK
}
__device__ __forceinline__ void pv_d0(f32x16* o, int vb, bf16x8 pa0, bf16x8 pa1, bf16x8 pa2, bf16x8 pa3) {
  pv_one<0>(o[0], vb, pa0, pa1, pa2, pa3); pv_one<1>(o[1], vb, pa0, pa1, pa2, pa3); pv_one<2>(o[2], vb, pa0, pa1, pa2, pa3); pv_one<3>(o[3], vb, pa0, pa1, pa2, pa3);
}
__device__ __forceinline__ float bf_lo(unsigned w) { return __uint_as_float(w << 16); }
__device__ __forceinline__ float bf_hi(unsigned w) { return __uint_as_float(w & 0xffff0000u); }

template <int KIND> __device__ __forceinline__ int tile_row(const UnitP& u, int j) {
  if (j == 0) return META_ROW;
  if (KIND == 0) { const int rows = u.T >> 6; int rs0 = 4 * u.blk - 4; rs0 = rs0 < 0 ? 0 : (rs0 > rows - 8 ? rows - 8 : rs0);
    int kr = rs0 + j - 1; kr = kr > rows - 1 ? rows - 1 : kr; return u.seqbase + 64 * kr; }
  else { int ks = 64 * u.blk + 64 * (j - 3); ks = ks < 0 ? 0 : (ks > u.T - 64 ? u.T - 64 : ks); return u.seqbase + ks; }
}


__device__ __forceinline__ void qkt1(f32x16& p, const ALDS char* Ks, const bf16x8* qr, int koff  , int r32, int hi) {
  p = f32x16{};
#pragma unroll
  for (int d0 = 0; d0 < 8; ++d0) { const int cb = (d0 * 16 + hi * 8) * 2;
    const bf16x8 b0 = *(const ALDS bf16x8*)(Ks + koff + (cb ^ ((r32 & 15) << 4)));
    p = __builtin_amdgcn_mfma_f32_32x32x16_bf16(b0, qr[d0], p, 0, 0, 0); }
}
__device__ __forceinline__ void partialSM1(f32x16& p, float& m_reg, float& alpha) {
  float pmax = p[0];
#pragma unroll
  for (int r = 1; r < 16; ++r) pmax = fmaxf(pmax, p[r]);
  { auto rr = __builtin_amdgcn_permlane32_swap(__float_as_uint(pmax), __float_as_uint(pmax), false, false);
    pmax = fmaxf(__uint_as_float(rr[0]), __uint_as_float(rr[1])); }
  float mn;
  if (__builtin_expect(__all(pmax - m_reg <= THRX), 1)) { mn = m_reg; alpha = 1.f; }
  else { mn = fmaxf(m_reg, pmax); alpha = __builtin_amdgcn_exp2f(m_reg - mn); m_reg = mn; }
#pragma unroll
  for (int r = 0; r < 16; ++r) p[r] = p[r] - mn;
#pragma unroll
  for (int r = 0; r < 8; ++r) p[r] = __builtin_amdgcn_exp2f(p[r]);
}
__device__ __forceinline__ void finishSM1(f32x16& p, float alpha, float& l_reg, bf16x8& pa0, bf16x8& pa1) {
#pragma unroll
  for (int r = 8; r < 16; ++r) p[r] = __builtin_amdgcn_exp2f(p[r]);
  float ps = 0;
#pragma unroll
  for (int r = 0; r < 16; ++r) ps += p[r];
  { auto rr = __builtin_amdgcn_permlane32_swap(__float_as_uint(ps), __float_as_uint(ps), false, false);
    ps = __uint_as_float(rr[0]) + __uint_as_float(rr[1]); }
  l_reg = l_reg * alpha + ps;
#define PK4(P, BASE, OUT) do { unsigned a0 = cvtpk(P[BASE + 0], P[BASE + 1]), a1 = cvtpk(P[BASE + 2], P[BASE + 3]);   \
    unsigned b0 = cvtpk(P[BASE + 4], P[BASE + 5]), b1 = cvtpk(P[BASE + 6], P[BASE + 7]);                              \
    auto r0 = __builtin_amdgcn_permlane32_swap(a0, b0, false, false); auto r1 = __builtin_amdgcn_permlane32_swap(a1, b1, false, false); \
    u32x4 w = {r0[0], r1[0], r0[1], r1[1]}; OUT = *reinterpret_cast<bf16x8*>(&w); } while (0)
  PK4(p, 0, pa0); PK4(p, 8, pa1);
#undef PK4
}
template <int D0> __device__ __forceinline__ void pv2_one(f32x16& od, int vbA, int vbB, bf16x8 pa0, bf16x8 pa1) {
  const s16x4 l0 = tr_read<D0 * 512>(vbA), h0 = tr_read<D0 * 512 + 2048>(vbA), l1 = tr_read<D0 * 512>(vbB), h1 = tr_read<D0 * 512 + 2048>(vbB);
  asm volatile("s_waitcnt lgkmcnt(0)" ::: "memory"); SBAR();
#define PK(L, H) (bf16x8){L[0], L[1], L[2], L[3], H[0], H[1], H[2], H[3]}
  od = __builtin_amdgcn_mfma_f32_32x32x16_bf16(pa0, PK(l0, h0), od, 0, 0, 0);
  od = __builtin_amdgcn_mfma_f32_32x32x16_bf16(pa1, PK(l1, h1), od, 0, 0, 0);
#undef PK
}
__device__ __forceinline__ void pv2(f32x16* o, int vbA, int vbB, bf16x8 pa0, bf16x8 pa1) {
  pv2_one<0>(o[0], vbA, vbB, pa0, pa1); pv2_one<1>(o[1], vbA, vbB, pa0, pa1); pv2_one<2>(o[2], vbA, vbB, pa0, pa1); pv2_one<3>(o[3], vbA, vbB, pa0, pa1);
}

constexpr int RB = 32768, NRB = 3, D_OFF_WS = NRB * RB, D_OFF_TAB = D_OFF_WS + 2048, D_ATT_LDS = D_OFF_TAB + 15 * 128 * 4;
struct DmaSrc { const bf16* k[2]; const bf16* v[2]; };
__device__ __forceinline__ DmaSrc dma_src(const bf16* P, int kcol, int vcol, int wid, int lane) {
  DmaSrc s;
#pragma unroll
  for (int i = 0; i < 2; ++i) {
    const int piece = i * 8 + wid;
    { const int row = piece * 4 + (lane >> 4), chunk = (lane & 15) ^ (row & 15); s.k[i] = P + ((size_t)(kcol >> 7) * PROWS + row) * 128 + chunk * 8; }
    { const int sub = piece * 2 + (lane >> 5), kk = (sub >> 2) * 8 + ((lane >> 2) & 7), c = (sub & 3) * 32 + (lane & 3) * 8;
      const int k = (kk & ~0xC) | ((kk & 4) << 1) | ((kk & 8) >> 1); s.v[i] = P + ((size_t)(vcol >> 7) * PROWS + k) * 128 + c; }
  }
  return s;
}
#define DMA_WAIT_BAR(last) do { if (last) asm volatile("s_waitcnt vmcnt(0) lgkmcnt(0)" ::: "memory"); else asm volatile("s_waitcnt vmcnt(4) lgkmcnt(0)" ::: "memory"); \
    __builtin_amdgcn_s_barrier(); asm volatile("" ::: "memory"); } while (0)
#define PK4(P, BASE, OUT) do { unsigned a0 = cvtpk(P[BASE + 0], P[BASE + 1]), a1 = cvtpk(P[BASE + 2], P[BASE + 3]);   \
    unsigned b0 = cvtpk(P[BASE + 4], P[BASE + 5]), b1 = cvtpk(P[BASE + 6], P[BASE + 7]);                              \
    auto r0 = __builtin_amdgcn_permlane32_swap(a0, b0, false, false); auto r1 = __builtin_amdgcn_permlane32_swap(a1, b1, false, false); \
    u32x4 w = {r0[0], r1[0], r0[1], r1[1]}; OUT = *reinterpret_cast<bf16x8*>(&w); } while (0)
#define ATT_EPILOGUE(OROW_EXPR, SSQ_IDX) do { \
  unsigned ze_ = 0u; asm volatile("" : "+s"(ze_)); const int lane_e = (int)__builtin_amdgcn_mbcnt_hi(~0u, __builtin_amdgcn_mbcnt_lo(~0u, ze_)), r32e = lane_e & 31, hie = lane_e >> 5; \
  if (hie == 0) li_l[r32e] = l_reg; asm volatile("s_waitcnt lgkmcnt(0)" ::: "memory"); \
  ALDS unsigned short* stg = (ALDS unsigned short*)(lds + wid * 8192); \
  _Pragma("unroll") for (int r = 0; r < 16; ++r) { const int orow = crow(r, hie); const float rl = __builtin_amdgcn_rcpf(li_l[orow]); \
    _Pragma("unroll") for (int d0 = 0; d0 < 4; ++d0) stg[orow * 128 + d0 * 32 + r32e] = (unsigned short)(cvtpk(o[d0][r] * rl, 0.f) & 0xffffu); } \
  asm volatile("s_waitcnt lgkmcnt(0)" ::: "memory"); \
  const int q = lane_e >> 1, half = lane_e & 1; float ss = 0.f; \
  const size_t orow_g = (size_t)(OROW_EXPR); \
  bf16* og = O + orow_g * LDO + ocol + half * 64; \
  _Pragma("unroll") for (int i = 0; i < 8; ++i) { const u32x4 v = *(const ALDS u32x4*)(stg + q * 128 + half * 64 + i * 8); \
    ss += bf_lo(v.x) * bf_lo(v.x) + bf_hi(v.x) * bf_hi(v.x) + bf_lo(v.y) * bf_lo(v.y) + bf_hi(v.y) * bf_hi(v.y) \
        + bf_lo(v.z) * bf_lo(v.z) + bf_hi(v.z) * bf_hi(v.z) + bf_lo(v.w) * bf_lo(v.w) + bf_hi(v.w) * bf_hi(v.w); \
    *(u32x4*)(og + i * 8) = v; } \
  ss += __builtin_bit_cast(float, __builtin_amdgcn_update_dpp(0, __builtin_bit_cast(int, ss), 0xB1, 0xF, 0xF, false)); \
  if (half == 0 && do_ssq) atomicAdd(ssq + orow_g * 2 + (SSQ_IDX), ss); } while (0)


constexpr int P_VOFF = 0, P_KOFF = 4 * 16384, P_OFF_WS = P_KOFF + 3 * 16384, P_OFF_TAB = P_OFF_WS + 2048, P_ATT_LDS = P_OFF_TAB + 15 * 128 * 4;
__device__ __forceinline__ void dma_tile_kv(const DmaSrc& s, size_t rowoff, ALDS char* vslot, ALDS char* kslot, int wid) {
#pragma unroll
  for (int i = 0; i < 2; ++i) {
    __builtin_amdgcn_global_load_lds((const unsigned*)(s.v[i] + rowoff), (ALDS unsigned*)(vslot + (i * 8 + wid) * 1024), 16, 0, 0);
    __builtin_amdgcn_global_load_lds((const unsigned*)(s.k[i] + rowoff), (ALDS unsigned*)(kslot + (i * 8 + wid) * 1024), 16, 0, 0);
  }
}
#define RESC4(a) do { if (__any((a) < 1.f)) { if (hi == 0) al_l[r32] = (a); asm volatile("s_waitcnt lgkmcnt(0)" ::: "memory"); \
    _Pragma("unroll") for (int r = 0; r < 16; ++r) { const float a_ = al_l[crow(r, hi)]; _Pragma("unroll") for (int d = 0; d < 4; ++d) o[d][r] *= a_; } } } while (0)
#define STEP_ENTER(TR, j) do { DMA_WAIT_BAR((j) + 1 >= NT); \
    if ((j) + 2 < NT) { const int k2_ = k3 == 0 ? 2 : k3 - 1; dma_tile_kv(src, (size_t)TR(u, (j) + 2) * 128, lds + P_VOFF + (((j) + 2) & 3) * 16384, lds + P_KOFF + k2_ * 16384, wid); } } while (0)
#define STEP_LEAVE() do { k3 = k3 == 2 ? 0 : k3 + 1; } while (0)

__device__ __forceinline__ void attn_unit_na4(const UnitP u, const bf16* __restrict__ P, bf16* __restrict__ O, float* __restrict__ ssq,
                                              const float* __restrict__ rpb, ALDS char* lds, const int wave_id, const bool do_ssq = true) {
  constexpr int NT = 12;
  unsigned zero_ = 0u; asm volatile("" : "+s"(zero_));
  int tid = wave_id * 64 + (int)__builtin_amdgcn_mbcnt_hi(~0u, __builtin_amdgcn_mbcnt_lo(~0u, zero_)); asm volatile("" : "+v"(tid));
  const int wid = __builtin_amdgcn_readfirstlane(tid >> 6), lane = tid & 63, r32 = lane & 31, hi = lane >> 5;
  ALDS float* wsf = (ALDS float*)(lds + P_OFF_WS) + wid * 64; ALDS float* li_l = wsf; ALDS float* al_l = wsf + 32;
  ALDS float* tab = (ALDS float*)(lds + P_OFF_TAB);
  const int rows = u.T >> 6, rp = wid >> 2, cg = wid & 3, R0 = 4 * u.blk + 2 * rp;
  const int kbA = cg == 0 ? 0 : cg - 1, kbB = cg == 0 ? 3 : cg;
  const int qi = r32 & 15, Rq = R0 + (r32 >> 4);
  const int qc = cg == 0 ? (qi < 8 ? qi : 48 + qi) : 16 * cg - 8 + qi;
  const int qrow = u.seqbase + 64 * Rq + qc;
  const int kcol = 2048 + 128 * u.head, vcol = 4096 + 128 * u.head, ocol = 128 * u.head;
  int rs0 = 4 * u.blk - 4; rs0 = rs0 < 0 ? 0 : (rs0 > rows - 8 ? rows - 8 : rs0);
  const int koffT = ((r32 < 16 ? 16 * kbA : 16 * kbB - 16) + r32) * 256;
  const DmaSrc src = dma_src(P, kcol, vcol, wid, lane);
  dma_tile_kv(src, (size_t)tile_row<0>(u, 0) * 128, lds + P_VOFF, lds + P_KOFF, wid); dma_tile_kv(src, (size_t)tile_row<0>(u, 1) * 128, lds + P_VOFF + 16384, lds + P_KOFF + 16384, wid);
  for (int idx = tid; idx < 15 * 128; idx += 512) { const int ir = idx >> 7, e = (idx & 127) - 48;
    tab[idx] = (e >= 0 && e <= 30) ? rpb[u.head * 465 + ir * 31 + e] * LOG2E : 0.f; }
  float m_reg = -1e30f, l_reg = 0; f32x16 o[4] = {}; bf16x8 qr[8];
  { const bf16* Qw = P + ((size_t)u.head * PROWS + qrow) * 128 + hi * 8;
#pragma unroll
    for (int d0 = 0; d0 < 8; ++d0) qr[d0] = *reinterpret_cast<const bf16x8*>(Qw + d0 * 16); }
#pragma unroll
  for (int d0 = 0; d0 < 8; ++d0) asm volatile("" :: "v"(qr[d0]));
  asm volatile("s_waitcnt vmcnt(0)" ::: "memory");
  const int vrd = (int)(unsigned)(__SIZE_TYPE__)lds + P_VOFF + v_rd_base(lane);
#define APPLY4(PP, j) do { int qc_ = qc, Rq_ = Rq; asm volatile("" : "+v"(qc_), "+v"(Rq_)); \
    const int kr_ = rs0 + (j) - 1; int rsR_ = Rq_ - 4; rsR_ = rsR_ < 0 ? 0 : (rsR_ > rows - 8 ? rows - 8 : rsR_); int cs_ = qc_ - 8; cs_ = cs_ < 0 ? 0 : (cs_ > 48 ? 48 : cs_); \
    const bool rv_ = (kr_ < rows) && (kr_ >= rsR_) && (kr_ < rsR_ + 8); \
    int ir_ = kr_ - Rq_ + 7; ir_ = ir_ < 0 ? 0 : (ir_ > 14 ? 14 : ir_); \
    const ALDS float* tA_ = tab + ir_ * 128 + (63 - qc_ + 16 * kbA + 4 * hi); const ALDS float* tB_ = tA_ + 16 * (kbB - kbA); \
    const int uA_ = rv_ ? 16 * kbA + 4 * hi - cs_ : 4096, uB_ = rv_ ? 16 * kbB + 4 * hi - cs_ : 4096; \
    _Pragma("unroll") for (int r = 0; r < 8; ++r) { const int of_ = (r & 3) + 8 * (r >> 2); PP[r] = ((unsigned)(of_ + uA_) < 16u) ? PP[r] + tA_[of_] : NEG; } \
    _Pragma("unroll") for (int r = 8; r < 16; ++r) { const int of_ = (r & 3) + 8 * ((r >> 2) - 2); PP[r] = ((unsigned)(of_ + uB_) < 16u) ? PP[r] + tB_[of_] : NEG; } } while (0)
  f32x16 pA, pB; float alA, alB; bf16x8 pa0, pa1;
  int k3 = 0;
  STEP_ENTER(tile_row<0>, 0);
  qkt1(pA, lds + P_KOFF, qr, r32 * 256, r32, hi);
#pragma unroll
  for (int r = 8; r < 16; ++r) pA[r] = NEG;
  partialSM1(pA, m_reg, alA);
  STEP_LEAVE();
#pragma unroll 1
  for (int j = 1; j + 1 < NT; j += 2) {
    STEP_ENTER(tile_row<0>, j);
    { const int vb = vrd + ((j - 1) & 3) * 16384;
      SBAR(); qkt1(pB, lds + P_KOFF + k3 * 16384, qr, koffT, r32, hi);
      finishSM1(pA, alA, l_reg, pa0, pa1); SBAR();
      if (j == 1) pv2(o, vb, vb + 4096, pa0, pa1); else pv2(o, vb + kbA * 4096, vb + kbB * 4096, pa0, pa1);
      APPLY4(pB, j); partialSM1(pB, m_reg, alB);
      RESC4(alB); }
    STEP_LEAVE();
    STEP_ENTER(tile_row<0>, j + 1);
    { const int vb = vrd + (j & 3) * 16384;
      SBAR(); qkt1(pA, lds + P_KOFF + k3 * 16384, qr, koffT, r32, hi);
      finishSM1(pB, alB, l_reg, pa0, pa1); SBAR();
      pv2(o, vb + kbA * 4096, vb + kbB * 4096, pa0, pa1);
      APPLY4(pA, j + 1); partialSM1(pA, m_reg, alA);
      RESC4(alA); }
    STEP_LEAVE();
  }
  STEP_ENTER(tile_row<0>, NT - 1);
  { const int vb = vrd + ((NT - 2) & 3) * 16384, vbl = vrd + ((NT - 1) & 3) * 16384;
    SBAR(); qkt1(pB, lds + P_KOFF + k3 * 16384, qr, koffT, r32, hi);
    finishSM1(pA, alA, l_reg, pa0, pa1); SBAR();
    pv2(o, vb + kbA * 4096, vb + kbB * 4096, pa0, pa1);
    APPLY4(pB, NT - 1); partialSM1(pB, m_reg, alB);
    RESC4(alB);
    finishSM1(pB, alB, l_reg, pa0, pa1); SBAR();
    pv2(o, vbl + kbA * 4096, vbl + kbB * 4096, pa0, pa1); }
#undef APPLY4
  asm volatile("s_waitcnt lgkmcnt(0)" ::: "memory"); __builtin_amdgcn_s_barrier(); asm volatile("" ::: "memory");
  ATT_EPILOGUE(u.seqbase + 64 * (R0 + (q >> 4)) + (cg == 0 ? ((q & 15) < 8 ? (q & 15) : 48 + (q & 15)) : 16 * cg - 8 + (q & 15)), 0);
  asm volatile("s_waitcnt lgkmcnt(0)" ::: "memory"); __builtin_amdgcn_s_barrier(); asm volatile("" ::: "memory");
}
__device__ __forceinline__ void attn_unit_sw4(const UnitP u, const bf16* __restrict__ P, bf16* __restrict__ O, float* __restrict__ ssq,
                                              const float* __restrict__ sinkp, ALDS char* lds, const int wave_id, const bool do_ssq = true) {
  constexpr int NT = 6;
  unsigned zero_ = 0u; asm volatile("" : "+s"(zero_));
  int tid = wave_id * 64 + (int)__builtin_amdgcn_mbcnt_hi(~0u, __builtin_amdgcn_mbcnt_lo(~0u, zero_)); asm volatile("" : "+v"(tid));
  const int wid = __builtin_amdgcn_readfirstlane(tid >> 6), lane = tid & 63, r32 = lane & 31, hi = lane >> 5;
  ALDS float* wsf = (ALDS float*)(lds + P_OFF_WS) + wid * 64; ALDS float* li_l = wsf; ALDS float* al_l = wsf + 32;
  ALDS float* tab = (ALDS float*)(lds + P_OFF_TAB);
  const int hq = 4 * u.head + (wid >> 1), tq = 64 * u.blk + 32 * (wid & 1) + r32;
  const int orow0 = u.seqbase + 64 * u.blk + 32 * (wid & 1), qrow = orow0 + r32;
  const int kcol = 8192 + 128 * u.head, vcol = 8704 + 128 * u.head, ocol = 2048 + 128 * hq;
  const float slope2 = __builtin_amdgcn_exp2f(-0.5f * (float)(hq + 1)) * LOG2E, sink2 = sinkp[hq] * LOG2E;
  const DmaSrc src = dma_src(P, kcol, vcol, wid, lane);
  dma_tile_kv(src, (size_t)tile_row<1>(u, 0) * 128, lds + P_VOFF, lds + P_KOFF, wid); dma_tile_kv(src, (size_t)tile_row<1>(u, 1) * 128, lds + P_VOFF + 16384, lds + P_KOFF + 16384, wid);
  for (int idx = tid; idx < 4 * 384; idx += 512) { const int hh = idx / 384, i = idx - hh * 384; int d = 191 - i; d = d < 0 ? -d : d;
    tab[idx] = (d <= 128) ? -(__builtin_amdgcn_exp2f(-0.5f * (float)(4 * u.head + hh + 1)) * LOG2E) * (float)d : NEG; }
  float m_reg = -1e30f, l_reg = 0; f32x16 o[4] = {}; bf16x8 qr[8];
  { const bf16* Qw = P + ((size_t)(48 + hq) * PROWS + qrow) * 128 + hi * 8;
#pragma unroll
    for (int d0 = 0; d0 < 8; ++d0) qr[d0] = *reinterpret_cast<const bf16x8*>(Qw + d0 * 16); }
#pragma unroll
  for (int d0 = 0; d0 < 8; ++d0) asm volatile("" :: "v"(qr[d0]));
  asm volatile("s_waitcnt vmcnt(0)" ::: "memory");
  const int vrd = (int)(unsigned)(__SIZE_TYPE__)lds + P_VOFF + v_rd_base(lane);
#define APPLYS(P0, P1, j) do { const int ks_ = 64 * u.blk + 64 * ((j) - 3); \
    if (ks_ >= 0 && ks_ < u.T) { int tq_ = tq; asm volatile("" : "+v"(tq_)); const ALDS float* tb_ = tab + (wid >> 1) * 384 + (191 - (tq_ - ks_ - 4 * hi)); \
      _Pragma("unroll") for (int r = 0; r < 16; ++r) { const int kc0_ = (r & 3) + 8 * (r >> 2); P0[r] = P0[r] + tb_[kc0_]; P1[r] = P1[r] + tb_[kc0_ + 32]; } } \
    else { _Pragma("unroll") for (int r = 0; r < 16; ++r) { P0[r] = NEG; P1[r] = NEG; } } } while (0)
  f32x16 pA0, pA1, pB0, pB1; float alA, alB; bf16x8 pa0, pa1, pa2, pa3;
  int k3 = 0;
  const bool lead = wid < 4;
#define SW_STEP_A(N0, N1, alN, O0, O1, alO, vb, jj) do { SBAR(); qkt(N0, N1, lds + P_KOFF + k3 * 16384, qr, r32, hi); \
      finishSM(O0, O1, alO, l_reg, pa0, pa1, pa2, pa3); SBAR(); \
      pv_d0(o, vb, pa0, pa1, pa2, pa3); \
      APPLYS(N0, N1, jj); partialSM(N0, N1, m_reg, alN); \
      RESC4(alN); } while (0)
#define SW_STEP_B(N0, N1, alN, O0, O1, alO, vb, jj) do { SBAR(); finishSM(O0, O1, alO, l_reg, pa0, pa1, pa2, pa3); SBAR(); \
      qkt(N0, N1, lds + P_KOFF + k3 * 16384, qr, r32, hi); SBAR(); \
      APPLYS(N0, N1, jj); partialSM(N0, N1, m_reg, alN); SBAR(); \
      pv_d0(o, vb, pa0, pa1, pa2, pa3); \
      RESC4(alN); } while (0)
  STEP_ENTER(tile_row<1>, 0);
  qkt(pA0, pA1, lds + P_KOFF, qr, r32, hi);
#pragma unroll
  for (int r = 0; r < 8; ++r) { const int md_ = 16 + tq - crow(r, hi); pA0[r] = pA0[r] - slope2 * (float)(md_ > 128 ? 128 : md_); }
#pragma unroll
  for (int r = 8; r < 16; ++r) pA0[r] = NEG;
#pragma unroll
  for (int r = 0; r < 16; ++r) pA1[r] = NEG;
  partialSM(pA0, pA1, m_reg, alA);
  STEP_LEAVE();
  if (lead) {
#pragma unroll 1
    for (int j = 1; j + 1 < NT; j += 2) {
      STEP_ENTER(tile_row<1>, j);
      { const int vb = vrd + ((j - 1) & 3) * 16384; SW_STEP_A(pB0, pB1, alB, pA0, pA1, alA, vb, j); }
      STEP_LEAVE();
      STEP_ENTER(tile_row<1>, j + 1);
      { const int vb = vrd + (j & 3) * 16384; SW_STEP_A(pA0, pA1, alA, pB0, pB1, alB, vb, j + 1); }
      STEP_LEAVE();
    }
    STEP_ENTER(tile_row<1>, NT - 1);
    { const int vb = vrd + ((NT - 2) & 3) * 16384, vbl = vrd + ((NT - 1) & 3) * 16384;
      SW_STEP_A(pB0, pB1, alB, pA0, pA1, alA, vb, NT - 1);
      finishSM(pB0, pB1, alB, l_reg, pa0, pa1, pa2, pa3); SBAR();
      pv_d0(o, vbl, pa0, pa1, pa2, pa3); }
  } else {
#pragma unroll 1
    for (int j = 1; j + 1 < NT; j += 2) {
      STEP_ENTER(tile_row<1>, j);
      { const int vb = vrd + ((j - 1) & 3) * 16384; SW_STEP_B(pB0, pB1, alB, pA0, pA1, alA, vb, j); }
      STEP_LEAVE();
      STEP_ENTER(tile_row<1>, j + 1);
      { const int vb = vrd + (j & 3) * 16384; SW_STEP_B(pA0, pA1, alA, pB0, pB1, alB, vb, j + 1); }
      STEP_LEAVE();
    }
    STEP_ENTER(tile_row<1>, NT - 1);
    { const int vb = vrd + ((NT - 2) & 3) * 16384, vbl = vrd + ((NT - 1) & 3) * 16384;
      SW_STEP_B(pB0, pB1, alB, pA0, pA1, alA, vb, NT - 1);
      finishSM(pB0, pB1, alB, l_reg, pa0, pa1, pa2, pa3); SBAR();
      pv_d0(o, vbl, pa0, pa1, pa2, pa3); }
  }
#undef APPLYS
#undef SW_STEP_A
#undef SW_STEP_B
  l_reg += __builtin_amdgcn_exp2f(sink2 - m_reg);
  asm volatile("s_waitcnt lgkmcnt(0)" ::: "memory"); __builtin_amdgcn_s_barrier(); asm volatile("" ::: "memory");
  ATT_EPILOGUE(orow0 + q, 1);
  asm volatile("s_waitcnt lgkmcnt(0)" ::: "memory"); __builtin_amdgcn_s_barrier(); asm volatile("" ::: "memory");
}
#undef RESC4
#undef STEP_ENTER
#undef STEP_LEAVE
#undef PK4
#undef DMA_WAIT_BAR
#undef ATT_EPILOGUE
#undef KSWZ
#undef SBAR
}

#define GAS __attribute__((address_space(1)))
#define LAS __attribute__((address_space(3)))
typedef unsigned short bf16;
typedef unsigned v4u __attribute__((ext_vector_type(4)));
typedef float f32x4 __attribute__((ext_vector_type(4)));
typedef short bf16x8 __attribute__((ext_vector_type(8)));
typedef GAS unsigned gu32;
typedef GAS unsigned long long gu64;
#define RLX_AGENT __ATOMIC_RELAXED, __HIP_MEMORY_SCOPE_AGENT
#define LDS_WAIT() asm volatile("s_waitcnt lgkmcnt(0)" ::: "memory")
#define VM_WAIT() asm volatile("s_waitcnt vmcnt(0)" ::: "memory")
__device__ __forceinline__ unsigned long long rt() { return __builtin_amdgcn_s_memrealtime(); }
__device__ __forceinline__ unsigned f2bf(float f) { unsigned u = __builtin_bit_cast(unsigned, f); return (u + 0x7fffu + ((u >> 16) & 1u)) >> 16; }
__device__ __forceinline__ unsigned pk2(float lo, float hi) { return f2bf(lo) | (f2bf(hi) << 16); }

#define XB_TMO      128
#define XB_XCNT(j)  (256  + 64 * (j))
#define XB_XSUB(j)  (1280 + 64 * (j))
#define XB_XGEN(j)  (2304 + 64 * (j))
#define XB_TOP      3328
#define XB_TOPGEN   3392
#define XCD_BAR_WORDS 3456
#define XB_SPIN_CAP (1u << 18)

__device__ __forceinline__ unsigned xb_ld(unsigned* p)              { return __hip_atomic_load(p, __ATOMIC_RELAXED, __HIP_MEMORY_SCOPE_AGENT); }
__device__ __forceinline__ unsigned xb_add(unsigned* p, unsigned v) { return __hip_atomic_fetch_add(p, v, __ATOMIC_RELAXED, __HIP_MEMORY_SCOPE_AGENT); }
__device__ __forceinline__ unsigned xb_xcc_id() { return (unsigned)__builtin_amdgcn_s_getreg((3 << 11) | 20) & 0xFu; }
#define XB_SPIN(cond, bar) do { unsigned _sp = 0; while (cond) { __builtin_amdgcn_s_sleep(1); \
    if ((++_sp & 255u) == 0u) { if (xb_ld(&(bar)[XB_TMO])) break; if (_sp > XB_SPIN_CAP) { atomicAdd(&(bar)[XB_TMO], 1u); break; } } } } while (0)

struct XcdBarrier {
    unsigned* bar; unsigned x; bool t0;
    volatile LAS unsigned* st;
};

__device__ __forceinline__ XcdBarrier xcd_barrier_post(unsigned* bar, volatile LAS unsigned* st, bool t0) {
    XcdBarrier b; b.bar = bar; b.x = xb_xcc_id(); b.st = st; b.t0 = t0;
    if (t0) (void)xb_add(&bar[XB_XCNT(b.x)], 1u);
    return b;
}
__device__ __forceinline__ void xcd_barrier_complete(unsigned* bar, unsigned x, unsigned& nloc, unsigned& nx) {
    const unsigned G = gridDim.x * gridDim.y * gridDim.z;
    unsigned sum, cnt, mine, sp = 0u;
    for (;;) {
        sum = 0u; cnt = 0u; mine = 0u;
#pragma unroll
        for (unsigned j = 0; j < 16; ++j) { const unsigned c = xb_ld(&bar[XB_XCNT(j)]); sum += c; cnt += (c > 0u) ? 1u : 0u; mine = (j == x) ? c : mine; }
        if (sum == G) break;
        __builtin_amdgcn_s_sleep(1);
        if ((++sp & 255u) == 0u) { if (xb_ld(&bar[XB_TMO])) break; if (sp > XB_SPIN_CAP) { atomicAdd(&bar[XB_TMO], 1u); break; } }
    }
    nloc = mine > 0u ? mine : 1u; nx = cnt > 0u ? cnt : 1u;
}

__device__ __forceinline__ void xcd_barrier(const XcdBarrier& b) {
    asm volatile("s_waitcnt vmcnt(0)" ::: "memory");
    __syncthreads();
    if (b.t0) {
        unsigned* bar = b.bar;
        __builtin_amdgcn_s_waitcnt(0);
        unsigned nloc = b.st[0], nx = b.st[1];
        if (nloc == 0u) { xcd_barrier_complete(bar, b.x, nloc, nx); b.st[0] = nloc; b.st[1] = nx; }
        const unsigned old = xb_add(&bar[XB_XSUB(b.x)], 1u);
        const unsigned gen = old / nloc;
        if (old + 1u == (gen + 1u) * nloc) {
            __builtin_amdgcn_fence(__ATOMIC_RELEASE, "agent");
            asm volatile("s_waitcnt vmcnt(0)" ::: "memory");
            const unsigned og = xb_add(&bar[XB_TOP], 1u);
            const unsigned tg = og / nx;
            if (og + 1u == (tg + 1u) * nx) xb_add(&bar[XB_TOPGEN], 1u);
            else XB_SPIN(xb_ld(&bar[XB_TOPGEN]) == tg, bar);
            __builtin_amdgcn_fence(__ATOMIC_ACQUIRE, "agent");
            xb_add(&bar[XB_XGEN(b.x)], 1u);
            asm volatile("s_waitcnt vmcnt(0)" ::: "memory");
        } else {
            XB_SPIN(xb_ld(&bar[XB_XGEN(b.x)]) == gen, bar);
            __builtin_amdgcn_fence(__ATOMIC_ACQUIRE, "agent");
            asm volatile("s_waitcnt vmcnt(0)" ::: "memory");
        }
    }
    __syncthreads();
}
#ifndef P4_INT8
#define P4_INT8 1
#endif
#ifndef WGM_P7
#define WGM_P7 2
#endif
#ifndef WGM_P1
#define WGM_P1 4
#endif
#ifndef WGM_P4
#define WGM_P4 4
#endif
#ifndef REP_P2
#define REP_P2 1
#endif
#ifndef REP_P6
#define REP_P6 1
#endif
#ifndef REP_P0
#define REP_P0 1
#endif
#ifndef REP_NA
#define REP_NA 1
#endif
#ifndef REP_SW
#define REP_SW 1
#endif
constexpr int NWAVES = 8;
constexpr int DM = 4096, TP = 16384, TS = 4096, MREAL = 24576, NMETA = 16, MPAD = 24832;
constexpr int DIN = 9216, DFF = 11008, NGU = 2 * DFF;
constexpr float EPS = 1e-6f;
constexpr float QSCALE = 0.08838834764831845f * 1.4426950408889634f;

constexpr size_t MiB = 1u << 20;
constexpr size_t WS_CTL = 0, CTL_ZERO_BYTES = 1 * MiB;
constexpr size_t WS_ACC2 = 256 * 1024;
constexpr size_t WS_WIN = 4 * MiB;
constexpr size_t WS_WOUT = WS_WIN + (size_t)DIN * DM * 2;
constexpr size_t WS_WGU = WS_WOUT + (size_t)DM * DM * 2;
constexpr size_t WS_WDN = WS_WGU + (size_t)NGU * DM * 2;
constexpr size_t WS_A = WS_WDN + (size_t)DM * DFF * 2;
constexpr size_t WS_B = WS_A + (size_t)MPAD * DM * 2;
constexpr size_t WS_END = WS_B + (size_t)MREAL * DFF * 2;
static_assert((size_t)MPAD * DIN * 2 <= (size_t)MREAL * DFF * 2, "proj fits the act region");
constexpr size_t WS_RSX = 768 * 1024;
constexpr size_t WS_ACTMAX = 896 * 1024;
constexpr size_t WS_CMAXD = 480 * 1024;
constexpr size_t WS_ACT8 = WS_WIN;
constexpr size_t WS_CMAXO = 736 * 1024;
constexpr size_t WS_ONSC = 1 * MiB;
constexpr size_t WS_ON8 = WS_B + 256 * MiB;
constexpr size_t WS_SCALEA = 512 * 1024;
constexpr size_t WS_COLMAX = 640 * 1024;
constexpr int CW_BAR = 4096;
static_assert(WS_ACC2 + (size_t)MREAL * 2 * 4 <= WS_SCALEA && WS_SCALEA + (size_t)MREAL * 4 <= WS_COLMAX && WS_COLMAX + (size_t)NGU * 4 <= WS_CMAXO && WS_CMAXO + (size_t)DM * 4 <= WS_RSX && WS_ACC2 + (size_t)MREAL * 8 <= WS_CMAXD && WS_CMAXD + (size_t)DM * 4 <= WS_SCALEA && WS_ACT8 + (size_t)MREAL * DFF <= WS_WDN && WS_RSX + (size_t)MREAL * 4 <= WS_ACTMAX && WS_ACTMAX + (size_t)MREAL * 4 <= CTL_ZERO_BYTES && WS_ONSC + (size_t)MREAL * 8 <= WS_WIN && (size_t)MREAL * DM * 2 <= 256 * MiB && 256 * MiB + (size_t)MREAL * DM <= (size_t)MREAL * DFF * 2 && WS_RSX + (size_t)MREAL * 4 <= CTL_ZERO_BYTES && (size_t)MREAL * DM <= (size_t)(DIN + DM) * DM * 2 && (CW_BAR + XCD_BAR_WORDS) * 4 <= (int)WS_ACC2, "control region map");

constexpr int RING_OFF = 0, RING_BYTES = 131072;
constexpr int LDSCTL_OFF = RING_BYTES, MISC_OFF = LDSCTL_OFF + 320;
constexpr int OG_OFF = 94208;
constexpr int SLAB_RED_OFF = 90112;
#ifndef SLAB0
#define SLAB0 412
#endif
constexpr int P0_SCR = 8448, GAIN_OFF = 69632;
constexpr int LDS_BYTES = 147456;
static_assert(MISC_OFF + 128 <= LDS_BYTES && NWAVES * P0_SCR <= GAIN_OFF && GAIN_OFF + 16384 <= RING_BYTES && att::P_ATT_LDS <= RING_BYTES && att::PROWS == MPAD, "LDS map");

__device__ __forceinline__ unsigned pkbf(float lo, float hi) { return pg8::cvt_pk_bf16(lo, hi); }
__device__ __forceinline__ int lane_id() { unsigned z = 0u; asm volatile("" : "+s"(z)); return (int)__builtin_amdgcn_mbcnt_hi(~0u, __builtin_amdgcn_mbcnt_lo(~0u, z)); }
struct Frame {
    LAS unsigned char* lds;
    volatile LAS unsigned* MISC;
    int wave;
    int vcu, G;
};
template <int PAT> __device__ __forceinline__ float swz_xor(float v) { return __builtin_bit_cast(float, __builtin_amdgcn_ds_swizzle(__builtin_bit_cast(int, v), PAT)); }
__device__ __forceinline__ float wave_sum(float v) {
    v += swz_xor<(1 << 10) | 0x1f>(v); v += swz_xor<(2 << 10) | 0x1f>(v); v += swz_xor<(4 << 10) | 0x1f>(v); v += swz_xor<(8 << 10) | 0x1f>(v); v += swz_xor<(16 << 10) | 0x1f>(v);
    const auto rr = __builtin_amdgcn_permlane32_swap(__float_as_uint(v), __float_as_uint(v), false, false);
    return __uint_as_float(rr[0]) + __uint_as_float(rr[1]);
}
__device__ __forceinline__ float wave_max(float v) {
    v = fmaxf(v, swz_xor<(1 << 10) | 0x1f>(v)); v = fmaxf(v, swz_xor<(2 << 10) | 0x1f>(v)); v = fmaxf(v, swz_xor<(4 << 10) | 0x1f>(v)); v = fmaxf(v, swz_xor<(8 << 10) | 0x1f>(v)); v = fmaxf(v, swz_xor<(16 << 10) | 0x1f>(v));
    const auto rr = __builtin_amdgcn_permlane32_swap(__float_as_uint(v), __float_as_uint(v), false, false);
    return fmaxf(__uint_as_float(rr[0]), __uint_as_float(rr[1]));
}
struct WItem { const float* W; bf16* WT; const float* kscale; float* cmax; int K, N, k0, n0, dst_row0, mode; float scale; int had; };
__device__ __forceinline__ void witem_load(f32x4 (&v)[8], const WItem& it, int lane) {
    const float* p = it.W + (size_t)(it.k0 + (lane >> 3)) * it.N + it.n0 + 4 * (lane & 7);
#pragma unroll
    for (int i = 0; i < 8; ++i) v[i] = __builtin_nontemporal_load((const GAS f32x4*)(p + (size_t)(8 * i) * it.N));
}
__device__ __forceinline__ void witem_store(const f32x4 (&v)[8], const WItem& it, LAS float* scr, int lane) {
#pragma unroll
    for (int i = 0; i < 8; ++i) { LAS float* d = scr + (8 * i + (lane >> 3)) * 33 + 4 * (lane & 7); d[0] = v[i].x; d[1] = v[i].y; d[2] = v[i].z; d[3] = v[i].w; }
    LDS_WAIT(); asm volatile("" ::: "memory");
    const int c = lane & 7;
    f32x4 ka = (f32x4){it.scale, it.scale, it.scale, it.scale}, kb = ka;
    if (it.kscale) { ka = *(const GAS f32x4*)(it.kscale + it.k0 + 8 * c) * it.scale; kb = *(const GAS f32x4*)(it.kscale + it.k0 + 8 * c + 4) * it.scale; }
#pragma unroll
    for (int j = 0; j < 4; ++j) { const int n = (lane >> 3) + 8 * j; const LAS float* s = scr + (8 * c) * 33 + n;
        float x[8] = {s[0 * 33] * ka.x, s[1 * 33] * ka.y, s[2 * 33] * ka.z, s[3 * 33] * ka.w, s[4 * 33] * kb.x, s[5 * 33] * kb.y, s[6 * 33] * kb.z, s[7 * 33] * kb.w};
        if (it.had) {
#pragma unroll
            for (int b = 1; b < 8; b <<= 1)
#pragma unroll
                for (int i = 0; i < 8; ++i) if (!(i & b)) { const float a = x[i], e = x[i | b]; x[i] = a + e; x[i | b] = a - e; }
#pragma unroll
            for (int i = 0; i < 8; ++i) { const float p = __builtin_bit_cast(float, __builtin_amdgcn_update_dpp(0, __builtin_bit_cast(int, x[i]), 0xB1, 0xF, 0xF, false)); x[i] = (lane & 1) ? p - x[i] : x[i] + p; }
#pragma unroll
            for (int i = 0; i < 8; ++i) { const float p = __builtin_bit_cast(float, __builtin_amdgcn_update_dpp(0, __builtin_bit_cast(int, x[i]), 0x4E, 0xF, 0xF, false)); x[i] = (lane & 2) ? p - x[i] : x[i] + p; } }
        if (it.mode == 1) {
            float m = fmaxf(fmaxf(fmaxf(fabsf(x[0]), fabsf(x[1])), fmaxf(fabsf(x[2]), fabsf(x[3]))), fmaxf(fmaxf(fabsf(x[4]), fabsf(x[5])), fmaxf(fabsf(x[6]), fabsf(x[7]))));
            m = fmaxf(m, __builtin_bit_cast(float, __builtin_amdgcn_update_dpp(0, __builtin_bit_cast(int, m), 0xB1, 0xF, 0xF, false)));
            m = fmaxf(m, __builtin_bit_cast(float, __builtin_amdgcn_update_dpp(0, __builtin_bit_cast(int, m), 0x4E, 0xF, 0xF, false)));
            m = fmaxf(m, swz_xor<(4 << 10) | 0x1f>(m));
            if (c == 0) atomicMax((unsigned*)it.cmax + it.dst_row0 + n, __builtin_bit_cast(unsigned, m));
        } else if (it.mode == 2) {
            const float cm = it.cmax[it.dst_row0 + n], inv = cm > 0.f ? 127.0f / cm : 0.f;
#define WQ_(v) __builtin_bit_cast(unsigned, __builtin_fmaf((v), inv, 12582912.0f))
            const unsigned lo = __builtin_amdgcn_perm(__builtin_amdgcn_perm(WQ_(x[3]), WQ_(x[2]), 0x0c0c0400u), __builtin_amdgcn_perm(WQ_(x[1]), WQ_(x[0]), 0x0c0c0400u), 0x05040100u);
            const unsigned hi = __builtin_amdgcn_perm(__builtin_amdgcn_perm(WQ_(x[7]), WQ_(x[6]), 0x0c0c0400u), __builtin_amdgcn_perm(WQ_(x[5]), WQ_(x[4]), 0x0c0c0400u), 0x05040100u);
#undef WQ_
            *(GAS unsigned long long*)((GAS unsigned char*)it.WT + (size_t)(it.dst_row0 + n) * it.K + it.k0 + 8 * c) = (unsigned long long)lo | ((unsigned long long)hi << 32);
        } else {
        v4u o; o.x = pkbf(x[0], x[1]); o.y = pkbf(x[2], x[3]); o.z = pkbf(x[4], x[5]); o.w = pkbf(x[6], x[7]);
        *(GAS v4u*)(it.WT + (size_t)(it.dst_row0 + n) * it.K + it.k0 + 8 * c) = o; } }
    LDS_WAIT(); asm volatile("" ::: "memory");
}
constexpr int NB_IN = DIN / 32, NB_DM = DM / 32, NB_FF = DFF / 32;
constexpr int I_IN = (DM / 64) * NB_IN, I_OUT = P4_INT8 ? 0   : (DM / 64) * NB_DM, I_D = (DFF / 64) * NB_DM;
constexpr int WI_N = I_IN + I_OUT + I_D, WI_A = I_IN + I_OUT;
struct WPtrs { const float *w_in, *w_out, *w_down, *g_na, *g_sw; bf16 *Win_t, *Wout_t, *Wdn_t; float* cmaxd; int dn_mode; };
__device__ __forceinline__ WItem witem_decode(const WPtrs& P, int it) {
    WItem w; int r = it; w.kscale = nullptr; w.cmax = nullptr; w.mode = 0; w.scale = 1.0f; w.had = 0;
    if (r < I_IN) { const int kb = r / NB_IN, nb = r % NB_IN, n0 = 32 * nb; const bool isq = (n0 < 2048) || (n0 >= 6144 && n0 < 8192);
        w.W = P.w_in; w.WT = P.Win_t; w.K = DM; w.N = DIN; w.k0 = 64 * kb; w.n0 = n0; w.dst_row0 = n0; w.scale = isq ? QSCALE : 1.0f; return w; } r -= I_IN;
    if (r < I_OUT) { const int kb = r / NB_DM, nb = r % NB_DM; w.W = P.w_out; w.WT = P.Wout_t; w.K = DM; w.N = DM; w.k0 = 64 * kb; w.n0 = 32 * nb; w.dst_row0 = 32 * nb;
        w.kscale = (64 * kb < 2048) ? P.g_na : P.g_sw - 2048; return w; } r -= I_OUT;
    { const int kb = r / NB_DM, nb = r % NB_DM; w.W = P.w_down; w.WT = P.Wdn_t; w.K = DFF; w.N = DM; w.k0 = 64 * kb; w.n0 = 32 * nb; w.dst_row0 = 32 * nb; w.had = 1; w.scale = 1.0f / 32.0f; w.mode = P.dn_mode; w.cmax = P.cmaxd; return w; }
}
constexpr int NSLAB = 2 * NB_FF;
template <bool KSC> __device__ __forceinline__ void w8_slab(const float* W, int ldn, const float* ksc, unsigned char* WT8, float* cmax, int n0, int dst_row0, LAS float* red  , int wave, int lane) {
    const int r8 = lane >> 3, c8 = lane & 7;
    const float* p = W + (size_t)(512 * wave + 64 * r8) * ldn + n0 + 4 * c8;
    unsigned st[128]; f32x4 mx = (f32x4){0.f, 0.f, 0.f, 0.f};
#pragma unroll
    for (int b = 0; b < 4; ++b) { f32x4 v[16];
#pragma unroll
        for (int i = 0; i < 16; ++i) v[i] = __builtin_nontemporal_load((const GAS f32x4*)(p + (size_t)(16 * b + i) * ldn));
        if constexpr (KSC) { const GAS f32x4* gp = (const GAS f32x4*)(ksc + 512 * wave + 64 * r8 + 16 * b);
#pragma unroll
            for (int i4 = 0; i4 < 4; ++i4) { const f32x4 g = gp[i4]; v[4 * i4] *= g.x; v[4 * i4 + 1] *= g.y; v[4 * i4 + 2] *= g.z; v[4 * i4 + 3] *= g.w; } }
#pragma unroll
        for (int i = 0; i < 16; ++i) { mx.x = fmaxf(mx.x, fabsf(v[i].x)); mx.y = fmaxf(mx.y, fabsf(v[i].y)); mx.z = fmaxf(mx.z, fabsf(v[i].z)); mx.w = fmaxf(mx.w, fabsf(v[i].w));
            st[2 * (16 * b + i)] = pkbf(v[i].x, v[i].y); st[2 * (16 * b + i) + 1] = pkbf(v[i].z, v[i].w); } }
#define SLAB_RED(PAT) do { mx.x = fmaxf(mx.x, swz_xor<PAT>(mx.x)); mx.y = fmaxf(mx.y, swz_xor<PAT>(mx.y)); mx.z = fmaxf(mx.z, swz_xor<PAT>(mx.z)); mx.w = fmaxf(mx.w, swz_xor<PAT>(mx.w)); } while (0)
    SLAB_RED((8 << 10) | 0x1f); SLAB_RED((16 << 10) | 0x1f);
#undef SLAB_RED
    { const auto r0 = __builtin_amdgcn_permlane32_swap(__float_as_uint(mx.x), __float_as_uint(mx.x), false, false); mx.x = fmaxf(__uint_as_float(r0[0]), __uint_as_float(r0[1]));
      const auto r1 = __builtin_amdgcn_permlane32_swap(__float_as_uint(mx.y), __float_as_uint(mx.y), false, false); mx.y = fmaxf(__uint_as_float(r1[0]), __uint_as_float(r1[1]));
      const auto r2 = __builtin_amdgcn_permlane32_swap(__float_as_uint(mx.z), __float_as_uint(mx.z), false, false); mx.z = fmaxf(__uint_as_float(r2[0]), __uint_as_float(r2[1]));
      const auto r3 = __builtin_amdgcn_permlane32_swap(__float_as_uint(mx.w), __float_as_uint(mx.w), false, false); mx.w = fmaxf(__uint_as_float(r3[0]), __uint_as_float(r3[1])); }
    if (r8 == 0) *(LAS f32x4*)(red + 32 * wave + 4 * c8) = mx;
    __syncthreads();
    f32x4 cm = *(const LAS f32x4*)(red + 4 * c8);
#pragma unroll
    for (int w = 1; w < 8; ++w) { const f32x4 o = *(const LAS f32x4*)(red + 32 * w + 4 * c8); cm.x = fmaxf(cm.x, o.x); cm.y = fmaxf(cm.y, o.y); cm.z = fmaxf(cm.z, o.z); cm.w = fmaxf(cm.w, o.w); }
    cm *= 1.00390625f;
    if (wave == 0 && r8 == 0) *(GAS f32x4*)(cmax + dst_row0 + 4 * c8) = cm;
    const float i0 = cm.x > 0.f ? 127.0f / cm.x : 0.f, i1 = cm.y > 0.f ? 127.0f / cm.y : 0.f, i2 = cm.z > 0.f ? 127.0f / cm.z : 0.f, i3 = cm.w > 0.f ? 127.0f / cm.w : 0.f;
    GAS unsigned char* dst = (GAS unsigned char*)WT8 + (size_t)(dst_row0 + 4 * c8) * DM + 512 * wave + 64 * r8;
#define SLAB_Q(word, hi, inv) __builtin_bit_cast(unsigned, __builtin_fmaf(__builtin_bit_cast(float, (hi) ? ((word) & 0xffff0000u) : ((word) << 16)), (inv), 12582912.0f))
#define SLAB_PK(a, b, c, d) __builtin_amdgcn_perm(__builtin_amdgcn_perm((d), (c), 0x0c0c0400u), __builtin_amdgcn_perm((b), (a), 0x0c0c0400u), 0x05040100u)
#pragma unroll
    for (int j = 0; j < 4; ++j) { const float inv = j == 0 ? i0 : (j == 1 ? i1 : (j == 2 ? i2 : i3));
#pragma unroll
        for (int q = 0; q < 4; ++q) { v4u o;
#pragma unroll
            for (int d = 0; d < 4; ++d) { const int i = 16 * q + 4 * d;
                const unsigned a = SLAB_Q(st[2 * (i + 0) + (j >> 1)], j & 1, inv), b = SLAB_Q(st[2 * (i + 1) + (j >> 1)], j & 1, inv), c = SLAB_Q(st[2 * (i + 2) + (j >> 1)], j & 1, inv), e = SLAB_Q(st[2 * (i + 3) + (j >> 1)], j & 1, inv);
                const unsigned w = SLAB_PK(a, b, c, e);
                if (d == 0) o.x = w; else if (d == 1) o.y = w; else if (d == 2) o.z = w; else o.w = w; }
            *(GAS v4u*)(dst + (size_t)j * DM + 16 * q) = o; } }
#undef SLAB_Q
#undef SLAB_PK
    __syncthreads();
}
__device__ __forceinline__ void wgu_slab(const float* w_gate, const float* w_up, unsigned char* WT8, float* cmax, int s, LAS float* red, int wave, int lane) {
    const int mat = s >= NB_FF ? 1 : 0, n0 = 32 * (s - mat * NB_FF), dst_row0 = (n0 >> 7) * 256 + mat * 128 + (n0 & 127);
    w8_slab<false>(mat ? w_up : w_gate, DFF, nullptr, WT8, cmax, n0, dst_row0, red, wave, lane);
}
constexpr int NSLAB_O = DM / 32;
__device__ __forceinline__ void wout_slab(const float* w_out, const LAS float* og  , unsigned char* WT8, float* cmax, int s, LAS float* red, int wave, int lane) {
    const int r8 = lane >> 3, c8 = lane & 7, n0 = 32 * s, kb = 2048 * (wave >> 2) + 32 * (wave & 3) + 4 * r8;
    const unsigned voff = ((unsigned)kb * DM + n0 + 4 * c8) * 4u;
    const LAS float* gl = og + kb;
    unsigned st[128]; f32x4 mx = (f32x4){0.f, 0.f, 0.f, 0.f};
#pragma unroll
    for (int b = 0; b < 4; ++b) { f32x4 v[16];
#pragma unroll
        for (int i = 0; i < 16; ++i) v[i] = __builtin_nontemporal_load((const GAS f32x4*)((const GAS char*)w_out + (size_t)(128 * i + b) * DM * 4 + voff));
#pragma unroll
        for (int i = 0; i < 16; ++i) { const float g = gl[128 * i + b] * (1.0f / 8.0f); v[i] *= g; }
        asm volatile("" ::: "memory");
#pragma unroll
        for (int s2 = 2; s2 < 16; s2 <<= 1)
#pragma unroll
            for (int i = 0; i < 16; ++i) if (!(i & s2)) { const f32x4 a = v[i], c = v[i | s2]; v[i] = a + c; v[i | s2] = a - c; }
#pragma unroll
        for (int i = 0; i < 16; ++i) { mx.x = fmaxf(mx.x, fabsf(v[i].x)); mx.y = fmaxf(mx.y, fabsf(v[i].y)); mx.z = fmaxf(mx.z, fabsf(v[i].z)); mx.w = fmaxf(mx.w, fabsf(v[i].w));
            st[2 * (16 * b + i)] = pkbf(v[i].x, v[i].y); st[2 * (16 * b + i) + 1] = pkbf(v[i].z, v[i].w); } }
#define SLAB_RED(PAT) do { mx.x = fmaxf(mx.x, swz_xor<PAT>(mx.x)); mx.y = fmaxf(mx.y, swz_xor<PAT>(mx.y)); mx.z = fmaxf(mx.z, swz_xor<PAT>(mx.z)); mx.w = fmaxf(mx.w, swz_xor<PAT>(mx.w)); } while (0)
    SLAB_RED((8 << 10) | 0x1f); SLAB_RED((16 << 10) | 0x1f);
#undef SLAB_RED
    { const auto r0 = __builtin_amdgcn_permlane32_swap(__float_as_uint(mx.x), __float_as_uint(mx.x), false, false); mx.x = fmaxf(__uint_as_float(r0[0]), __uint_as_float(r0[1]));
      const auto r1 = __builtin_amdgcn_permlane32_swap(__float_as_uint(mx.y), __float_as_uint(mx.y), false, false); mx.y = fmaxf(__uint_as_float(r1[0]), __uint_as_float(r1[1]));
      const auto r2 = __builtin_amdgcn_permlane32_swap(__float_as_uint(mx.z), __float_as_uint(mx.z), false, false); mx.z = fmaxf(__uint_as_float(r2[0]), __uint_as_float(r2[1]));
      const auto r3 = __builtin_amdgcn_permlane32_swap(__float_as_uint(mx.w), __float_as_uint(mx.w), false, false); mx.w = fmaxf(__uint_as_float(r3[0]), __uint_as_float(r3[1])); }
    if (r8 == 0) *(LAS f32x4*)(red + 32 * wave + 4 * c8) = mx;
    __syncthreads();
    f32x4 cm = *(const LAS f32x4*)(red + 4 * c8);
#pragma unroll
    for (int w = 1; w < 8; ++w) { const f32x4 o = *(const LAS f32x4*)(red + 32 * w + 4 * c8); cm.x = fmaxf(cm.x, o.x); cm.y = fmaxf(cm.y, o.y); cm.z = fmaxf(cm.z, o.z); cm.w = fmaxf(cm.w, o.w); }
    cm *= 1.00390625f;
    if (wave == 0 && r8 == 0) *(GAS f32x4*)(cmax + n0 + 4 * c8) = cm;
    const float i0 = cm.x > 0.f ? 127.0f / cm.x : 0.f, i1 = cm.y > 0.f ? 127.0f / cm.y : 0.f, i2 = cm.z > 0.f ? 127.0f / cm.z : 0.f, i3 = cm.w > 0.f ? 127.0f / cm.w : 0.f;
    GAS unsigned char* dst = (GAS unsigned char*)WT8 + (size_t)(n0 + 4 * c8) * DM + kb;
#define SLAB_Q(word, hi, inv) __builtin_bit_cast(unsigned, __builtin_fmaf(__builtin_bit_cast(float, (hi) ? ((word) & 0xffff0000u) : ((word) << 16)), (inv), 12582912.0f))
#define SLAB_PK(a, b, c, d) __builtin_amdgcn_perm(__builtin_amdgcn_perm((d), (c), 0x0c0c0400u), __builtin_amdgcn_perm((b), (a), 0x0c0c0400u), 0x05040100u)
#pragma unroll
    for (int j = 0; j < 4; ++j) { const float inv = j == 0 ? i0 : (j == 1 ? i1 : (j == 2 ? i2 : i3));
#pragma unroll
        for (int i = 0; i < 16; ++i) {
            const unsigned a = SLAB_Q(st[2 * (0 + i) + (j >> 1)], j & 1, inv), b = SLAB_Q(st[2 * (16 + i) + (j >> 1)], j & 1, inv), c = SLAB_Q(st[2 * (32 + i) + (j >> 1)], j & 1, inv), e = SLAB_Q(st[2 * (48 + i) + (j >> 1)], j & 1, inv);
            *(GAS unsigned*)(dst + (size_t)j * DM + 128 * i) = SLAB_PK(a, b, c, e); } }
#undef SLAB_Q
#undef SLAB_PK
    __syncthreads();
}
__device__ __forceinline__ void witems_run(const WPtrs& P, int lo, int hi, int rank, int nw, LAS float* scr, int lane) {
    if (lo + rank >= hi) return;
    WItem cur = witem_decode(P, lo + rank); f32x4 cv[8]; witem_load(cv, cur, lane);
    for (int it = lo + rank; it < hi; it += nw) {
        const int itn = it + nw; WItem nxt = cur; f32x4 nv[8];
        if (itn < hi) { nxt = witem_decode(P, itn); witem_load(nv, nxt, lane); }
        witem_store(cv, cur, scr, lane);
        if (itn < hi) {
#pragma unroll
            for (int i = 0; i < 8; ++i) cv[i] = nv[i];
            cur = nxt; }
    }
}
__device__ __forceinline__ void gain_to_lds(const float* g, LAS unsigned char* dst, int tid) {
    for (int i = tid; i < DM / 4; i += NWAVES * 64) ((LAS f32x4*)dst)[i] = ((const GAS f32x4*)g)[i];
}
__device__ __forceinline__ const float* x_row(const float* xp, const float* xs, const float* meta, int m) {
    return m < TP ? xp + (size_t)m * DM : (m < MREAL ? xs + (size_t)(m - TP) * DM : meta + (size_t)(m - MREAL) * DM);
}

typedef const __attribute__((address_space(4))) char* kptr_t;
__device__ __forceinline__ kptr_t kbase() { kptr_t p = (kptr_t)__builtin_amdgcn_kernarg_segment_ptr(); asm volatile("" : "+s"(p)); return p; }
__device__ __forceinline__ const float* kin(kptr_t p, int i) { return *(const float* const __attribute__((address_space(4)))*)(p + 8 * i); }
__device__ __forceinline__ float* kout(kptr_t p) { return *(float* const __attribute__((address_space(4)))*)(p + 128); }
__device__ __forceinline__ unsigned char* kws(kptr_t p) { return *(unsigned char* const __attribute__((address_space(4)))*)(p + 136); }
#define K_IN(name, i) const float* const name = kin(kp_, i)
#define K_WS(type, name, off) type* const name = (type*)(kws(kp_) + (off))
#define K_WPTRS(DN_MODE) const WPtrs WP{kin(kp_, 3), kin(kp_, 4), kin(kp_, 15), kin(kp_, 7), kin(kp_, 8), (bf16*)(kws(kp_) + WS_WIN), (bf16*)(kws(kp_) + WS_WOUT), (bf16*)(kws(kp_) + WS_WDN), (float*)(kws(kp_) + WS_CMAXD), (DN_MODE)}
#define GRID_BAR() do { XcdBarrier b_; b_.bar = (unsigned*)(kws(kbase()) + WS_CTL) + CW_BAR; b_.x = xb_xcc_id(); b_.st = F.MISC + 8; b_.t0 = (F.wave == 0 && lane_id() == 0); xcd_barrier(b_); } while (0)
struct Args { const float* in[16]; float* out; unsigned char* ws; };
__global__ void __launch_bounds__(NWAVES * 64, 2) enc_fwd(Args args) {
    extern __shared__ __attribute__((aligned(16))) unsigned char lds[];
    Frame F;
    F.lds = (LAS unsigned char*)lds;
    F.MISC = (volatile LAS unsigned*)(F.lds + MISC_OFF);
    F.wave = __builtin_amdgcn_readfirstlane((int)threadIdx.x >> 6);
    F.G = gridDim.x; { const int bx = blockIdx.x; F.vcu = (F.G % 8 == 0) ? (bx % 8) * (F.G / 8) + bx / 8 : bx; }
    for (int u = (F.wave * 64 + lane_id()); u < (LDS_BYTES - LDSCTL_OFF) / 4; u += NWAVES * 64) ((LAS unsigned*)(F.lds + LDSCTL_OFF))[u] = 0u;
    __syncthreads();
    (void)xcd_barrier_post((unsigned*)(kws(kbase()) + WS_CTL) + CW_BAR, F.MISC + 8, F.wave == 0 && lane_id() == 0);
    const int gw = F.vcu * NWAVES + F.wave, NGW = F.G * NWAVES;

#pragma unroll
    for (int rep_ = 0; rep_ < REP_P0; ++rep_) {
        const kptr_t kp_ = kbase(); K_IN(x_prompt, 0); K_IN(x_sample, 1); K_IN(meta, 2); K_IN(g_pre_mix, 9); K_WS(bf16, Abuf, WS_A); K_WS(float, rsx, WS_RSX);
        int ln = lane_id(); asm volatile("" : "+v"(ln));
        LAS float* scr = (LAS float*)(F.lds + RING_OFF + F.wave * P0_SCR);
        { int td = (F.wave * 64 + lane_id()); asm volatile("" : "+v"(td)); gain_to_lds(g_pre_mix, F.lds + GAIN_OFF, td); } __syncthreads();
        { constexpr int SLAB_ITEMS = 53; const int nsl = SLAB0 + (P4_INT8 ? NSLAB_O : 0), rem = nsl % F.G, nlight = rem ? F.G - rem : 0; const int nextra = (SLAB_ITEMS * nlight < WI_A) ? SLAB_ITEMS * nlight : 0;
          if (rep_ == 0) { K_IN(w_gate, 13); K_IN(w_up, 14); K_IN(w_out, 4); K_IN(g_na, 7); K_IN(g_sw, 8);
            { int td = F.wave * 64 + ln; for (int i = td; i < DM / 4; i += NWAVES * 64) ((LAS f32x4*)(F.lds + OG_OFF))[i] = i < 512 ? ((const GAS f32x4*)g_na)[i] : ((const GAS f32x4*)g_sw)[i - 512]; } __syncthreads(); K_WS(unsigned char, Wgu8, WS_WGU); K_WS(float, cmaxw, WS_COLMAX); K_WS(unsigned char, Wout8, WS_WOUT); K_WS(float, cmaxo, WS_CMAXO);
            for (int s = F.vcu; s < nsl; s += F.G) { if (s < SLAB0) wgu_slab(w_gate, w_up, Wgu8, cmaxw, s, (LAS float*)(F.lds + SLAB_RED_OFF), F.wave, ln);
                                                   else wout_slab(w_out, (const LAS float*)(F.lds + OG_OFF), Wout8, cmaxo, s - SLAB0, (LAS float*)(F.lds + SLAB_RED_OFF), F.wave, ln); } }
          K_WPTRS(1);
          if (nextra > 0 && F.vcu >= rem) witems_run(WP, 0, nextra, (F.vcu - rem) * NWAVES + F.wave, nlight * NWAVES, scr, ln);
          witems_run(WP, nextra, WI_A, gw, NGW, scr, ln);
          witems_run(WP, WI_A, WI_N, gw, NGW, scr, ln); }
        {
            f32x4 v[16];
            auto load_row = [&](f32x4 (&d)[16], int m) { if (m < MREAL + NMETA) { const GAS f32x4* xr = (const GAS f32x4*)x_row(x_prompt, x_sample, meta, m) + ln;
#pragma unroll
                    for (int j = 0; j < 16; ++j) d[j] = __builtin_nontemporal_load(xr + 64 * j); } };
            if (gw < MPAD) load_row(v, gw);
            for (int m = gw; m < MPAD; m += NGW) {
                const int mn = m + NGW; f32x4 nv[16];
                if (mn < MPAD) load_row(nv, mn);
                GAS unsigned long long* o8 = (GAS unsigned long long*)(Abuf + (size_t)m * DM) + ln;
                if (m >= MREAL + NMETA) {
#pragma unroll
                    for (int j = 0; j < 16; ++j) o8[64 * j] = 0ull;
                } else {
                    float s = 0.f;
#pragma unroll
                    for (int j = 0; j < 16; ++j) s += (v[j].x * v[j].x + v[j].y * v[j].y) + (v[j].z * v[j].z + v[j].w * v[j].w);
                    const float nrm = sqrtf(wave_sum(s) * (1.0f / DM) + EPS), rs = 1.0f / nrm;
                    if (ln == 0 && m < MREAL) rsx[m] = nrm;
#pragma unroll
                    for (int j = 0; j < 16; ++j) { const f32x4 g = ((const LAS f32x4*)(F.lds + GAIN_OFF))[ln + 64 * j];
                        o8[64 * j] = (unsigned long long)pkbf(v[j].x * rs * g.x, v[j].y * rs * g.y) | ((unsigned long long)pkbf(v[j].z * rs * g.z, v[j].w * rs * g.w) << 32);
                        if ((j & 3) == 3) asm volatile("" ::: "memory"); }
                }
                if (mn < MPAD) {
#pragma unroll
                    for (int j = 0; j < 16; ++j) v[j] = nv[j]; }
            }
        }
    }
    GRID_BAR();

    {
        const kptr_t kp_ = kbase(); K_WS(bf16, Abuf, WS_A); K_WS(bf16, Win_t, WS_WIN); K_WS(bf16, Bbuf, WS_B);
        pg8::Gemm g{Abuf, Win_t, MPAD, DIN, DM}; pg8::StaticOrder S; S.init(MPAD, DIN, F.G, (int)blockIdx.x, WGM_P1);
        pg8::EpiBf16Blk E{Bbuf, MPAD};
        pg8::gemm_phase<pg8::EpiBf16Blk, pg8::StaticOrder, true, true>(F.lds + RING_OFF, g, S, E, F.wave);
        { constexpr int NWG = (MPAD / 256) * (DIN / 256); const int rem = NWG % F.G; const bool idle = rem != 0 && (int)blockIdx.x >= rem;
          if (idle || rem == 0) { int ln = lane_id(); asm volatile("" : "+v"(ln));
              K_IN(w_gate, 13); K_IN(w_up, 14); K_WS(unsigned char, Wgu8, WS_WGU); K_WS(float, cmaxw, WS_COLMAX);
              const int rank = idle ? (int)blockIdx.x - rem : (int)blockIdx.x, nr = idle ? F.G - rem : F.G;
              for (int s = SLAB0 + rank; s < NSLAB; s += nr) wgu_slab(w_gate, w_up, Wgu8, cmaxw, s, (LAS float*)(F.lds + SLAB_RED_OFF), F.wave, ln); } }
    }
    GRID_BAR();

#pragma unroll
    for (int rep_ = 0; rep_ < REP_P2; ++rep_) {
        const kptr_t kp_ = kbase(); K_WS(bf16, Bbuf, WS_B); K_WS(float, ssq, WS_ACC2); K_IN(rpb, 5); K_IN(sink, 6);
        const att::bf16* Pp = (const att::bf16*)Bbuf; att::bf16* Op = (att::bf16*)kout(kp_);
#pragma unroll
        for (int rna_ = 0; rna_ < REP_NA; ++rna_)
        for (int uidx = F.vcu; uidx < 1536; uidx += F.G) {
            att::UnitP u;
            if (uidx < 1024) { u.seqbase = 0; u.T = TP; u.head = uidx >> 6; u.blk = uidx & 63; }
            else { const int v = uidx - 1024; u.seqbase = TP + TS * (v >> 8); u.T = TS; u.head = (v & 255) >> 4; u.blk = v & 15; }
            att::bf16* Op2 = Op; float* ssq2 = ssq; const att::bf16* Pp2 = Pp; asm volatile("" : "+s"(Op2), "+s"(ssq2), "+s"(Pp2));
            att::attn_unit_na4(u, Pp2, Op2, ssq2, rpb, (LAS char*)F.lds + RING_OFF, F.wave, rna_ == 0);
        }
#pragma unroll
        for (int rsw_ = 0; rsw_ < REP_SW; ++rsw_)
        for (int uidx = F.vcu; uidx < 1536; uidx += F.G) {
            att::UnitP u;
            if (uidx < 1024) { u.seqbase = 0; u.T = TP; u.head = uidx >> 8; u.blk = uidx & 255; }
            else { const int v = uidx - 1024; u.seqbase = TP + TS * (v >> 8); u.T = TS; u.head = (v & 255) >> 6; u.blk = v & 63; }
            att::bf16* Op2 = Op; float* ssq2 = ssq; const att::bf16* Pp2 = Pp; asm volatile("" : "+s"(Op2), "+s"(ssq2), "+s"(Pp2));
            att::attn_unit_sw4(u, Pp2, Op2, ssq2, sink, (LAS char*)F.lds + RING_OFF, F.wave, rsw_ == 0);
        }
    }
    GRID_BAR();

#if P4_INT8
    { int ln3 = lane_id(); asm volatile("" : "+v"(ln3));
    const kptr_t kp_ = kbase(); K_WS(float, ssq, WS_ACC2); K_WS(float, onsc, WS_ONSC); K_WS(unsigned char, On8, WS_ON8); const bf16* const Obuf = (const bf16*)kout(kp_);
    for (int m = gw; m < MREAL; m += NGW) {
        const GAS unsigned long long* orow = (const GAS unsigned long long*)(Obuf + (size_t)m * DM) + ln3;
        f32x4 v[16];
        { unsigned long long ow[16];
#pragma unroll
          for (int j = 0; j < 16; ++j) ow[j] = __builtin_nontemporal_load(orow + 64 * j);
#pragma unroll
          for (int j = 0; j < 16; ++j) { const unsigned lo = (unsigned)ow[j], hi = (unsigned)(ow[j] >> 32); v[j] = (f32x4){att::bf_lo(lo), att::bf_hi(lo), att::bf_lo(hi), att::bf_hi(hi)}; } }
        const float qa = ssq[2 * (size_t)m], qb = ssq[2 * (size_t)m + 1];
#pragma unroll
        for (int s2 = 1; s2 < 8; s2 <<= 1)
#pragma unroll
            for (int j = 0; j < 16; ++j) if (!(j & s2)) { const f32x4 a = v[j], c = v[j | s2]; v[j] = a + c; v[j | s2] = a - c; }
        float ama = 0.f, amb = 0.f;
#pragma unroll
        for (int j = 0; j < 16; ++j) { const float mx = fmaxf(fmaxf(fabsf(v[j].x), fabsf(v[j].y)), fmaxf(fabsf(v[j].z), fabsf(v[j].w)));
            if (j < 8) ama = fmaxf(ama, mx); else amb = fmaxf(amb, mx); }
        const float rsa = 1.0f / sqrtf(qa * (1.0f / 2048.0f) + EPS), rsb = 1.0f / sqrtf(qb * (1.0f / 2048.0f) + EPS);
        float na = wave_max(ama) * rsa, nb = wave_max(amb) * rsb;
        na = fmaxf(fmaxf(na, nb * (1.0f / 32.0f)), 1e-30f); nb = fmaxf(nb, na * (1.0f / 32.0f));
        const float sa = na * (1.0f / 127.0f), sb = nb * (1.0f / 127.0f), ia = rsa / sa, ib = rsb / sb;
        GAS unsigned* o4 = (GAS unsigned*)(On8 + (size_t)m * DM) + ln3;
#pragma unroll
        for (int j = 0; j < 16; ++j) { const float iv = j < 8 ? ia : ib;
            const int a0 = (int)__builtin_rintf(v[j].x * iv), a1 = (int)__builtin_rintf(v[j].y * iv), a2 = (int)__builtin_rintf(v[j].z * iv), a3 = (int)__builtin_rintf(v[j].w * iv);
            o4[64 * j] = ((unsigned)a0 & 255u) | (((unsigned)a1 & 255u) << 8) | (((unsigned)a2 & 255u) << 16) | ((unsigned)a3 << 24); }
        if (ln3 == 0) { onsc[2 * (size_t)m] = sa; onsc[2 * (size_t)m + 1] = sb; }
    }
    }
    GRID_BAR();

    {
        const kptr_t kp_ = kbase(); K_WS(bf16, On8, WS_ON8); K_WS(bf16, Wout8, WS_WOUT); K_WS(float, onsc, WS_ONSC); K_WS(float, cmaxo, WS_CMAXO); K_WS(bf16, Bbuf, WS_B);
        pg8::Gemm g{On8, Wout8, MREAL, DM, DM / 2}; pg8::StaticOrder S; S.init(MREAL, DM, F.G, (int)blockIdx.x, WGM_P4);
        pg8::EpiBf16I8Norm2 E{Bbuf, DM, onsc, cmaxo};
        pg8::gemm_phase<pg8::EpiBf16I8Norm2, pg8::StaticOrder, true, true>(F.lds + RING_OFF, g, S, E, F.wave);
    }
#else
    {
        const kptr_t kp_ = kbase(); K_WS(bf16, Wout_t, WS_WOUT); K_WS(float, ssq, WS_ACC2); K_WS(bf16, Bbuf, WS_B);
        pg8::Gemm g{(const bf16*)kout(kp_), Wout_t, MREAL, DM, DM}; pg8::StaticOrder S; S.init(MREAL, DM, F.G, (int)blockIdx.x, WGM_P4);
        pg8::EpiBf16Norm2 E{Bbuf, DM, ssq, 1.0f / 2048.0f, EPS};
        pg8::gemm_phase<pg8::EpiBf16Norm2, pg8::StaticOrder, true, true>(F.lds + RING_OFF, g, S, E, F.wave);
    }
#endif
    GRID_BAR();

    { int ln5 = lane_id(); asm volatile("" : "+v"(ln5));
    const kptr_t kp_ = kbase(); K_IN(g_pre_mix, 9); K_IN(g_post_mix, 10); K_IN(g_pre_ffn, 11); K_WS(bf16, Abuf, WS_A); K_WS(bf16, Bbuf, WS_B); K_WS(unsigned char, H8, WS_WIN); K_WS(float, scaleA, WS_SCALEA); K_WS(float, rsx, WS_RSX); float* const out = kout(kp_);
    { int td = (F.wave * 64 + lane_id()); asm volatile("" : "+v"(td)); gain_to_lds(g_post_mix, F.lds + RING_OFF, td); gain_to_lds(g_pre_ffn, F.lds + RING_OFF + 16384, td);
      for (int i = td; i < DM / 4; i += NWAVES * 64) { const f32x4 g = ((const GAS f32x4*)g_pre_mix)[i]; ((LAS f32x4*)(F.lds + RING_OFF + 32768))[i] = (f32x4){1.0f / g.x, 1.0f / g.y, 1.0f / g.z, 1.0f / g.w}; } } __syncthreads();
    for (int m = gw; m < MREAL; m += NGW) {
        const GAS unsigned long long* mr = (const GAS unsigned long long*)(Bbuf + (size_t)m * DM) + ln5;
        const GAS unsigned long long* hr = (const GAS unsigned long long*)(Abuf + (size_t)m * DM) + ln5;
        f32x4 v[16]; unsigned long long mw[16], hw[16]; float s = 0.f;
#pragma unroll
        for (int j = 0; j < 16; ++j) { mw[j] = __builtin_nontemporal_load(mr + 64 * j); hw[j] = __builtin_nontemporal_load(hr + 64 * j); }
        const float nrm = rsx[m];
#pragma unroll
        for (int j = 0; j < 16; ++j) { const unsigned lo = (unsigned)mw[j], hi = (unsigned)(mw[j] >> 32); const float a = att::bf_lo(lo), b = att::bf_hi(lo), c = att::bf_lo(hi), d = att::bf_hi(hi);
            s += (a * a + b * b) + (c * c + d * d); }
        const float rs1 = 1.0f / sqrtf(wave_sum(s) * (1.0f / DM) + EPS); float s2 = 0.f;
        GAS unsigned long long* x8 = (GAS unsigned long long*)(out + (size_t)m * DM) + ln5;
#pragma unroll
        for (int j = 0; j < 16; ++j) { const f32x4 g = ((const LAS f32x4*)(F.lds + RING_OFF))[ln5 + 64 * j], rg = ((const LAS f32x4*)(F.lds + RING_OFF + 32768))[ln5 + 64 * j];
            const unsigned lo = (unsigned)mw[j], hi = (unsigned)(mw[j] >> 32), xl = (unsigned)hw[j], xh = (unsigned)(hw[j] >> 32);
            v[j].x = att::bf_lo(xl) * nrm * rg.x + att::bf_lo(lo) * rs1 * g.x; v[j].y = att::bf_hi(xl) * nrm * rg.y + att::bf_hi(lo) * rs1 * g.y;
            v[j].z = att::bf_lo(xh) * nrm * rg.z + att::bf_lo(hi) * rs1 * g.z; v[j].w = att::bf_hi(xh) * nrm * rg.w + att::bf_hi(hi) * rs1 * g.w;
            s2 += (v[j].x * v[j].x + v[j].y * v[j].y) + (v[j].z * v[j].z + v[j].w * v[j].w);
            x8[64 * j] = (unsigned long long)pkbf(v[j].x, v[j].y) | ((unsigned long long)pkbf(v[j].z, v[j].w) << 32);
            if ((j & 3) == 3) asm volatile("" ::: "memory"); }
        const float rs2 = 1.0f / sqrtf(wave_sum(s2) * (1.0f / DM) + EPS);
        float am = 0.f;
#pragma unroll
        for (int j = 0; j < 16; ++j) { const f32x4 g = ((const LAS f32x4*)(F.lds + RING_OFF + 16384))[ln5 + 64 * j];
            v[j].x *= rs2 * g.x; v[j].y *= rs2 * g.y; v[j].z *= rs2 * g.z; v[j].w *= rs2 * g.w;
            am = fmaxf(fmaxf(am, fmaxf(fabsf(v[j].x), fabsf(v[j].y))), fmaxf(fabsf(v[j].z), fabsf(v[j].w)));
            if ((j & 3) == 3) asm volatile("" ::: "memory"); }
        am = wave_max(am); const float inv = am > 0.f ? 127.0f / am : 0.f;
        GAS unsigned* o4 = (GAS unsigned*)(H8 + (size_t)m * DM) + ln5;
#pragma unroll
        for (int j = 0; j < 16; ++j) { const int a0 = (int)__builtin_rintf(v[j].x * inv), a1 = (int)__builtin_rintf(v[j].y * inv), a2 = (int)__builtin_rintf(v[j].z * inv), a3 = (int)__builtin_rintf(v[j].w * inv);
            o4[64 * j] = ((unsigned)a0 & 255u) | (((unsigned)a1 & 255u) << 8) | (((unsigned)a2 & 255u) << 16) | ((unsigned)a3 << 24); }
        if (ln5 == 0) scaleA[m] = am * (1.0f / 127.0f);
    }
    }
    GRID_BAR();

#pragma unroll
    for (int rep_ = 0; rep_ < REP_P6; ++rep_) {
        const kptr_t kp_ = kbase(); K_WS(bf16, H8, WS_WIN); K_WS(bf16, Wgu_t, WS_WGU); K_WS(bf16, Bbuf, WS_B);
        K_WS(float, scaleA, WS_SCALEA); K_WS(float, cmax, WS_COLMAX);
        pg8::Gemm g{H8, Wgu_t, MREAL, NGU, DM / 2};
        pg8::StaticOrder S; S.init(MREAL, NGU, F.G, (int)blockIdx.x);
        pg8::EpiSwiGLUI8 E{Bbuf, DFF, scaleA, cmax};
        pg8::gemm_phase<pg8::EpiSwiGLUI8, pg8::StaticOrder, true, true>(F.lds + RING_OFF, g, S, E, F.wave);
        if (rep_ == 0) { constexpr int NWG = (MREAL / 256) * (NGU / 256); const int rem = NWG % F.G; const bool idle = rem != 0 && (int)blockIdx.x >= rem;
          if (idle || rem == 0) { int ln = lane_id(); asm volatile("" : "+v"(ln));
              K_WPTRS(2);
              witems_run(WP, WI_A, WI_N, (idle ? (int)blockIdx.x - rem : (int)blockIdx.x) * NWAVES + F.wave, (idle ? F.G - rem : F.G) * NWAVES, (LAS float*)(F.lds + RING_OFF + F.wave * P0_SCR), ln); } }
    }
    GRID_BAR();

    { int ln6 = lane_id(); asm volatile("" : "+v"(ln6));
    const kptr_t kp_ = kbase(); K_WS(bf16, Bbuf, WS_B); K_WS(unsigned char, Act8, WS_ACT8); K_WS(float, scaleA, WS_SCALEA);
    const unsigned sm1 = (ln6 & 1) ? 0x80000000u : 0u, sm2 = (ln6 & 2) ? 0x80000000u : 0u, sm4 = (ln6 & 4) ? 0x80000000u : 0u;
#define P6B_X1(X) do { const float o_ = (X); const float p_ = __builtin_bit_cast(float, __builtin_amdgcn_update_dpp(0, __builtin_bit_cast(int, o_), 0xB1, 0xF, 0xF, false)); (X) = p_ + __builtin_bit_cast(float, __builtin_bit_cast(unsigned, o_) ^ sm1); } while (0)
#define P6B_X2(X) do { const float o_ = (X); const float p_ = __builtin_bit_cast(float, __builtin_amdgcn_update_dpp(0, __builtin_bit_cast(int, o_), 0x4E, 0xF, 0xF, false)); (X) = p_ + __builtin_bit_cast(float, __builtin_bit_cast(unsigned, o_) ^ sm2); } while (0)
#define P6B_X4(X) do { const float o_ = (X); const int lo_ = __builtin_amdgcn_update_dpp(0, __builtin_bit_cast(int, o_), 0x104, 0xF, 0x5, false); \
        const float p_ = __builtin_bit_cast(float, __builtin_amdgcn_update_dpp(lo_, __builtin_bit_cast(int, o_), 0x114, 0xF, 0xA, false)); (X) = p_ + __builtin_bit_cast(float, __builtin_bit_cast(unsigned, o_) ^ sm4); } while (0)
    for (int m = gw; m < MREAL; m += NGW) {
        const GAS unsigned long long* ar = (const GAS unsigned long long*)(Bbuf + (size_t)m * DFF) + ln6;
        GAS unsigned* o4 = (GAS unsigned*)(Act8 + (size_t)m * DFF) + ln6;
        unsigned st[86]; float am = 0.f;
        { unsigned long long aw[43];
#pragma unroll
          for (int i = 0; i < 43; ++i) aw[i] = __builtin_nontemporal_load(ar + 64 * i);
#pragma unroll
          for (int i = 0; i < 43; ++i) { const unsigned lo = (unsigned)aw[i], hi = (unsigned)(aw[i] >> 32);
            const float x0 = att::bf_lo(lo), y0 = att::bf_hi(lo), z0 = att::bf_lo(hi), w0 = att::bf_hi(hi);
            const float a_ = x0 + y0, b_ = x0 - y0, c_ = z0 + w0, d_ = z0 - w0; float x = a_ + c_, y = b_ + d_, z = a_ - c_, w = b_ - d_;
            P6B_X1(x); P6B_X1(y); P6B_X1(z); P6B_X1(w); P6B_X2(x); P6B_X2(y); P6B_X2(z); P6B_X2(w); P6B_X4(x); P6B_X4(y); P6B_X4(z); P6B_X4(w);
            am = fmaxf(fmaxf(am, fmaxf(fabsf(x), fabsf(y))), fmaxf(fabsf(z), fabsf(w)));
            st[2 * i] = pkbf(x, y); st[2 * i + 1] = pkbf(z, w); } }
        am = wave_max(am) * 1.00390625f;
        const float inv = am > 0.f ? 127.0f / am : 0.f;
#pragma unroll
        for (int j = 0; j < 43; ++j) { const unsigned lo = st[2 * j], hi = st[2 * j + 1];
#define P6B_Q(v) __builtin_bit_cast(unsigned, __builtin_fmaf((v), inv, 12582912.0f))
            o4[64 * j] = __builtin_amdgcn_perm(__builtin_amdgcn_perm(P6B_Q(att::bf_hi(hi)), P6B_Q(att::bf_lo(hi)), 0x0c0c0400u), __builtin_amdgcn_perm(P6B_Q(att::bf_hi(lo)), P6B_Q(att::bf_lo(lo)), 0x0c0c0400u), 0x05040100u);
#undef P6B_Q
        }
        if (ln6 == 0) scaleA[m] = am * (1.0f / 127.0f);
    }
#undef P6B_X1
#undef P6B_X2
#undef P6B_X4
    }
    GRID_BAR();

    {
        const kptr_t kp_ = kbase(); K_WS(bf16, Abuf, WS_A); K_WS(bf16, Wdn8, WS_WDN); K_WS(bf16, Act8, WS_ACT8); K_WS(float, scaleA, WS_SCALEA); K_WS(float, cmaxd, WS_CMAXD);
        pg8::Gemm g{Act8, Wdn8, MREAL, DM, DFF / 2}; pg8::StaticOrder S; S.init(MREAL, DM, F.G, (int)blockIdx.x, WGM_P7);
        pg8::EpiBf16I8 E{Abuf, DM, scaleA, cmaxd};
        pg8::gemm_phase<pg8::EpiBf16I8, pg8::StaticOrder, true, true>(F.lds + RING_OFF, g, S, E, F.wave);
    }
    GRID_BAR();

    { int ln8 = lane_id(); asm volatile("" : "+v"(ln8));
    const kptr_t kp_ = kbase(); K_IN(g_post_ffn, 12); K_WS(bf16, Abuf, WS_A); float* const out = kout(kp_);
    { int td = (F.wave * 64 + lane_id()); asm volatile("" : "+v"(td)); gain_to_lds(g_post_ffn, F.lds + RING_OFF, td); } __syncthreads();
    for (int m = gw; m < MREAL; m += NGW) {
        GAS f32x4* yr = (GAS f32x4*)(out + (size_t)m * DM) + ln8;
        const GAS unsigned long long* xr = (const GAS unsigned long long*)(out + (size_t)m * DM) + ln8;
        const GAS unsigned long long* fr = (const GAS unsigned long long*)(Abuf + (size_t)m * DM) + ln8;
        unsigned long long xw[16], fw[16]; float sf = 0.f;
#pragma unroll
        for (int j = 0; j < 16; ++j) { xw[j] = __builtin_nontemporal_load(xr + 64 * j); fw[j] = __builtin_nontemporal_load(fr + 64 * j); }
#pragma unroll
        for (int j = 0; j < 16; ++j) { const unsigned lo = (unsigned)fw[j], hi = (unsigned)(fw[j] >> 32); const float a = att::bf_lo(lo), b = att::bf_hi(lo), c = att::bf_lo(hi), d = att::bf_hi(hi);
            sf += (a * a + b * b) + (c * c + d * d); }
        const float rs3 = 1.0f / sqrtf(wave_sum(sf) * (1.0f / DM) + EPS);
#pragma unroll
        for (int j = 0; j < 16; ++j) { const f32x4 g3 = ((const LAS f32x4*)(F.lds + RING_OFF))[ln8 + 64 * j];
            const unsigned lo = (unsigned)fw[j], hi = (unsigned)(fw[j] >> 32), xl = (unsigned)xw[j], xh = (unsigned)(xw[j] >> 32);
            f32x4 y; y.x = att::bf_lo(xl) + att::bf_lo(lo) * rs3 * g3.x; y.y = att::bf_hi(xl) + att::bf_hi(lo) * rs3 * g3.y;
            y.z = att::bf_lo(xh) + att::bf_lo(hi) * rs3 * g3.z; y.w = att::bf_hi(xh) + att::bf_hi(hi) * rs3 * g3.w;
            __builtin_nontemporal_store(y, yr + 64 * j);
            if ((j & 3) == 3) asm volatile("" ::: "memory"); }
    }
    }
}

extern "C" void kernel_launch(void* const* d_in, const int* in_sizes, int n_in, void* d_out, int out_size, void* d_ws, size_t ws_size, hipStream_t stream) {
    static int grid = 0;
    if (grid == 0) {
        if (n_in != 16 || in_sizes[0] != TP * DM || in_sizes[1] != 2 * TS * DM || out_size != MREAL * DM || ws_size < WS_END) {
            fprintf(stderr, "kernel_launch: shape mismatch: n_in %d in0 %d in1 %d out %d ws %zu (need %zu); nothing launched\n", n_in, n_in > 0 ? in_sizes[0] : -1, n_in > 1 ? in_sizes[1] : -1, out_size, ws_size, (size_t)WS_END); grid = -1; return; }
        int dev = 0, cus = 0, per_cu = 0;
        if (hipGetDevice(&dev) != hipSuccess || hipDeviceGetAttribute(&cus, hipDeviceAttributeMultiprocessorCount, dev) != hipSuccess) { fprintf(stderr, "kernel_launch: device query failed\n"); grid = -1; return; }
        if (hipFuncSetAttribute((const void*)enc_fwd, hipFuncAttributeMaxDynamicSharedMemorySize, LDS_BYTES) != hipSuccess) { fprintf(stderr, "kernel_launch: hipFuncSetAttribute failed\n"); grid = -1; return; }
        if (hipOccupancyMaxActiveBlocksPerMultiprocessor(&per_cu, (const void*)enc_fwd, NWAVES * 64, LDS_BYTES) != hipSuccess || per_cu < 1)
            fprintf(stderr, "kernel_launch: note: occupancy query reports %d workgroups per CU\n", per_cu);
        (void)hipGetLastError();
        grid = cus;
    }
    if (grid < 0) return;
    if (hipMemsetAsync((char*)d_ws + WS_CTL, 0, CTL_ZERO_BYTES, stream) != hipSuccess) { fprintf(stderr, "kernel_launch: memset failed\n"); return; }
    Args a{};
    for (int i = 0; i < 16; ++i) a.in[i] = (const float*)d_in[i];
    a.out = (float*)d_out; a.ws = (unsigned char*)d_ws;
    hipLaunchKernelGGL(enc_fwd, dim3(grid), dim3(NWAVES * 64), LDS_BYTES, stream, a);
    const hipError_t le = hipPeekAtLastError();
    if (le != hipSuccess) fprintf(stderr, "kernel_launch: launch failed: %s\n", hipGetErrorName(le));
}
```
